# Optimizing an MI355X kernel written in HIP

```python
import jax, jax.numpy as jnp
from jax import lax
import numpy as np

D_MODEL = 1024
BATCH = 8
SEQ = 4096
DEPTH = 4

N_MIXERS = 4
GROUP_WIDTH = D_MODEL // N_MIXERS
HEAD_DIM = 64
N_GROUP_HEADS = GROUP_WIDTH // HEAD_DIM
D_FF = 4 * D_MODEL
N_MOD = 6
RMS_EPS = 1e-6
NEG_INF = -1e30

ROPE_THETA = 500000.0
ROPE_DIM = HEAD_DIM // 4

CONV_WIDTH = 3

CMP_BLOCK = 32
CMP_STRIDE = 16
CMP_HIDDEN = 2 * HEAD_DIM
SLC_BLOCK = 64
N_SLC = 16
N_INIT_BLOCKS = 1
N_LOCAL_BLOCKS = 2
FORCE_BONUS = 1e4
WINDOW = 512
Q_BLOCK = 128
N_BRANCH = 3

GLA_DK = HEAD_DIM // 2
GLA_DV = HEAD_DIM
GLA_RANK = 16
GLA_TAU = 16.0
GLA_CHUNK = 64

GMLP_CHUNK = 128
GMLP_DIM = GROUP_WIDTH // N_GROUP_HEADS

SPLIT_SIZES = (
    GROUP_WIDTH, GROUP_WIDTH, GROUP_WIDTH,
    GROUP_WIDTH, 2 * N_BRANCH * HEAD_DIM, N_BRANCH * N_GROUP_HEADS,
    N_GROUP_HEADS * GLA_DK, N_GROUP_HEADS * GLA_DK,
    N_GROUP_HEADS * GLA_DV, N_GROUP_HEADS * GLA_DV, GLA_RANK,
    GROUP_WIDTH, GROUP_WIDTH,
)
D_IN_PROJ = sum(SPLIT_SIZES)

kernel_name = 'hybrid_parallel_group_block'


def rms_norm(x, gain=None):
    xf = x.astype(jnp.float32)
    y = xf * lax.rsqrt(jnp.mean(xf * xf, axis=-1, keepdims=True) + RMS_EPS)
    if gain is not None:
        y = y * gain.astype(jnp.float32)
    return y.astype(x.dtype)


def layer_norm(x):
    xf = x.astype(jnp.float32)
    mu = jnp.mean(xf, axis=-1, keepdims=True)
    var = jnp.mean(jnp.square(xf - mu), axis=-1, keepdims=True)
    return ((xf - mu) * lax.rsqrt(var + RMS_EPS)).astype(x.dtype)


def split_cols(z, sizes):
    out, start = [], 0
    for s in sizes:
        out.append(z[..., start:start + s])
        start += s
    return out


def partial_rotary(x, positions):
    half = ROPE_DIM // 2
    inv_freq = ROPE_THETA ** (-jnp.arange(0, ROPE_DIM, 2, dtype=jnp.float32) / ROPE_DIM)
    ang = positions.astype(jnp.float32)[..., None] * inv_freq
    cos = jnp.cos(ang)[:, :, None, :]
    sin = jnp.sin(ang)[:, :, None, :]
    xr = x[..., :ROPE_DIM].astype(jnp.float32)
    x1, x2 = xr[..., :half], xr[..., half:]
    rot = jnp.concatenate([x1 * cos - x2 * sin, x2 * cos + x1 * sin], axis=-1).astype(x.dtype)
    return jnp.concatenate([rot, x[..., ROPE_DIM:]], axis=-1)


def masked_softmax(s, mask):
    p = jax.nn.softmax(jnp.where(mask, s, NEG_INF), axis=-1)
    return jnp.where(mask, p, 0.0)


def short_conv_mixer(h_in, b_gate, c_gate, conv_w):
    z = c_gate * h_in
    y = lax.conv_general_dilated(z, conv_w.astype(z.dtype)[:, None, :], (1,), ((CONV_WIDTH - 1, 0),),
                                 dimension_numbers=('NWC', 'WIO', 'NWC'),
                                 feature_group_count=GROUP_WIDTH)
    return b_gate * y


def cmp_to_slc_matrix(n_cmp, n_blk):
    cs = np.arange(n_cmp) * CMP_STRIDE
    ss = np.arange(n_blk) * SLC_BLOCK
    ov = np.minimum(cs[:, None] + CMP_BLOCK, ss[None, :] + SLC_BLOCK) - np.maximum(cs[:, None], ss[None, :])
    return jnp.asarray(np.clip(ov, 0, None) / CMP_STRIDE, dtype=jnp.float32)


def nsa_mixer(q_in, kv_in, gate_in, positions, cmp_pos, cmp_w1, cmp_w2):
    B, S, _ = q_in.shape
    H, HD = N_GROUP_HEADS, HEAD_DIM
    scale = HD ** -0.5
    q = q_in.reshape(B, S, H, HD)
    k_cmp, v_cmp, k_slc, v_slc, k_win, v_win = jnp.split(kv_in, 2 * N_BRANCH, axis=-1)

    n_cmp = (S - CMP_BLOCK) // CMP_STRIDE + 1
    blk = np.arange(n_cmp)[:, None] * CMP_STRIDE + np.arange(CMP_BLOCK)[None, :]

    def compress(t, j):
        z = (t[:, blk] + cmp_pos[j]).reshape(B, n_cmp, CMP_BLOCK * HD)
        return jax.nn.silu(z @ cmp_w1[j]) @ cmp_w2[j]

    kc, vc = compress(k_cmp, 0), compress(v_cmp, 1)
    t_idx = jnp.arange(S)
    cmp_end = jnp.arange(n_cmp) * CMP_STRIDE + CMP_BLOCK - 1
    mask_c = cmp_end[None, :] <= t_idx[:, None]
    s_c = jnp.einsum('bshd,bnd->bhsn', q, kc).astype(jnp.float32) * scale
    p_c = masked_softmax(s_c, mask_c)
    o_cmp = jnp.einsum('bhsn,bnd->bshd', p_c.astype(vc.dtype), vc)

    n_blk = S // SLC_BLOCK
    p_slc = jnp.einsum('bhsn,nj->bsj', p_c, cmp_to_slc_matrix(n_cmp, n_blk))
    cur = (t_idx // SLC_BLOCK)[:, None]
    j = jnp.arange(n_blk)[None, :]
    forced = (j < N_INIT_BLOCKS) | ((cur - j >= 0) & (cur - j < N_LOCAL_BLOCKS))
    score = jnp.where(j <= cur, p_slc + jnp.where(forced, FORCE_BONUS, 0.0), NEG_INF)
    n_top = min(N_SLC, n_blk)
    _, sel_idx = lax.top_k(score, n_top)

    q_r = partial_rotary(q, positions)
    rope_k = lambda t: partial_rotary(t[:, :, None, :], positions)[:, :, 0, :]
    k_s_blk = rope_k(k_slc).reshape(B, n_blk, SLC_BLOCK, HD)
    v_s_blk = v_slc.reshape(B, n_blk, SLC_BLOCK, HD)
    pad = ((0, 0), (WINDOW, 0), (0, 0))
    k_w_pad = jnp.pad(rope_k(k_win), pad)
    v_w_pad = jnp.pad(v_win, pad)

    n_qb = S // Q_BLOCK
    q_blocks = q_r.reshape(B, n_qb, Q_BLOCK, H, HD).transpose(1, 0, 3, 2, 4)
    idx_blocks = sel_idx.reshape(B, n_qb, Q_BLOCK, n_top).transpose(1, 0, 2, 3)
    take = jax.vmap(lambda blocks, idx: blocks[idx])

    def block_fn(args):
        qb, q_b, idx_b = args
        tq = qb * Q_BLOCK + jnp.arange(Q_BLOCK)
        k_sel = take(k_s_blk, idx_b).reshape(B, Q_BLOCK, n_top * SLC_BLOCK, HD)
        v_sel = take(v_s_blk, idx_b).reshape(B, Q_BLOCK, n_top * SLC_BLOCK, HD)
        kpos = (idx_b[..., None] * SLC_BLOCK + jnp.arange(SLC_BLOCK)).reshape(B, Q_BLOCK, n_top * SLC_BLOCK)
        s_s = jnp.einsum('bhqd,bqkd->bhqk', q_b, k_sel).astype(jnp.float32) * scale
        p_s = masked_softmax(s_s, (kpos <= tq[None, :, None])[:, None])
        o_s = jnp.einsum('bhqk,bqkd->bhqd', p_s.astype(v_sel.dtype), v_sel)
        start = qb * Q_BLOCK
        k_wb = lax.dynamic_slice_in_dim(k_w_pad, start, Q_BLOCK + WINDOW, axis=1)
        v_wb = lax.dynamic_slice_in_dim(v_w_pad, start, Q_BLOCK + WINDOW, axis=1)
        kpos_w = start - WINDOW + jnp.arange(Q_BLOCK + WINDOW)
        diff = tq[:, None] - kpos_w[None, :]
        m_w = (diff >= 0) & (diff < WINDOW) & (kpos_w[None, :] >= 0)
        s_w = jnp.einsum('bhqd,bkd->bhqk', q_b, k_wb).astype(jnp.float32) * scale
        p_w = masked_softmax(s_w, m_w)
        o_w = jnp.einsum('bhqk,bkd->bhqd', p_w.astype(v_wb.dtype), v_wb)
        return o_s, o_w

    o_sel, o_win = lax.map(block_fn, (jnp.arange(n_qb), q_blocks, idx_blocks))
    to_bshd = lambda o: o.transpose(1, 0, 3, 2, 4).reshape(B, S, H, HD)
    g = jax.nn.sigmoid(gate_in.astype(jnp.float32)).astype(q.dtype).reshape(B, S, H, N_BRANCH)
    o = g[..., 0:1] * o_cmp + g[..., 1:2] * to_bshd(o_sel) + g[..., 2:3] * to_bshd(o_win)
    return o.reshape(B, S, GROUP_WIDTH)


def gla_mixer(q_in, k_in, v_in, g_in, lr_in, gate_w2, gate_b):
    B, S, _ = q_in.shape
    H, C = N_GROUP_HEADS, GLA_CHUNK
    n_c = S // C
    log_a = jax.nn.log_sigmoid((lr_in @ gate_w2 + gate_b).astype(jnp.float32)) / GLA_TAU

    def chunk(t, d):
        return t.reshape(B, n_c, C, H, d).transpose(0, 3, 1, 2, 4).astype(jnp.float32)

    q = chunk(q_in, GLA_DK) * GLA_DK ** -0.5
    k = chunk(k_in, GLA_DK)
    v = chunk(v_in, GLA_DV)
    b = jnp.cumsum(chunk(log_a, GLA_DK), axis=3)
    b_last = b[:, :, :, -1:, :]
    b_mid = b[:, :, :, C // 2:C // 2 + 1, :]
    causal = jnp.tril(jnp.ones((C, C), dtype=bool))
    att = jnp.einsum('bhntd,bhnsd->bhnts', q * jnp.exp(b - b_mid), k * jnp.exp(b_mid - b))
    o_intra = jnp.einsum('bhnts,bhnsv->bhntv', jnp.where(causal, att, 0.0), v)
    kv = jnp.einsum('bhnsd,bhnsv->bhndv', k * jnp.exp(b_last - b), v)
    decay = jnp.exp(b_last[:, :, :, 0, :])

    def step(state, inp):
        dec, kv_n = inp
        return dec[..., None] * state + kv_n, state

    init = jnp.zeros((B, H, GLA_DK, GLA_DV), jnp.float32)
    _, s_prev = lax.scan(step, init, (jnp.moveaxis(decay, 2, 0), jnp.moveaxis(kv, 2, 0)))
    o_inter = jnp.einsum('bhntd,nbhdv->bhntv', q * jnp.exp(b), s_prev)
    o = (o_intra + o_inter).transpose(0, 2, 3, 1, 4).reshape(B, S, H, GLA_DV)
    g = jax.nn.silu(g_in.astype(jnp.float32)).reshape(B, S, H, GLA_DV)
    return (g * rms_norm(o)).reshape(B, S, GROUP_WIDTH).astype(q_in.dtype)


def gmlp_mixer(u_in, v_in, w_s, b_s):
    B, S, _ = u_in.shape
    G, T = N_GROUP_HEADS, GMLP_CHUNK
    n_ch = S // T
    v = layer_norm(v_in.reshape(B, S, G, GMLP_DIM)).reshape(B, n_ch, T, G, GMLP_DIM)
    w = jnp.where(jnp.tril(jnp.ones((T, T), dtype=bool)), w_s, 0.0)
    mixed = jnp.einsum('gts,bnsgc->bntgc', w, v) + b_s.T[:, :, None]
    return (u_in.reshape(B, n_ch, T, G, GMLP_DIM) * mixed).reshape(B, S, GROUP_WIDTH)


def mixer_block(h, positions, w_in, conv_w, cmp_pos, cmp_w1, cmp_w2, gla_gate_w2, gla_gate_b,
                gmlp_ws, gmlp_b, grp_gain, w_o):
    B, S, _ = h.shape
    (a_h, a_b, a_c, n_q, n_kv, n_g, l_q, l_k, l_v, l_g, l_lr, m_u, m_v) = split_cols(h @ w_in, SPLIT_SIZES)
    outs = jnp.stack([
        short_conv_mixer(a_h, a_b, a_c, conv_w),
        nsa_mixer(n_q, n_kv, n_g, positions, cmp_pos, cmp_w1, cmp_w2),
        gla_mixer(l_q, l_k, l_v, l_g, l_lr, gla_gate_w2, gla_gate_b),
        gmlp_mixer(m_u, m_v, gmlp_ws, gmlp_b),
    ], axis=2)
    outs = rms_norm(outs, grp_gain.reshape(N_MIXERS, GROUP_WIDTH))
    return outs.reshape(B, S, D_MODEL) @ w_o


def setup_inputs(seed: int = 0) -> dict:
    key = jax.random.key(seed)
    ks = jax.random.split(key, 20)
    nrm = lambda k, shape, s: jax.random.normal(k, shape, jnp.float32) * s
    positions = (jax.random.randint(ks[2], (BATCH, 1), 0, SEQ, dtype=jnp.int32)
                 + jnp.arange(SEQ, dtype=jnp.int32)[None, :])
    return {
        'x': nrm(ks[0], (BATCH, SEQ, D_MODEL), 1.0),
        'c': nrm(ks[1], (BATCH, D_MODEL), 1.0),
        'positions': positions,
        'w_in': nrm(ks[3], (DEPTH, D_MODEL, D_IN_PROJ), D_MODEL ** -0.5),
        'conv_w': nrm(ks[4], (DEPTH, CONV_WIDTH, GROUP_WIDTH), CONV_WIDTH ** -0.5),
        'cmp_pos': nrm(ks[5], (DEPTH, 2, CMP_BLOCK, HEAD_DIM), 0.1),
        'cmp_w1': nrm(ks[6], (DEPTH, 2, CMP_BLOCK * HEAD_DIM, CMP_HIDDEN), (CMP_BLOCK * HEAD_DIM) ** -0.5),
        'cmp_w2': nrm(ks[7], (DEPTH, 2, CMP_HIDDEN, HEAD_DIM), CMP_HIDDEN ** -0.5),
        'gla_gate_w2': nrm(ks[8], (DEPTH, GLA_RANK, N_GROUP_HEADS * GLA_DK), GLA_RANK ** -0.5),
        'gla_gate_b': nrm(ks[9], (DEPTH, N_GROUP_HEADS * GLA_DK), 0.1),
        'gmlp_ws': nrm(ks[10], (DEPTH, N_GROUP_HEADS, GMLP_CHUNK, GMLP_CHUNK), 0.5 * GMLP_CHUNK ** -0.5),
        'gmlp_b': 1.0 + nrm(ks[11], (DEPTH, N_GROUP_HEADS, GMLP_CHUNK), 0.1),
        'grp_gain': 1.0 + nrm(ks[12], (DEPTH, D_MODEL), 0.1),
        'w_o': nrm(ks[13], (DEPTH, D_MODEL, D_MODEL), D_MODEL ** -0.5),
        'norm_g': 1.0 + nrm(ks[14], (DEPTH, 4, D_MODEL), 0.1),
        'w_mod': nrm(ks[15], (DEPTH, D_MODEL, N_MOD * D_MODEL), D_MODEL ** -0.5),
        'b_mod': nrm(ks[16], (DEPTH, N_MOD * D_MODEL), 0.02),
        'w_up': nrm(ks[17], (DEPTH, D_MODEL, D_FF), D_MODEL ** -0.5),
        'w_down': nrm(ks[18], (DEPTH, D_FF, D_MODEL), D_FF ** -0.5),
    }


def reference(x, c, positions, w_in, conv_w, cmp_pos, cmp_w1, cmp_w2, gla_gate_w2, gla_gate_b,
              gmlp_ws, gmlp_b, grp_gain, w_o, norm_g, w_mod, b_mod, w_up, w_down):
    cond = jax.nn.silu(c)
    for l in range(DEPTH):
        mod = cond @ w_mod[l] + b_mod[l]
        sh1, sc1, gt1, sh2, sc2, gt2 = [m[:, None, :] for m in jnp.split(mod, N_MOD, axis=-1)]
        h = rms_norm(x, norm_g[l, 0]) * (1.0 + sc1) + sh1
        y = mixer_block(h, positions, w_in[l], conv_w[l], cmp_pos[l], cmp_w1[l], cmp_w2[l],
                        gla_gate_w2[l], gla_gate_b[l], gmlp_ws[l], gmlp_b[l], grp_gain[l], w_o[l])
        x = x + gt1 * rms_norm(y, norm_g[l, 1])
        h = rms_norm(x, norm_g[l, 2]) * (1.0 + sc2) + sh2
        y = jnp.square(jax.nn.relu(h @ w_up[l])) @ w_down[l]
        x = x + gt2 * rms_norm(y, norm_g[l, 3])
    return x
```

```cpp
#include <hip/hip_runtime.h>
#include <cstdint>
#include <cstdio>

#define LAS __attribute__((address_space(3)))
typedef _Float16 f16;
typedef f16 f16x4 __attribute__((ext_vector_type(4)));
typedef f16 f16x8 __attribute__((ext_vector_type(8)));
typedef float f32x4 __attribute__((ext_vector_type(4)));

constexpr int D = 1024, NB = 8, S = 4096, DEPTH = 4, M = NB * S, DFF = 4096;
constexpr int NIN = 2716, ZP = 2816;
constexpr int ZC_AH = 0, ZC_AB = 256, ZC_AC = 512, ZC_NQ = 768, ZC_KCMP = 1024, ZC_VCMP = 1088, ZC_KSLC = 1152, ZC_VSLC = 1216,
              ZC_KWIN = 1280, ZC_VWIN = 1344, ZC_NG = 1408, ZC_LQ = 1424, ZC_LK = 1552, ZC_LV = 1680, ZC_LG = 1936, ZC_LR = 2192,
              ZC_MU = 2208, ZC_MV = 2464;
constexpr int NCMP = 255;
constexpr float EPS = 1e-6f;
constexpr int NT = 512, NWAVE = 8;

constexpr size_t MiB = 1u << 20;
constexpr size_t WS_CTL = 0;
constexpr size_t WS_MOD = 1 * MiB;
constexpr size_t WS_ROPE = 2 * MiB;
constexpr size_t WS_W16 = 4 * MiB;
constexpr size_t WS_H = 98 * MiB;
constexpr size_t WS_Y = 162 * MiB;
constexpr size_t WS_BIG = 226 * MiB;
constexpr size_t WS_Z = WS_BIG;
constexpr size_t WS_MIX = WS_BIG + 176 * MiB;
constexpr size_t WS_KSR = WS_BIG + 240 * MiB;
constexpr size_t WS_KWR = WS_BIG + 244 * MiB;
constexpr size_t WS_HID = WS_BIG + 248 * MiB;
constexpr size_t WS_KC = WS_BIG + 251 * MiB;
constexpr size_t WS_VC = WS_BIG + 252 * MiB;
constexpr size_t WS_END = 482 * MiB;
constexpr size_t WS_LA = WS_H;
constexpr size_t WS_QE2 = WS_H + 16 * MiB;
constexpr size_t WS_OI = WS_H + 32 * MiB;
constexpr size_t WS_KV = WS_Y;
constexpr size_t WS_SPREV = WS_Y + 16 * MiB;
constexpr size_t WS_VN = WS_Y + 32 * MiB;

constexpr int LDS_BYTES = 147456;

struct Ctx {
    const float* in[19];
    float* out;
    unsigned char* ws;
    int lo, hi;
};

__device__ __forceinline__ float wave_sum(float v) {
#pragma unroll
    for (int o = 32; o > 0; o >>= 1) v += __shfl_xor(v, o);
    return v;
}
__device__ __forceinline__ float wave_max(float v) {
#pragma unroll
    for (int o = 32; o > 0; o >>= 1) v = fmaxf(v, __shfl_xor(v, o));
    return v;
}
#define WAVE_LDS_SYNC() asm volatile("s_waitcnt lgkmcnt(0)" ::: "memory")
__device__ __forceinline__ float siluf(float v) { return v / (1.f + expf(-v)); }
__device__ __forceinline__ float sigmoidf_(float v) { return 1.f / (1.f + expf(-v)); }

__device__ __forceinline__ void sincos_d(double a, double& s, double& c) {
    const double two_over_pi = 0.63661977236758134308, pio2_hi = 1.57079632679489655800e+00, pio2_lo = 6.12323399573676603587e-17;
    const double kq = rint(a * two_over_pi);
    double r = (a - kq * pio2_hi) - kq * pio2_lo;
    const double r2 = r * r;
    double sp = r * (1.0 + r2 * (-1.0 / 6 + r2 * (1.0 / 120 + r2 * (-1.0 / 5040 + r2 * (1.0 / 362880 + r2 * (-1.0 / 39916800 + r2 * (1.0 / 6227020800.0 + r2 * (-1.0 / 1307674368000.0))))))));
    double cp = 1.0 + r2 * (-0.5 + r2 * (1.0 / 24 + r2 * (-1.0 / 720 + r2 * (1.0 / 40320 + r2 * (-1.0 / 3628800 + r2 * (1.0 / 479001600.0 + r2 * (-1.0 / 87178291200.0 + r2 * (1.0 / 20922789888000.0))))))));
    const int q = ((int)kq) & 3;
    if (q == 0) { s = sp; c = cp; } else if (q == 1) { s = cp; c = -sp; } else if (q == 2) { s = -sp; c = -cp; } else { s = -cp; c = sp; }
}

__device__ __forceinline__ void ph_mod(const Ctx& C, int bid, int nblk) {
    const float* c = C.in[1]; const float* w_mod = C.in[15]; const float* b_mod = C.in[16];
    float* MOD = (float*)(C.ws + WS_MOD);
    const int total = DEPTH * NB * 6 * D;
    for (int idx = bid * NT + threadIdx.x; idx < total; idx += nblk * NT) {
        const int n = idx % (6 * D), bb = (idx / (6 * D)) % NB, l = idx / (6 * D * NB);
        float acc = b_mod[l * 6 * D + n];
        const float* w = w_mod + (size_t)l * D * 6 * D + n;
        for (int k = 0; k < D; ++k) { const float cv = c[bb * D + k]; acc += siluf(cv) * w[(size_t)k * 6 * D]; }
        MOD[idx] = acc;
    }
}
__device__ __forceinline__ void ph_rope(const Ctx& C, int bid, int nblk) {
    const int* pos = (const int*)C.in[2];
    float* RC = (float*)(C.ws + WS_ROPE); float* RS = RC + (size_t)M * 8;
    const double invf[8] = {1.0, 0.19392274474868576, 0.03760603093086393, 0.007292664737217109, 0.001414213562373095, 0.0002742481756762073, 5.318295896944988e-05, 1.031338537721246e-05};
    for (int idx = bid * NT + threadIdx.x; idx < M * 8; idx += nblk * NT) {
        const int i = idx & 7, m = idx >> 3;
        double f = invf[0];
#pragma unroll
        for (int j = 1; j < 8; ++j) f = (i == j) ? invf[j] : f;
        double s, c; sincos_d((double)pos[m] * f, s, c);
        RC[idx] = (float)c; RS[idx] = (float)s;
    }
}
__device__ __forceinline__ void adaln_row(const float (&xv)[16], const float* g, const float* sc, const float* sh, f16* hrow, int lane) {
    float ss = 0.f;
#pragma unroll
    for (int j = 0; j < 16; ++j) ss += xv[j] * xv[j];
    const float r = rsqrtf(wave_sum(ss) * (1.f / D) + EPS);
#pragma unroll
    for (int j = 0; j < 4; ++j) {
        const int c0 = 256 * j + 4 * lane;
        const f32x4 gv = *(const f32x4*)(g + c0), scv = *(const f32x4*)(sc + c0), shv = *(const f32x4*)(sh + c0);
        f16x4 o;
#pragma unroll
        for (int e = 0; e < 4; ++e) o[e] = (f16)(xv[4 * j + e] * r * gv[e] * (1.f + scv[e]) + shv[e]);
        *(f16x4*)(hrow + c0) = o;
    }
}
__device__ __forceinline__ void ph_norm0(const Ctx& C, int bid, int nblk) {
    const float* x = C.in[0]; const float* norm_g = C.in[14]; const float* MOD = (const float*)(C.ws + WS_MOD);
    f16* H = (f16*)(C.ws + WS_H);
    const int lane = threadIdx.x & 63, gw = bid * NWAVE + (threadIdx.x >> 6), ngw = nblk * NWAVE;
    for (int m = gw; m < M; m += ngw) {
        const int b = m / S;
        float xv[16];
#pragma unroll
        for (int j = 0; j < 4; ++j) { const f32x4 v = *(const f32x4*)(x + (size_t)m * D + 256 * j + 4 * lane); xv[4 * j] = v[0]; xv[4 * j + 1] = v[1]; xv[4 * j + 2] = v[2]; xv[4 * j + 3] = v[3]; }
        const float* mod = MOD + (size_t)(0 * NB + b) * 6 * D;
        adaln_row(xv, norm_g + 0, mod + D, mod + 0, H + (size_t)m * D, lane);
    }
}
__device__ __forceinline__ void ph_resnorm(const Ctx& C, int l, int sub, int bid, int nblk) {
    const float* norm_g = C.in[14]; const float* MOD = (const float*)(C.ws + WS_MOD);
    const f16* Y = (const f16*)(C.ws + WS_Y); f16* H = (f16*)(C.ws + WS_H);
    const float* xsrc = (l == 0 && sub == 0) ? C.in[0] : C.out;
    const float* ga = norm_g + (size_t)(l * 4 + (sub == 0 ? 1 : 3)) * D;
    const bool has_next = !(l == DEPTH - 1 && sub == 1);
    const int ln = sub == 0 ? l : l + 1;
    const float* gb = norm_g + (size_t)((has_next ? ln : 0) * 4 + (sub == 0 ? 2 : 0)) * D;
    const int lane = threadIdx.x & 63, gw = bid * NWAVE + (threadIdx.x >> 6), ngw = nblk * NWAVE;
    for (int m = gw; m < M; m += ngw) {
        const int b = m / S;
        const float* mod = MOD + (size_t)(l * NB + b) * 6 * D;
        const float* gt = mod + (sub == 0 ? 2 : 5) * D;
        float yv[16], xv[16]; float ss = 0.f;
#pragma unroll
        for (int j = 0; j < 4; ++j) {
            const f16x4 v = *(const f16x4*)(Y + (size_t)m * D + 256 * j + 4 * lane);
#pragma unroll
            for (int e = 0; e < 4; ++e) { yv[4 * j + e] = (float)v[e]; ss += yv[4 * j + e] * yv[4 * j + e]; }
        }
        const float r = rsqrtf(wave_sum(ss) * (1.f / D) + EPS);
#pragma unroll
        for (int j = 0; j < 4; ++j) {
            const int c0 = 256 * j + 4 * lane;
            const f32x4 xo = *(const f32x4*)(xsrc + (size_t)m * D + c0), gav = *(const f32x4*)(ga + c0), gtv = *(const f32x4*)(gt + c0);
            f32x4 xn;
#pragma unroll
            for (int e = 0; e < 4; ++e) { xn[e] = xo[e] + gtv[e] * (yv[4 * j + e] * r * gav[e]); xv[4 * j + e] = xn[e]; }
            *(f32x4*)(C.out + (size_t)m * D + c0) = xn;
        }
        if (has_next) {
            const float* modn = MOD + (size_t)(ln * NB + b) * 6 * D;
            adaln_row(xv, gb, modn + (sub == 0 ? 4 : 1) * D, modn + (sub == 0 ? 3 : 0) * D, H + (size_t)m * D, lane);
        }
    }
}

template <int ACT, bool REMAP>
__device__ __forceinline__ void gemm_naive(const f16* A, const float* W, int N, int K, f16* O, int ldc, int bid, int nblk, LAS float* lds) {
    LAS float* As = lds;
    LAS float* Bs = lds + 16 * 132;
    const int tid = threadIdx.x, tx = tid & 15, ty = tid >> 4;
    const int ntn = (N + 127) / 128, ntm = M / 128;
    for (int tile = bid; tile < ntm * ntn; tile += nblk) {
        const int tm = tile / ntn, tn = tile % ntn, m0 = tm * 128, n0 = tn * 128;
        float acc[4][8];
#pragma unroll
        for (int i = 0; i < 4; ++i)
#pragma unroll
            for (int j = 0; j < 8; ++j) acc[i][j] = 0.f;
        for (int k0 = 0; k0 < K; k0 += 16) {
            {
                const f16x4 v = *(const f16x4*)(A + (size_t)(m0 + (tid >> 2)) * K + k0 + (tid & 3) * 4);
#pragma unroll
                for (int j = 0; j < 4; ++j) As[((tid & 3) * 4 + j) * 132 + (tid >> 2)] = (float)v[j];
                const int k = tid >> 5, n = n0 + (tid & 31) * 4;
                f32x4 w = {0.f, 0.f, 0.f, 0.f};
                if (n < N) w = *(const f32x4*)(W + (size_t)(k0 + k) * N + n);
                *(LAS f32x4*)(Bs + k * 128 + (tid & 31) * 4) = w;
            }
            __syncthreads();
#pragma unroll
            for (int kk = 0; kk < 16; ++kk) {
                const f32x4 a = *(const LAS f32x4*)(As + kk * 132 + ty * 4);
                const f32x4 b0 = *(const LAS f32x4*)(Bs + kk * 128 + tx * 8), b1 = *(const LAS f32x4*)(Bs + kk * 128 + tx * 8 + 4);
#pragma unroll
                for (int i = 0; i < 4; ++i) {
#pragma unroll
                    for (int j = 0; j < 4; ++j) { acc[i][j] += a[i] * b0[j]; acc[i][4 + j] += a[i] * b1[j]; }
                }
            }
            __syncthreads();
        }
#pragma unroll
        for (int i = 0; i < 4; ++i)
#pragma unroll
            for (int j = 0; j < 8; ++j) {
                const int n = n0 + tx * 8 + j;
                if (n < N) {
                    float v = acc[i][j];
                    if (ACT == 1) v = v > 0.f ? v * v : 0.f;
                    const int nc = REMAP ? n + (n >= 1420 ? 4 : 0) : n;
                    O[(size_t)(m0 + ty * 4 + i) * ldc + nc] = (f16)v;
                }
            }
    }
}

__device__ __forceinline__ void ph_conv(const Ctx& C, int l, int bid, int nblk) {
    const f16* Z = (const f16*)(C.ws + WS_Z); f16* MIX = (f16*)(C.ws + WS_MIX);
    const float* cw = C.in[4] + (size_t)l * 3 * 256; const float* gain = C.in[12] + (size_t)l * D;
    const int lane = threadIdx.x & 63, gw = bid * NWAVE + (threadIdx.x >> 6), ngw = nblk * NWAVE;
    for (int m = gw; m < M; m += ngw) {
        const int t = m % S;
        float o[4]; float ss = 0.f;
#pragma unroll
        for (int j = 0; j < 4; ++j) {
            const int ch = lane + 64 * j; float y = 0.f;
#pragma unroll
            for (int k = 0; k < 3; ++k) {
                const int tt = t - 2 + k;
                if (tt >= 0) { const f16* zr = Z + (size_t)(m - 2 + k) * ZP; y += (float)zr[ZC_AC + ch] * (float)zr[ZC_AH + ch] * cw[k * 256 + ch]; }
            }
            o[j] = (float)Z[(size_t)m * ZP + ZC_AB + ch] * y; ss += o[j] * o[j];
        }
        const float r = rsqrtf(wave_sum(ss) * (1.f / 256) + EPS);
#pragma unroll
        for (int j = 0; j < 4; ++j) { const int ch = lane + 64 * j; MIX[(size_t)m * D + ch] = (f16)(o[j] * r * gain[ch]); }
    }
}
__device__ __forceinline__ void ph_rotk(const Ctx& C, int bid, int nblk) {
    const f16* Z = (const f16*)(C.ws + WS_Z); f16* KSR = (f16*)(C.ws + WS_KSR); f16* KWR = (f16*)(C.ws + WS_KWR);
    const float* RC = (const float*)(C.ws + WS_ROPE); const float* RS = RC + (size_t)M * 8;
    for (int idx = bid * NT + threadIdx.x; idx < M * 128; idx += nblk * NT) {
        const int d = idx & 63, which = (idx >> 6) & 1, m = idx >> 7;
        const f16* zr = Z + (size_t)m * ZP + (which ? ZC_KWIN : ZC_KSLC);
        float v = (float)zr[d];
        if (d < 16) { const int i = d & 7; const float cs = RC[m * 8 + i], sn = RS[m * 8 + i];
            if (d < 8) v = v * cs - (float)zr[d + 8] * sn; else v = v * cs + (float)zr[d - 8] * sn; }
        (which ? KWR : KSR)[(size_t)m * 64 + d] = (f16)v;
    }
}
__device__ __forceinline__ void ph_cmp1(const Ctx& C, int l, int bid, int nblk) {
    const f16* Z = (const f16*)(C.ws + WS_Z); float* HID = (float*)(C.ws + WS_HID);
    const float* cpos = C.in[5] + (size_t)l * 2 * 32 * 64; const float* w1 = C.in[6] + (size_t)l * 2 * 2048 * 128;
    const int total = 2 * NB * NCMP * 128;
    for (int idx = bid * NT + threadIdx.x; idx < total; idx += nblk * NT) {
        const int o = idx & 127, i = (idx >> 7) % NCMP, b = ((idx >> 7) / NCMP) % NB, j = (idx >> 7) / (NCMP * NB);
        const float* w = w1 + (size_t)j * 2048 * 128 + o; const float* pp = cpos + j * 2048;
        const f16* zb = Z + (size_t)(b * S + 16 * i) * ZP + (j ? ZC_VCMP : ZC_KCMP);
        float acc = 0.f;
        for (int p = 0; p < 32; ++p)
            for (int d = 0; d < 64; ++d) acc += ((float)zb[(size_t)p * ZP + d] + pp[p * 64 + d]) * w[(size_t)(p * 64 + d) * 128];
        HID[idx] = siluf(acc);
    }
}
__device__ __forceinline__ void ph_cmp2(const Ctx& C, int l, int bid, int nblk) {
    const float* HID = (const float*)(C.ws + WS_HID); float* KC = (float*)(C.ws + WS_KC); float* VC = (float*)(C.ws + WS_VC);
    const float* w2 = C.in[7] + (size_t)l * 2 * 128 * 64;
    const int total = 2 * NB * NCMP * 64;
    for (int idx = bid * NT + threadIdx.x; idx < total; idx += nblk * NT) {
        const int d = idx & 63, bi = (idx >> 6) % (NB * NCMP), j = (idx >> 6) / (NB * NCMP);
        const float* hrow = HID + ((size_t)j * NB * NCMP + bi) * 128; const float* w = w2 + (size_t)j * 128 * 64 + d;
        float acc = 0.f;
        for (int o = 0; o < 128; ++o) acc += hrow[o] * w[o * 64];
        (j ? VC : KC)[(size_t)bi * 64 + d] = acc;
    }
}
__device__ __forceinline__ void ph_nsa(const Ctx& C, int l, int bid, int nblk, LAS float* lds) {
    const f16* Z = (const f16*)(C.ws + WS_Z); f16* MIX = (f16*)(C.ws + WS_MIX);
    const f16* KSR = (const f16*)(C.ws + WS_KSR); const f16* KWR = (const f16*)(C.ws + WS_KWR);
    const float* KC = (const float*)(C.ws + WS_KC); const float* VC = (const float*)(C.ws + WS_VC);
    const float* RC = (const float*)(C.ws + WS_ROPE); const float* RS = RC + (size_t)M * 8;
    const float* gain = C.in[12] + (size_t)l * D + 256;
    const int tid = threadIdx.x, lane = tid & 63, wave = tid >> 6;
    LAS float* kcs = lds;
    LAS float* wsb = lds + 16640 + wave * 1792;
    LAS float* Pc = wsb;
    LAS float* qs = wsb + 1024;
    LAS float* qr = wsb + 1280;
    LAS float* pS = wsb + 1536;
    const float NEG = -__builtin_inff();
    for (int item = bid; item < M / 128; item += nblk) {
        const int m0 = item * 128, b = m0 / S, t0 = m0 % S;
        const int nload = (t0 + 127 >= 31) ? ((t0 + 127 - 31) / 16 + 1 > NCMP ? NCMP : (t0 + 127 - 31) / 16 + 1) : 0;
        __syncthreads();
        for (int idx = tid; idx < nload * 64; idx += NT) kcs[(idx >> 6) * 65 + (idx & 63)] = KC[((size_t)b * NCMP + (idx >> 6)) * 64 + (idx & 63)];
        __syncthreads();
        for (int tt = wave; tt < 128; tt += NWAVE) {
            const int m = m0 + tt, t = t0 + tt;
            const f16* zr = Z + (size_t)m * ZP;
            float q[4];
            const float cs = RC[(size_t)m * 8 + (lane & 7)], sn = RS[(size_t)m * 8 + (lane & 7)];
#pragma unroll
            for (int h = 0; h < 4; ++h) {
                q[h] = (float)zr[ZC_NQ + 64 * h + lane]; qs[h * 64 + lane] = q[h];
                const float pr = __shfl_xor(q[h], 8);
                float r = q[h];
                if (lane < 8) r = q[h] * cs - pr * sn; else if (lane < 16) r = q[h] * cs + pr * sn;
                qr[h * 64 + lane] = r;
            }
            WAVE_LDS_SYNC();
            int ncv = t >= 31 ? (t - 31) / 16 + 1 : 0; if (ncv > NCMP) ncv = NCMP;
            float sc[4][4];
#pragma unroll
            for (int h = 0; h < 4; ++h)
#pragma unroll
                for (int r = 0; r < 4; ++r) sc[h][r] = 0.f;
            for (int d = 0; d < 64; ++d) {
                float kv[4];
#pragma unroll
                for (int r = 0; r < 4; ++r) { const int i = lane + 64 * r; kv[r] = (i < ncv) ? kcs[i * 65 + d] : 0.f; }
#pragma unroll
                for (int h = 0; h < 4; ++h) { const float qv = qs[h * 64 + d];
#pragma unroll
                    for (int r = 0; r < 4; ++r) sc[h][r] += qv * kv[r]; }
            }
#pragma unroll
            for (int h = 0; h < 4; ++h) {
                float mx = NEG;
#pragma unroll
                for (int r = 0; r < 4; ++r) { const int i = lane + 64 * r; sc[h][r] = (i < ncv) ? sc[h][r] * 0.125f : NEG; mx = fmaxf(mx, sc[h][r]); }
                mx = wave_max(mx);
                float e[4], sum = 0.f;
#pragma unroll
                for (int r = 0; r < 4; ++r) { const int i = lane + 64 * r; e[r] = (i < ncv) ? expf(sc[h][r] - mx) : 0.f; sum += e[r]; }
                sum = wave_sum(sum);
                const float inv = ncv > 0 ? 1.f / sum : 0.f;
#pragma unroll
                for (int r = 0; r < 4; ++r) Pc[h * 256 + lane + 64 * r] = e[r] * inv;
            }
            WAVE_LDS_SYNC();
            float ocmp[4] = {0.f, 0.f, 0.f, 0.f};
            for (int i = 0; i < ncv; ++i) { const float vv = VC[((size_t)b * NCMP + i) * 64 + lane];
#pragma unroll
                for (int h = 0; h < 4; ++h) ocmp[h] += Pc[h * 256 + i] * vv; }
            float pslc = 0.f;
#pragma unroll
            for (int h = 0; h < 4; ++h) {
                const LAS float* P = Pc + h * 256 + 4 * lane;
                pslc += (lane > 0 ? P[-1] : 0.f) + 2.f * P[0] + 2.f * P[1] + 2.f * P[2] + P[3];
            }
            const int cur = t >> 6;
            const bool forced = (lane < 1) || (cur - lane >= 0 && cur - lane < 2);
            const float score = (lane <= cur) ? pslc + (forced ? 1e4f : 0.f) : -1e30f;
            int rank = 0;
            for (int jj = 0; jj < 64; ++jj) { const float o = __shfl(score, jj); rank += (o > score || (o == score && jj < lane)) ? 1 : 0; }
            const unsigned long long selmask = __ballot(rank < 16);
            float osel[4] = {0.f, 0.f, 0.f, 0.f}, msel[4] = {NEG, NEG, NEG, NEG}, lsel[4] = {0.f, 0.f, 0.f, 0.f};
            float owin[4] = {0.f, 0.f, 0.f, 0.f}, mwin[4] = {NEG, NEG, NEG, NEG}, lwin[4] = {0.f, 0.f, 0.f, 0.f};
#define NSA_ATTEND(KR, VCOL, KP0, OO, MM, LL) do { \
                const int kp0_ = (KP0); const int kp = kp0_ + lane; const bool valid = kp >= 0 && kp <= t; \
                float s[4] = {0.f, 0.f, 0.f, 0.f}; \
                if (valid) { const f16* kr = (KR) + ((size_t)b * S + kp) * 64; \
                    _Pragma("unroll") for (int d8 = 0; d8 < 8; ++d8) { const f16x8 kv8 = *(const f16x8*)(kr + 8 * d8); \
                        _Pragma("unroll") for (int e = 0; e < 8; ++e) { const float kd = (float)kv8[e]; \
                            _Pragma("unroll") for (int h = 0; h < 4; ++h) s[h] += qr[h * 64 + d8 * 8 + e] * kd; } } } \
                _Pragma("unroll") for (int h = 0; h < 4; ++h) { \
                    const float sv = valid ? s[h] * 0.125f : NEG; \
                    const float mn = fmaxf(MM[h], wave_max(sv)); \
                    const float corr = (MM[h] == NEG) ? 0.f : expf(MM[h] - mn); \
                    const float p = valid ? expf(sv - mn) : 0.f; \
                    LL[h] = LL[h] * corr + wave_sum(p); OO[h] *= corr; MM[h] = mn; \
                    pS[h * 64 + lane] = p; } \
                WAVE_LDS_SYNC(); \
                for (int k = 0; k < 64; ++k) { const int kpk = kp0_ + k; if (kpk < 0 || kpk > t) continue; \
                    const float vv = (float)Z[((size_t)b * S + kpk) * ZP + (VCOL) + lane]; \
                    _Pragma("unroll") for (int h = 0; h < 4; ++h) OO[h] += pS[h * 64 + k] * vv; } \
                WAVE_LDS_SYNC(); } while (0)
            for (int jb = 0; jb <= cur; ++jb) { if (!((selmask >> jb) & 1ull)) continue; NSA_ATTEND(KSR, ZC_VSLC, 64 * jb, osel, msel, lsel); }
            for (int jb = 0; jb < 8; ++jb) { const int kpw = t - 511 + 64 * jb; if (kpw + 63 < 0) continue; NSA_ATTEND(KWR, ZC_VWIN, kpw, owin, mwin, lwin); }
#undef NSA_ATTEND
            float o[4]; float ss = 0.f;
#pragma unroll
            for (int h = 0; h < 4; ++h) {
                const float g0 = sigmoidf_((float)zr[ZC_NG + 3 * h + 0]), g1 = sigmoidf_((float)zr[ZC_NG + 3 * h + 1]), g2 = sigmoidf_((float)zr[ZC_NG + 3 * h + 2]);
                o[h] = g0 * ocmp[h] + g1 * (osel[h] / lsel[h]) + g2 * (owin[h] / lwin[h]);
                ss += o[h] * o[h];
            }
            const float r = rsqrtf(wave_sum(ss) * (1.f / 256) + EPS);
#pragma unroll
            for (int h = 0; h < 4; ++h) MIX[(size_t)m * D + 256 + 64 * h + lane] = (f16)(o[h] * r * gain[64 * h + lane]);
            WAVE_LDS_SYNC();
        }
    }
}
__device__ __forceinline__ void ph_gla1(const Ctx& C, int l, int bid, int nblk) {
    const f16* Z = (const f16*)(C.ws + WS_Z); float* LA = (float*)(C.ws + WS_LA);
    const float* w2 = C.in[8] + (size_t)l * 16 * 128; const float* gb = C.in[9] + (size_t)l * 128;
    for (int idx = bid * NT + threadIdx.x; idx < M * 128; idx += nblk * NT) {
        const int dim = idx & 127, m = idx >> 7;
        const f16* lr = Z + (size_t)m * ZP + ZC_LR;
        float a = gb[dim];
#pragma unroll
        for (int r = 0; r < 16; ++r) a += (float)lr[r] * w2[r * 128 + dim];
        const float ls = fminf(a, 0.f) - log1pf(expf(-fabsf(a)));
        LA[idx] = ls * (1.f / 16.f);
    }
}
__device__ __forceinline__ void ph_gla2(const Ctx& C, int bid, int nblk) {
    float* LA = (float*)(C.ws + WS_LA);
    const int total = (M / 64) * 128;
    for (int idx = bid * NT + threadIdx.x; idx < total; idx += nblk * NT) {
        const int dim = idx & 127, ch = idx >> 7;
        float run = 0.f;
        for (int tt = 0; tt < 64; ++tt) { float* p = LA + ((size_t)ch * 64 + tt) * 128 + dim; run += *p; *p = run; }
    }
}
__device__ __forceinline__ void ph_gla3(const Ctx& C, int bid, int nblk, LAS float* lds) {
    const f16* Z = (const f16*)(C.ws + WS_Z); const float* Bc = (const float*)(C.ws + WS_LA);
    float* QE2 = (float*)(C.ws + WS_QE2); float* OI = (float*)(C.ws + WS_OI); float* KV = (float*)(C.ws + WS_KV);
    LAS float* qe = lds; LAS float* ke = lds + 2112; LAS float* k2 = lds + 4224; LAS float* vs = lds + 6336; LAS float* att = lds + 10432;
    const int tid = threadIdx.x;
    for (int item = bid; item < NB * 4 * 64; item += nblk) {
        const int n = item & 63, h = (item >> 6) & 3, b = item >> 8;
        const size_t m0 = (size_t)b * S + n * 64;
        __syncthreads();
        for (int idx = tid; idx < 2048; idx += NT) {
            const int tt = idx >> 5, d = idx & 31;
            const float bb = Bc[(m0 + tt) * 128 + 32 * h + d], bmid = Bc[(m0 + 32) * 128 + 32 * h + d], blast = Bc[(m0 + 63) * 128 + 32 * h + d];
            const float qv = (float)Z[(m0 + tt) * ZP + ZC_LQ + 32 * h + d] * 0.17677669529663687f, kv = (float)Z[(m0 + tt) * ZP + ZC_LK + 32 * h + d];
            qe[tt * 33 + d] = qv * expf(bb - bmid); ke[tt * 33 + d] = kv * expf(bmid - bb); k2[tt * 33 + d] = kv * expf(blast - bb);
            QE2[(m0 + tt) * 128 + 32 * h + d] = qv * expf(bb);
        }
        for (int idx = tid; idx < 4096; idx += NT) { const int tt = idx >> 6, v = idx & 63; vs[idx] = (float)Z[(m0 + tt) * ZP + ZC_LV + 64 * h + v]; }
        __syncthreads();
        for (int idx = tid; idx < 4096; idx += NT) {
            const int tt = idx >> 6, s = idx & 63; float a = 0.f;
            if (s <= tt) { for (int d = 0; d < 32; ++d) a += qe[tt * 33 + d] * ke[s * 33 + d]; }
            att[tt * 65 + s] = a;
        }
        __syncthreads();
        for (int idx = tid; idx < 4096; idx += NT) {
            const int tt = idx >> 6, v = idx & 63; float o = 0.f;
            for (int s = 0; s <= tt; ++s) o += att[tt * 65 + s] * vs[s * 64 + v];
            OI[(m0 + tt) * 256 + 64 * h + v] = o;
        }
        for (int idx = tid; idx < 2048; idx += NT) {
            const int d = idx >> 6, v = idx & 63; float a = 0.f;
            for (int s = 0; s < 64; ++s) a += k2[s * 33 + d] * vs[s * 64 + v];
            KV[(size_t)item * 2048 + idx] = a;
        }
    }
}
__device__ __forceinline__ void ph_gla4(const Ctx& C, int bid, int nblk) {
    const float* Bc = (const float*)(C.ws + WS_LA); const float* KV = (const float*)(C.ws + WS_KV); float* SP = (float*)(C.ws + WS_SPREV);
    for (int idx = bid * NT + threadIdx.x; idx < NB * 4 * 2048; idx += nblk * NT) {
        const int dv = idx & 2047, bh = idx >> 11, d = dv >> 6, h = bh & 3, b = bh >> 2;
        float st = 0.f;
        for (int n = 0; n < 64; ++n) {
            SP[((size_t)bh * 64 + n) * 2048 + dv] = st;
            const float dec = expf(Bc[((size_t)b * S + n * 64 + 63) * 128 + 32 * h + d]);
            st = dec * st + KV[((size_t)bh * 64 + n) * 2048 + dv];
        }
    }
}
__device__ __forceinline__ void ph_gla5(const Ctx& C, int l, int bid, int nblk) {
    const f16* Z = (const f16*)(C.ws + WS_Z); f16* MIX = (f16*)(C.ws + WS_MIX);
    const float* QE2 = (const float*)(C.ws + WS_QE2); const float* OI = (const float*)(C.ws + WS_OI); const float* SP = (const float*)(C.ws + WS_SPREV);
    const float* gain = C.in[12] + (size_t)l * D + 512;
    const int lane = threadIdx.x & 63, gw = bid * NWAVE + (threadIdx.x >> 6), ngw = nblk * NWAVE;
    for (int m = gw; m < M; m += ngw) {
        const int b = m / S, t = m % S, n = t >> 6;
        float og[4]; float ss = 0.f;
#pragma unroll
        for (int h = 0; h < 4; ++h) {
            float o = OI[(size_t)m * 256 + 64 * h + lane];
            const float* sp = SP + ((size_t)(b * 4 + h) * 64 + n) * 2048 + lane; const float* qe = QE2 + (size_t)m * 128 + 32 * h;
            for (int d = 0; d < 32; ++d) o += qe[d] * sp[d * 64];
            const float ms = wave_sum(o * o) * (1.f / 64);
            const float gv = (float)Z[(size_t)m * ZP + ZC_LG + 64 * h + lane];
            og[h] = siluf(gv) * (o * rsqrtf(ms + EPS)); ss += og[h] * og[h];
        }
        const float r = rsqrtf(wave_sum(ss) * (1.f / 256) + EPS);
#pragma unroll
        for (int h = 0; h < 4; ++h) MIX[(size_t)m * D + 512 + 64 * h + lane] = (f16)(og[h] * r * gain[64 * h + lane]);
    }
}
__device__ __forceinline__ void ph_gmlp1(const Ctx& C, int bid, int nblk) {
    const f16* Z = (const f16*)(C.ws + WS_Z); float* VN = (float*)(C.ws + WS_VN);
    const int lane = threadIdx.x & 63, gw = bid * NWAVE + (threadIdx.x >> 6), ngw = nblk * NWAVE;
    for (int m = gw; m < M; m += ngw) {
#pragma unroll
        for (int g = 0; g < 4; ++g) {
            const float v = (float)Z[(size_t)m * ZP + ZC_MV + 64 * g + lane];
            const float mu = wave_sum(v) * (1.f / 64), dv = v - mu, var = wave_sum(dv * dv) * (1.f / 64);
            VN[(size_t)m * 256 + 64 * g + lane] = dv * rsqrtf(var + EPS);
        }
    }
}
__device__ __forceinline__ void ph_gmlp2(const Ctx& C, int l, int bid, int nblk) {
    const f16* Z = (const f16*)(C.ws + WS_Z); f16* MIX = (f16*)(C.ws + WS_MIX); const float* VN = (const float*)(C.ws + WS_VN);
    const float* ws_ = C.in[10] + (size_t)l * 4 * 128 * 128; const float* bs = C.in[11] + (size_t)l * 4 * 128; const float* gain = C.in[12] + (size_t)l * D + 768;
    const int lane = threadIdx.x & 63, gw = bid * NWAVE + (threadIdx.x >> 6), ngw = nblk * NWAVE;
    for (int m = gw; m < M; m += ngw) {
        const int tp = m & 127; const size_t mc = (size_t)(m - tp);
        float o[4]; float ss = 0.f;
#pragma unroll
        for (int g = 0; g < 4; ++g) {
            const float* w = ws_ + ((size_t)g * 128 + tp) * 128; float acc = 0.f;
            for (int s = 0; s <= tp; ++s) acc += w[s] * VN[(mc + s) * 256 + 64 * g + lane];
            o[g] = (float)Z[(size_t)m * ZP + ZC_MU + 64 * g + lane] * (acc + bs[g * 128 + tp]); ss += o[g] * o[g];
        }
        const float r = rsqrtf(wave_sum(ss) * (1.f / 256) + EPS);
#pragma unroll
        for (int g = 0; g < 4; ++g) MIX[(size_t)m * D + 768 + 64 * g + lane] = (f16)(o[g] * r * gain[64 * g + lane]);
    }
}

template <int PH>
__global__ void __launch_bounds__(NT, 2) k_phase(Ctx C) {
    extern __shared__ __attribute__((aligned(16))) unsigned char lds_raw[];
    LAS float* lds = (LAS float*)lds_raw;
    const int bid = blockIdx.x, nblk = gridDim.x, l = C.lo;
    f16* H = (f16*)(C.ws + WS_H); f16* Zb = (f16*)(C.ws + WS_Z); f16* MIX = (f16*)(C.ws + WS_MIX); f16* Y = (f16*)(C.ws + WS_Y); f16* U = (f16*)(C.ws + WS_BIG);
    if constexpr (PH == 0) { ph_mod(C, bid, nblk); ph_rope(C, bid, nblk); }
    if constexpr (PH == 1) { ph_norm0(C, bid, nblk); }
    if constexpr (PH == 2) gemm_naive<0, true>(H, C.in[3] + (size_t)l * D * NIN, NIN, D, Zb, ZP, bid, nblk, lds);
    if constexpr (PH == 3) { ph_conv(C, l, bid, nblk); ph_rotk(C, bid, nblk); ph_cmp1(C, l, bid, nblk); ph_gla1(C, l, bid, nblk); ph_gmlp1(C, bid, nblk); }
    if constexpr (PH == 4) { ph_cmp2(C, l, bid, nblk); ph_gla2(C, bid, nblk); ph_gmlp2(C, l, bid, nblk); }
    if constexpr (PH == 5) { ph_nsa(C, l, bid, nblk, lds); }
    if constexpr (PH == 12) { ph_gla3(C, bid, nblk, lds); }
    if constexpr (PH == 6) ph_gla4(C, bid, nblk);
    if constexpr (PH == 7) ph_gla5(C, l, bid, nblk);
    if constexpr (PH == 8) gemm_naive<0, false>(MIX, C.in[13] + (size_t)l * D * D, D, D, Y, D, bid, nblk, lds);
    if constexpr (PH == 9) ph_resnorm(C, l, 0, bid, nblk);
    if constexpr (PH == 10) gemm_naive<1, false>(H, C.in[17] + (size_t)l * D * DFF, DFF, D, U, DFF, bid, nblk, lds);
    if constexpr (PH == 11) gemm_naive<0, false>(U, C.in[18] + (size_t)l * DFF * D, D, DFF, Y, D, bid, nblk, lds);
    if constexpr (PH == 13) ph_resnorm(C, l, 1, bid, nblk);
}
template <int PH> static void launch_phase(Ctx c, int l, hipStream_t stream) {
    static bool attr = false;
    if (!attr) { (void)hipFuncSetAttribute((const void*)k_phase<PH>, hipFuncAttributeMaxDynamicSharedMemorySize, LDS_BYTES); attr = true; }
    c.lo = l; c.hi = 0;
    hipLaunchKernelGGL(k_phase<PH>, dim3(256), dim3(NT), LDS_BYTES, stream, c);
}

extern "C" void kernel_launch(void* const* d_in, const int* in_sizes, int n_in, void* d_out, int out_size, void* d_ws, size_t ws_size, hipStream_t stream) {
    if (n_in != 19 || ws_size < WS_END) { fprintf(stderr, "kernel_launch: unexpected n_in %d / ws_size %zu\n", n_in, ws_size); return; }
    Ctx c{};
    for (int i = 0; i < 19; ++i) c.in[i] = (const float*)d_in[i];
    c.out = (float*)d_out; c.ws = (unsigned char*)d_ws;
    launch_phase<0>(c, 0, stream);
    launch_phase<1>(c, 0, stream);
    for (int l = 0; l < DEPTH; ++l) {
        launch_phase<2>(c, l, stream); launch_phase<3>(c, l, stream); launch_phase<4>(c, l, stream); launch_phase<5>(c, l, stream); launch_phase<12>(c, l, stream);
        launch_phase<6>(c, l, stream); launch_phase<7>(c, l, stream); launch_phase<8>(c, l, stream); launch_phase<9>(c, l, stream);
        launch_phase<10>(c, l, stream); launch_phase<11>(c, l, stream); launch_phase<13>(c, l, stream);
    }
}
```

```cpp
#include <hip/hip_runtime.h>
#include <cstdint>
#include <cstdio>

#define LAS __attribute__((address_space(3)))
typedef _Float16 f16;
typedef f16 f16x4 __attribute__((ext_vector_type(4)));
typedef f16 f16x8 __attribute__((ext_vector_type(8)));
typedef float f32x4 __attribute__((ext_vector_type(4)));

constexpr int D = 1024, NB = 8, S = 4096, DEPTH = 4, M = NB * S, DFF = 4096;
constexpr int NIN = 2716, ZP = 2816;
constexpr int ZC_AH = 0, ZC_AB = 256, ZC_AC = 512, ZC_NQ = 768, ZC_KCMP = 1024, ZC_VCMP = 1088, ZC_KSLC = 1152, ZC_VSLC = 1216,
              ZC_KWIN = 1280, ZC_VWIN = 1344, ZC_NG = 1408, ZC_LQ = 1424, ZC_LK = 1552, ZC_LV = 1680, ZC_LG = 1936, ZC_LR = 2192,
              ZC_MU = 2208, ZC_MV = 2464;
constexpr int NCMP = 255;
constexpr float EPS = 1e-6f;
constexpr int NT = 512, NWAVE = 8;

constexpr size_t MiB = 1u << 20;
constexpr size_t WS_CTL = 0;
constexpr size_t WS_MOD = 1 * MiB;
constexpr size_t WS_ROPE = 2 * MiB;
constexpr size_t WS_W16 = 4 * MiB;
constexpr size_t WS_H = 98 * MiB;
constexpr size_t WS_Y = 162 * MiB;
constexpr size_t WS_BIG = 226 * MiB;
constexpr size_t WS_Z = WS_BIG;
constexpr size_t WS_MIX = WS_BIG + 176 * MiB;
constexpr size_t WS_KSR = WS_BIG + 240 * MiB;
constexpr size_t WS_KWR = WS_BIG + 244 * MiB;
constexpr size_t WS_HID = WS_BIG + 248 * MiB;
constexpr size_t WS_KC = WS_BIG + 251 * MiB;
constexpr size_t WS_VC = WS_BIG + 252 * MiB;
constexpr size_t WS_END = 482 * MiB;
constexpr size_t WS_LA = WS_H;
constexpr size_t WS_QE2 = WS_H + 16 * MiB;
constexpr size_t WS_OI = WS_H + 32 * MiB;
constexpr size_t WS_KV = WS_Y;
constexpr size_t WS_SPREV = WS_Y + 16 * MiB;
constexpr size_t WS_VN = WS_Y + 32 * MiB;

constexpr int LDS_BYTES = 147456;

struct Ctx {
    const float* in[19];
    float* out;
    unsigned char* ws;
    int lo, hi;
};

__device__ __forceinline__ float wave_sum(float v) {
#pragma unroll
    for (int o = 32; o > 0; o >>= 1) v += __shfl_xor(v, o);
    return v;
}
__device__ __forceinline__ float wave_max(float v) {
#pragma unroll
    for (int o = 32; o > 0; o >>= 1) v = fmaxf(v, __shfl_xor(v, o));
    return v;
}
#define WAVE_LDS_SYNC() asm volatile("s_waitcnt lgkmcnt(0)" ::: "memory")
__device__ __forceinline__ float siluf(float v) { return v / (1.f + expf(-v)); }
__device__ __forceinline__ float sigmoidf_(float v) { return 1.f / (1.f + expf(-v)); }

__device__ __forceinline__ void sincos_d(double a, double& s, double& c) {
    const double two_over_pi = 0.63661977236758134308, pio2_hi = 1.57079632679489655800e+00, pio2_lo = 6.12323399573676603587e-17;
    const double kq = rint(a * two_over_pi);
    double r = (a - kq * pio2_hi) - kq * pio2_lo;
    const double r2 = r * r;
    double sp = r * (1.0 + r2 * (-1.0 / 6 + r2 * (1.0 / 120 + r2 * (-1.0 / 5040 + r2 * (1.0 / 362880 + r2 * (-1.0 / 39916800 + r2 * (1.0 / 6227020800.0 + r2 * (-1.0 / 1307674368000.0))))))));
    double cp = 1.0 + r2 * (-0.5 + r2 * (1.0 / 24 + r2 * (-1.0 / 720 + r2 * (1.0 / 40320 + r2 * (-1.0 / 3628800 + r2 * (1.0 / 479001600.0 + r2 * (-1.0 / 87178291200.0 + r2 * (1.0 / 20922789888000.0))))))));
    const int q = ((int)kq) & 3;
    if (q == 0) { s = sp; c = cp; } else if (q == 1) { s = cp; c = -sp; } else if (q == 2) { s = -sp; c = -cp; } else { s = -cp; c = sp; }
}

__device__ __forceinline__ void ph_mod(const Ctx& C, int TID, int bid, int nblk) {
    const float* c = C.in[1]; const float* w_mod = C.in[15]; const float* b_mod = C.in[16];
    float* MOD = (float*)(C.ws + WS_MOD);
    const int total = DEPTH * NB * 6 * D;
    for (int idx = bid * NT + TID; idx < total; idx += nblk * NT) {
        const int n = idx % (6 * D), bb = (idx / (6 * D)) % NB, l = idx / (6 * D * NB);
        float acc = b_mod[l * 6 * D + n];
        const float* w = w_mod + (size_t)l * D * 6 * D + n;
        for (int k = 0; k < D; ++k) { const float cv = c[bb * D + k]; acc += siluf(cv) * w[(size_t)k * 6 * D]; }
        MOD[idx] = acc;
    }
}
__device__ __forceinline__ void ph_rope(const Ctx& C, int TID, int bid, int nblk) {
    const int* pos = (const int*)C.in[2];
    float* RC = (float*)(C.ws + WS_ROPE); float* RS = RC + (size_t)M * 8;
    const double invf[8] = {1.0, 0.19392274474868576, 0.03760603093086393, 0.007292664737217109, 0.001414213562373095, 0.0002742481756762073, 5.318295896944988e-05, 1.031338537721246e-05};
    for (int idx = bid * NT + TID; idx < M * 8; idx += nblk * NT) {
        const int i = idx & 7, m = idx >> 3;
        double f = invf[0];
#pragma unroll
        for (int j = 1; j < 8; ++j) f = (i == j) ? invf[j] : f;
        double s, c; sincos_d((double)pos[m] * f, s, c);
        RC[idx] = (float)c; RS[idx] = (float)s;
    }
}
__device__ __forceinline__ void adaln_row(const float (&xv)[16], const float* g, const float* sc, const float* sh, f16* hrow, int lane) {
    float ss = 0.f;
#pragma unroll
    for (int j = 0; j < 16; ++j) ss += xv[j] * xv[j];
    const float r = rsqrtf(wave_sum(ss) * (1.f / D) + EPS);
#pragma unroll
    for (int j = 0; j < 4; ++j) {
        const int c0 = 256 * j + 4 * lane;
        const f32x4 gv = *(const f32x4*)(g + c0), scv = *(const f32x4*)(sc + c0), shv = *(const f32x4*)(sh + c0);
        f16x4 o;
#pragma unroll
        for (int e = 0; e < 4; ++e) o[e] = (f16)(xv[4 * j + e] * r * gv[e] * (1.f + scv[e]) + shv[e]);
        *(f16x4*)(hrow + c0) = o;
    }
}
__device__ __forceinline__ void ph_norm0(const Ctx& C, int TID, int bid, int nblk) {
    const float* x = C.in[0]; const float* norm_g = C.in[14]; const float* MOD = (const float*)(C.ws + WS_MOD);
    f16* H = (f16*)(C.ws + WS_H);
    const int lane = TID & 63, gw = bid * NWAVE + (TID >> 6), ngw = nblk * NWAVE;
    for (int m = gw; m < M; m += ngw) {
        const int b = m / S;
        float xv[16];
#pragma unroll
        for (int j = 0; j < 4; ++j) { const f32x4 v = *(const f32x4*)(x + (size_t)m * D + 256 * j + 4 * lane); xv[4 * j] = v[0]; xv[4 * j + 1] = v[1]; xv[4 * j + 2] = v[2]; xv[4 * j + 3] = v[3]; }
        const float* mod = MOD + (size_t)(0 * NB + b) * 6 * D;
        adaln_row(xv, norm_g + 0, mod + D, mod + 0, H + (size_t)m * D, lane);
    }
}
__device__ __forceinline__ void ph_resnorm(const Ctx& C, int l, int sub, int TID, int bid, int nblk) {
    const float* norm_g = C.in[14]; const float* MOD = (const float*)(C.ws + WS_MOD);
    const f16* Y = (const f16*)(C.ws + WS_Y); f16* H = (f16*)(C.ws + WS_H);
    const float* xsrc = (l == 0 && sub == 0) ? C.in[0] : C.out;
    const float* ga = norm_g + (size_t)(l * 4 + (sub == 0 ? 1 : 3)) * D;
    const bool has_next = !(l == DEPTH - 1 && sub == 1);
    const int ln = sub == 0 ? l : l + 1;
    const float* gb = norm_g + (size_t)((has_next ? ln : 0) * 4 + (sub == 0 ? 2 : 0)) * D;
    const int lane = TID & 63, gw = bid * NWAVE + (TID >> 6), ngw = nblk * NWAVE;
    for (int m = gw; m < M; m += ngw) {
        const int b = m / S;
        const float* mod = MOD + (size_t)(l * NB + b) * 6 * D;
        const float* gt = mod + (sub == 0 ? 2 : 5) * D;
        float yv[16], xv[16]; float ss = 0.f;
#pragma unroll
        for (int j = 0; j < 4; ++j) {
            const f16x4 v = *(const f16x4*)(Y + (size_t)m * D + 256 * j + 4 * lane);
#pragma unroll
            for (int e = 0; e < 4; ++e) { yv[4 * j + e] = (float)v[e]; ss += yv[4 * j + e] * yv[4 * j + e]; }
        }
        const float r = rsqrtf(wave_sum(ss) * (1.f / D) + EPS);
#pragma unroll
        for (int j = 0; j < 4; ++j) {
            const int c0 = 256 * j + 4 * lane;
            const f32x4 xo = *(const f32x4*)(xsrc + (size_t)m * D + c0), gav = *(const f32x4*)(ga + c0), gtv = *(const f32x4*)(gt + c0);
            f32x4 xn;
#pragma unroll
            for (int e = 0; e < 4; ++e) { xn[e] = xo[e] + gtv[e] * (yv[4 * j + e] * r * gav[e]); xv[4 * j + e] = xn[e]; }
            *(f32x4*)(C.out + (size_t)m * D + c0) = xn;
        }
        if (has_next) {
            const float* modn = MOD + (size_t)(ln * NB + b) * 6 * D;
            adaln_row(xv, gb, modn + (sub == 0 ? 4 : 1) * D, modn + (sub == 0 ? 3 : 0) * D, H + (size_t)m * D, lane);
        }
    }
}

template <int ACT, bool REMAP>
__device__ __forceinline__ void gemm_naive(const f16* A, const float* W, int N, int K, f16* O, int ldc, int TID, int bid, int nblk, LAS float* lds) {
    LAS float* As = lds;
    LAS float* Bs = lds + 16 * 132;
    const int tid = TID, tx = tid & 15, ty = tid >> 4;
    const int ntn = (N + 127) / 128, ntm = M / 128;
    for (int tile = bid; tile < ntm * ntn; tile += nblk) {
        const int tm = tile / ntn, tn = tile % ntn, m0 = tm * 128, n0 = tn * 128;
        float acc[4][8];
#pragma unroll
        for (int i = 0; i < 4; ++i)
#pragma unroll
            for (int j = 0; j < 8; ++j) acc[i][j] = 0.f;
        for (int k0 = 0; k0 < K; k0 += 16) {
            {
                const f16x4 v = *(const f16x4*)(A + (size_t)(m0 + (tid >> 2)) * K + k0 + (tid & 3) * 4);
#pragma unroll
                for (int j = 0; j < 4; ++j) As[((tid & 3) * 4 + j) * 132 + (tid >> 2)] = (float)v[j];
                const int k = tid >> 5, n = n0 + (tid & 31) * 4;
                f32x4 w = {0.f, 0.f, 0.f, 0.f};
                if (n < N) w = *(const f32x4*)(W + (size_t)(k0 + k) * N + n);
                *(LAS f32x4*)(Bs + k * 128 + (tid & 31) * 4) = w;
            }
            __syncthreads();
#pragma unroll
            for (int kk = 0; kk < 16; ++kk) {
                const f32x4 a = *(const LAS f32x4*)(As + kk * 132 + ty * 4);
                const f32x4 b0 = *(const LAS f32x4*)(Bs + kk * 128 + tx * 8), b1 = *(const LAS f32x4*)(Bs + kk * 128 + tx * 8 + 4);
#pragma unroll
                for (int i = 0; i < 4; ++i) {
#pragma unroll
                    for (int j = 0; j < 4; ++j) { acc[i][j] += a[i] * b0[j]; acc[i][4 + j] += a[i] * b1[j]; }
                }
            }
            __syncthreads();
        }
#pragma unroll
        for (int i = 0; i < 4; ++i)
#pragma unroll
            for (int j = 0; j < 8; ++j) {
                const int n = n0 + tx * 8 + j;
                if (n < N) {
                    float v = acc[i][j];
                    if (ACT == 1) v = v > 0.f ? v * v : 0.f;
                    const int nc = REMAP ? n + (n >= 1420 ? 4 : 0) : n;
                    O[(size_t)(m0 + ty * 4 + i) * ldc + nc] = (f16)v;
                }
            }
    }
}

__device__ __forceinline__ void ph_conv(const Ctx& C, int l, int TID, int bid, int nblk) {
    const f16* Z = (const f16*)(C.ws + WS_Z); f16* MIX = (f16*)(C.ws + WS_MIX);
    const float* cw = C.in[4] + (size_t)l * 3 * 256; const float* gain = C.in[12] + (size_t)l * D;
    const int lane = TID & 63, gw = bid * NWAVE + (TID >> 6), ngw = nblk * NWAVE;
    for (int m = gw; m < M; m += ngw) {
        const int t = m % S;
        float o[4]; float ss = 0.f;
#pragma unroll
        for (int j = 0; j < 4; ++j) {
            const int ch = lane + 64 * j; float y = 0.f;
#pragma unroll
            for (int k = 0; k < 3; ++k) {
                const int tt = t - 2 + k;
                if (tt >= 0) { const f16* zr = Z + (size_t)(m - 2 + k) * ZP; y += (float)zr[ZC_AC + ch] * (float)zr[ZC_AH + ch] * cw[k * 256 + ch]; }
            }
            o[j] = (float)Z[(size_t)m * ZP + ZC_AB + ch] * y; ss += o[j] * o[j];
        }
        const float r = rsqrtf(wave_sum(ss) * (1.f / 256) + EPS);
#pragma unroll
        for (int j = 0; j < 4; ++j) { const int ch = lane + 64 * j; MIX[(size_t)m * D + ch] = (f16)(o[j] * r * gain[ch]); }
    }
}
__device__ __forceinline__ void ph_rotk(const Ctx& C, int TID, int bid, int nblk) {
    const f16* Z = (const f16*)(C.ws + WS_Z); f16* KSR = (f16*)(C.ws + WS_KSR); f16* KWR = (f16*)(C.ws + WS_KWR);
    const float* RC = (const float*)(C.ws + WS_ROPE); const float* RS = RC + (size_t)M * 8;
    for (int idx = bid * NT + TID; idx < M * 128; idx += nblk * NT) {
        const int d = idx & 63, which = (idx >> 6) & 1, m = idx >> 7;
        const f16* zr = Z + (size_t)m * ZP + (which ? ZC_KWIN : ZC_KSLC);
        float v = (float)zr[d];
        if (d < 16) { const int i = d & 7; const float cs = RC[m * 8 + i], sn = RS[m * 8 + i];
            if (d < 8) v = v * cs - (float)zr[d + 8] * sn; else v = v * cs + (float)zr[d - 8] * sn; }
        (which ? KWR : KSR)[(size_t)m * 64 + d] = (f16)v;
    }
}
__device__ __forceinline__ void ph_cmp1(const Ctx& C, int l, int TID, int bid, int nblk) {
    const f16* Z = (const f16*)(C.ws + WS_Z); float* HID = (float*)(C.ws + WS_HID);
    const float* cpos = C.in[5] + (size_t)l * 2 * 32 * 64; const float* w1 = C.in[6] + (size_t)l * 2 * 2048 * 128;
    const int total = 2 * NB * NCMP * 128;
    for (int idx = bid * NT + TID; idx < total; idx += nblk * NT) {
        const int o = idx & 127, i = (idx >> 7) % NCMP, b = ((idx >> 7) / NCMP) % NB, j = (idx >> 7) / (NCMP * NB);
        const float* w = w1 + (size_t)j * 2048 * 128 + o; const float* pp = cpos + j * 2048;
        const f16* zb = Z + (size_t)(b * S + 16 * i) * ZP + (j ? ZC_VCMP : ZC_KCMP);
        float acc = 0.f;
        for (int p = 0; p < 32; ++p)
            for (int d = 0; d < 64; ++d) acc += ((float)zb[(size_t)p * ZP + d] + pp[p * 64 + d]) * w[(size_t)(p * 64 + d) * 128];
        HID[idx] = siluf(acc);
    }
}
__device__ __forceinline__ void ph_cmp2(const Ctx& C, int l, int TID, int bid, int nblk) {
    const float* HID = (const float*)(C.ws + WS_HID); float* KC = (float*)(C.ws + WS_KC); float* VC = (float*)(C.ws + WS_VC);
    const float* w2 = C.in[7] + (size_t)l * 2 * 128 * 64;
    const int total = 2 * NB * NCMP * 64;
    for (int idx = bid * NT + TID; idx < total; idx += nblk * NT) {
        const int d = idx & 63, bi = (idx >> 6) % (NB * NCMP), j = (idx >> 6) / (NB * NCMP);
        const float* hrow = HID + ((size_t)j * NB * NCMP + bi) * 128; const float* w = w2 + (size_t)j * 128 * 64 + d;
        float acc = 0.f;
        for (int o = 0; o < 128; ++o) acc += hrow[o] * w[o * 64];
        (j ? VC : KC)[(size_t)bi * 64 + d] = acc;
    }
}
__device__ __forceinline__ void ph_nsa(const Ctx& C, int l, int TID, int bid, int nblk, LAS float* lds) {
    const f16* Z = (const f16*)(C.ws + WS_Z); f16* MIX = (f16*)(C.ws + WS_MIX);
    const f16* KSR = (const f16*)(C.ws + WS_KSR); const f16* KWR = (const f16*)(C.ws + WS_KWR);
    const float* KC = (const float*)(C.ws + WS_KC); const float* VC = (const float*)(C.ws + WS_VC);
    const float* RC = (const float*)(C.ws + WS_ROPE); const float* RS = RC + (size_t)M * 8;
    const float* gain = C.in[12] + (size_t)l * D + 256;
    const int tid = TID, lane = tid & 63, wave = tid >> 6;
    LAS float* kcs = lds;
    LAS float* wsb = lds + 16640 + wave * 1792;
    LAS float* Pc = wsb;
    LAS float* qs = wsb + 1024;
    LAS float* qr = wsb + 1280;
    LAS float* pS = wsb + 1536;
    const float NEG = -__builtin_inff();
    for (int item = bid; item < M / 128; item += nblk) {
        const int m0 = item * 128, b = m0 / S, t0 = m0 % S;
        const int nload = (t0 + 127 >= 31) ? ((t0 + 127 - 31) / 16 + 1 > NCMP ? NCMP : (t0 + 127 - 31) / 16 + 1) : 0;
        __syncthreads();
        for (int idx = tid; idx < nload * 64; idx += NT) kcs[(idx >> 6) * 65 + (idx & 63)] = KC[((size_t)b * NCMP + (idx >> 6)) * 64 + (idx & 63)];
        __syncthreads();
        for (int tt = wave; tt < 128; tt += NWAVE) {
            const int m = m0 + tt, t = t0 + tt;
            const f16* zr = Z + (size_t)m * ZP;
            float q[4];
            const float cs = RC[(size_t)m * 8 + (lane & 7)], sn = RS[(size_t)m * 8 + (lane & 7)];
#pragma unroll
            for (int h = 0; h < 4; ++h) {
                q[h] = (float)zr[ZC_NQ + 64 * h + lane]; qs[h * 64 + lane] = q[h];
                const float pr = __shfl_xor(q[h], 8);
                float r = q[h];
                if (lane < 8) r = q[h] * cs - pr * sn; else if (lane < 16) r = q[h] * cs + pr * sn;
                qr[h * 64 + lane] = r;
            }
            WAVE_LDS_SYNC();
            int ncv = t >= 31 ? (t - 31) / 16 + 1 : 0; if (ncv > NCMP) ncv = NCMP;
            float sc[4][4];
#pragma unroll
            for (int h = 0; h < 4; ++h)
#pragma unroll
                for (int r = 0; r < 4; ++r) sc[h][r] = 0.f;
            for (int d = 0; d < 64; ++d) {
                float kv[4];
#pragma unroll
                for (int r = 0; r < 4; ++r) { const int i = lane + 64 * r; kv[r] = (i < ncv) ? kcs[i * 65 + d] : 0.f; }
#pragma unroll
                for (int h = 0; h < 4; ++h) { const float qv = qs[h * 64 + d];
#pragma unroll
                    for (int r = 0; r < 4; ++r) sc[h][r] += qv * kv[r]; }
            }
#pragma unroll
            for (int h = 0; h < 4; ++h) {
                float mx = NEG;
#pragma unroll
                for (int r = 0; r < 4; ++r) { const int i = lane + 64 * r; sc[h][r] = (i < ncv) ? sc[h][r] * 0.125f : NEG; mx = fmaxf(mx, sc[h][r]); }
                mx = wave_max(mx);
                float e[4], sum = 0.f;
#pragma unroll
                for (int r = 0; r < 4; ++r) { const int i = lane + 64 * r; e[r] = (i < ncv) ? expf(sc[h][r] - mx) : 0.f; sum += e[r]; }
                sum = wave_sum(sum);
                const float inv = ncv > 0 ? 1.f / sum : 0.f;
#pragma unroll
                for (int r = 0; r < 4; ++r) Pc[h * 256 + lane + 64 * r] = e[r] * inv;
            }
            WAVE_LDS_SYNC();
            float ocmp[4] = {0.f, 0.f, 0.f, 0.f};
            for (int i = 0; i < ncv; ++i) { const float vv = VC[((size_t)b * NCMP + i) * 64 + lane];
#pragma unroll
                for (int h = 0; h < 4; ++h) ocmp[h] += Pc[h * 256 + i] * vv; }
            float pslc = 0.f;
#pragma unroll
            for (int h = 0; h < 4; ++h) {
                const LAS float* P = Pc + h * 256 + 4 * lane;
                pslc += (lane > 0 ? P[-1] : 0.f) + 2.f * P[0] + 2.f * P[1] + 2.f * P[2] + P[3];
            }
            const int cur = t >> 6;
            const bool forced = (lane < 1) || (cur - lane >= 0 && cur - lane < 2);
            const float score = (lane <= cur) ? pslc + (forced ? 1e4f : 0.f) : -1e30f;
            int rank = 0;
            for (int jj = 0; jj < 64; ++jj) { const float o = __shfl(score, jj); rank += (o > score || (o == score && jj < lane)) ? 1 : 0; }
            const unsigned long long selmask = __ballot(rank < 16);
            float osel[4] = {0.f, 0.f, 0.f, 0.f}, msel[4] = {NEG, NEG, NEG, NEG}, lsel[4] = {0.f, 0.f, 0.f, 0.f};
            float owin[4] = {0.f, 0.f, 0.f, 0.f}, mwin[4] = {NEG, NEG, NEG, NEG}, lwin[4] = {0.f, 0.f, 0.f, 0.f};
#define NSA_ATTEND(KR, VCOL, KP0, OO, MM, LL) do { \
                const int kp0_ = (KP0); const int kp = kp0_ + lane; const bool valid = kp >= 0 && kp <= t; \
                float s[4] = {0.f, 0.f, 0.f, 0.f}; \
                if (valid) { const f16* kr = (KR) + ((size_t)b * S + kp) * 64; \
                    _Pragma("unroll") for (int d8 = 0; d8 < 8; ++d8) { const f16x8 kv8 = *(const f16x8*)(kr + 8 * d8); \
                        _Pragma("unroll") for (int e = 0; e < 8; ++e) { const float kd = (float)kv8[e]; \
                            _Pragma("unroll") for (int h = 0; h < 4; ++h) s[h] += qr[h * 64 + d8 * 8 + e] * kd; } } } \
                _Pragma("unroll") for (int h = 0; h < 4; ++h) { \
                    const float sv = valid ? s[h] * 0.125f : NEG; \
                    const float mn = fmaxf(MM[h], wave_max(sv)); \
                    const float corr = (MM[h] == NEG) ? 0.f : expf(MM[h] - mn); \
                    const float p = valid ? expf(sv - mn) : 0.f; \
                    LL[h] = LL[h] * corr + wave_sum(p); OO[h] *= corr; MM[h] = mn; \
                    pS[h * 64 + lane] = p; } \
                WAVE_LDS_SYNC(); \
                for (int k = 0; k < 64; ++k) { const int kpk = kp0_ + k; if (kpk < 0 || kpk > t) continue; \
                    const float vv = (float)Z[((size_t)b * S + kpk) * ZP + (VCOL) + lane]; \
                    _Pragma("unroll") for (int h = 0; h < 4; ++h) OO[h] += pS[h * 64 + k] * vv; } \
                WAVE_LDS_SYNC(); } while (0)
            for (int jb = 0; jb <= cur; ++jb) { if (!((selmask >> jb) & 1ull)) continue; NSA_ATTEND(KSR, ZC_VSLC, 64 * jb, osel, msel, lsel); }
            for (int jb = 0; jb < 8; ++jb) { const int kpw = t - 511 + 64 * jb; if (kpw + 63 < 0) continue; NSA_ATTEND(KWR, ZC_VWIN, kpw, owin, mwin, lwin); }
#undef NSA_ATTEND
            float o[4]; float ss = 0.f;
#pragma unroll
            for (int h = 0; h < 4; ++h) {
                const float g0 = sigmoidf_((float)zr[ZC_NG + 3 * h + 0]), g1 = sigmoidf_((float)zr[ZC_NG + 3 * h + 1]), g2 = sigmoidf_((float)zr[ZC_NG + 3 * h + 2]);
                o[h] = g0 * ocmp[h] + g1 * (osel[h] / lsel[h]) + g2 * (owin[h] / lwin[h]);
                ss += o[h] * o[h];
            }
            const float r = rsqrtf(wave_sum(ss) * (1.f / 256) + EPS);
#pragma unroll
            for (int h = 0; h < 4; ++h) MIX[(size_t)m * D + 256 + 64 * h + lane] = (f16)(o[h] * r * gain[64 * h + lane]);
            WAVE_LDS_SYNC();
        }
    }
}
__device__ __forceinline__ void ph_gla1(const Ctx& C, int l, int TID, int bid, int nblk) {
    const f16* Z = (const f16*)(C.ws + WS_Z); float* LA = (float*)(C.ws + WS_LA);
    const float* w2 = C.in[8] + (size_t)l * 16 * 128; const float* gb = C.in[9] + (size_t)l * 128;
    for (int idx = bid * NT + TID; idx < M * 128; idx += nblk * NT) {
        const int dim = idx & 127, m = idx >> 7;
        const f16* lr = Z + (size_t)m * ZP + ZC_LR;
        float a = gb[dim];
#pragma unroll
        for (int r = 0; r < 16; ++r) a += (float)lr[r] * w2[r * 128 + dim];
        const float ls = fminf(a, 0.f) - log1pf(expf(-fabsf(a)));
        LA[idx] = ls * (1.f / 16.f);
    }
}
__device__ __forceinline__ void ph_gla2(const Ctx& C, int TID, int bid, int nblk) {
    float* LA = (float*)(C.ws + WS_LA);
    const int total = (M / 64) * 128;
    for (int idx = bid * NT + TID; idx < total; idx += nblk * NT) {
        const int dim = idx & 127, ch = idx >> 7;
        float run = 0.f;
        for (int tt = 0; tt < 64; ++tt) { float* p = LA + ((size_t)ch * 64 + tt) * 128 + dim; run += *p; *p = run; }
    }
}
__device__ __forceinline__ void ph_gla3(const Ctx& C, int TID, int bid, int nblk, LAS float* lds) {
    const f16* Z = (const f16*)(C.ws + WS_Z); const float* Bc = (const float*)(C.ws + WS_LA);
    float* QE2 = (float*)(C.ws + WS_QE2); float* OI = (float*)(C.ws + WS_OI); float* KV = (float*)(C.ws + WS_KV);
    LAS float* qe = lds; LAS float* ke = lds + 2112; LAS float* k2 = lds + 4224; LAS float* vs = lds + 6336; LAS float* att = lds + 10432;
    const int tid = TID;
    for (int item = bid; item < NB * 4 * 64; item += nblk) {
        const int n = item & 63, h = (item >> 6) & 3, b = item >> 8;
        const size_t m0 = (size_t)b * S + n * 64;
        __syncthreads();
        for (int idx = tid; idx < 2048; idx += NT) {
            const int tt = idx >> 5, d = idx & 31;
            const float bb = Bc[(m0 + tt) * 128 + 32 * h + d], bmid = Bc[(m0 + 32) * 128 + 32 * h + d], blast = Bc[(m0 + 63) * 128 + 32 * h + d];
            const float qv = (float)Z[(m0 + tt) * ZP + ZC_LQ + 32 * h + d] * 0.17677669529663687f, kv = (float)Z[(m0 + tt) * ZP + ZC_LK + 32 * h + d];
            qe[tt * 33 + d] = qv * expf(bb - bmid); ke[tt * 33 + d] = kv * expf(bmid - bb); k2[tt * 33 + d] = kv * expf(blast - bb);
            QE2[(m0 + tt) * 128 + 32 * h + d] = qv * expf(bb);
        }
        for (int idx = tid; idx < 4096; idx += NT) { const int tt = idx >> 6, v = idx & 63; vs[idx] = (float)Z[(m0 + tt) * ZP + ZC_LV + 64 * h + v]; }
        __syncthreads();
        for (int idx = tid; idx < 4096; idx += NT) {
            const int tt = idx >> 6, s = idx & 63; float a = 0.f;
            if (s <= tt) { for (int d = 0; d < 32; ++d) a += qe[tt * 33 + d] * ke[s * 33 + d]; }
            att[tt * 65 + s] = a;
        }
        __syncthreads();
        for (int idx = tid; idx < 4096; idx += NT) {
            const int tt = idx >> 6, v = idx & 63; float o = 0.f;
            for (int s = 0; s <= tt; ++s) o += att[tt * 65 + s] * vs[s * 64 + v];
            OI[(m0 + tt) * 256 + 64 * h + v] = o;
        }
        for (int idx = tid; idx < 2048; idx += NT) {
            const int d = idx >> 6, v = idx & 63; float a = 0.f;
            for (int s = 0; s < 64; ++s) a += k2[s * 33 + d] * vs[s * 64 + v];
            KV[(size_t)item * 2048 + idx] = a;
        }
    }
}
__device__ __forceinline__ void ph_gla4(const Ctx& C, int TID, int bid, int nblk) {
    const float* Bc = (const float*)(C.ws + WS_LA); const float* KV = (const float*)(C.ws + WS_KV); float* SP = (float*)(C.ws + WS_SPREV);
    for (int idx = bid * NT + TID; idx < NB * 4 * 2048; idx += nblk * NT) {
        const int dv = idx & 2047, bh = idx >> 11, d = dv >> 6, h = bh & 3, b = bh >> 2;
        float st = 0.f;
        for (int n = 0; n < 64; ++n) {
            SP[((size_t)bh * 64 + n) * 2048 + dv] = st;
            const float dec = expf(Bc[((size_t)b * S + n * 64 + 63) * 128 + 32 * h + d]);
            st = dec * st + KV[((size_t)bh * 64 + n) * 2048 + dv];
        }
    }
}
__device__ __forceinline__ void ph_gla5(const Ctx& C, int l, int TID, int bid, int nblk) {
    const f16* Z = (const f16*)(C.ws + WS_Z); f16* MIX = (f16*)(C.ws + WS_MIX);
    const float* QE2 = (const float*)(C.ws + WS_QE2); const float* OI = (const float*)(C.ws + WS_OI); const float* SP = (const float*)(C.ws + WS_SPREV);
    const float* gain = C.in[12] + (size_t)l * D + 512;
    const int lane = TID & 63, gw = bid * NWAVE + (TID >> 6), ngw = nblk * NWAVE;
    for (int m = gw; m < M; m += ngw) {
        const int b = m / S, t = m % S, n = t >> 6;
        float og[4]; float ss = 0.f;
#pragma unroll
        for (int h = 0; h < 4; ++h) {
            float o = OI[(size_t)m * 256 + 64 * h + lane];
            const float* sp = SP + ((size_t)(b * 4 + h) * 64 + n) * 2048 + lane; const float* qe = QE2 + (size_t)m * 128 + 32 * h;
            for (int d = 0; d < 32; ++d) o += qe[d] * sp[d * 64];
            const float ms = wave_sum(o * o) * (1.f / 64);
            const float gv = (float)Z[(size_t)m * ZP + ZC_LG + 64 * h + lane];
            og[h] = siluf(gv) * (o * rsqrtf(ms + EPS)); ss += og[h] * og[h];
        }
        const float r = rsqrtf(wave_sum(ss) * (1.f / 256) + EPS);
#pragma unroll
        for (int h = 0; h < 4; ++h) MIX[(size_t)m * D + 512 + 64 * h + lane] = (f16)(og[h] * r * gain[64 * h + lane]);
    }
}
__device__ __forceinline__ void ph_gmlp1(const Ctx& C, int TID, int bid, int nblk) {
    const f16* Z = (const f16*)(C.ws + WS_Z); float* VN = (float*)(C.ws + WS_VN);
    const int lane = TID & 63, gw = bid * NWAVE + (TID >> 6), ngw = nblk * NWAVE;
    for (int m = gw; m < M; m += ngw) {
#pragma unroll
        for (int g = 0; g < 4; ++g) {
            const float v = (float)Z[(size_t)m * ZP + ZC_MV + 64 * g + lane];
            const float mu = wave_sum(v) * (1.f / 64), dv = v - mu, var = wave_sum(dv * dv) * (1.f / 64);
            VN[(size_t)m * 256 + 64 * g + lane] = dv * rsqrtf(var + EPS);
        }
    }
}
__device__ __forceinline__ void ph_gmlp2(const Ctx& C, int l, int TID, int bid, int nblk) {
    const f16* Z = (const f16*)(C.ws + WS_Z); f16* MIX = (f16*)(C.ws + WS_MIX); const float* VN = (const float*)(C.ws + WS_VN);
    const float* ws_ = C.in[10] + (size_t)l * 4 * 128 * 128; const float* bs = C.in[11] + (size_t)l * 4 * 128; const float* gain = C.in[12] + (size_t)l * D + 768;
    const int lane = TID & 63, gw = bid * NWAVE + (TID >> 6), ngw = nblk * NWAVE;
    for (int m = gw; m < M; m += ngw) {
        const int tp = m & 127; const size_t mc = (size_t)(m - tp);
        float o[4]; float ss = 0.f;
#pragma unroll
        for (int g = 0; g < 4; ++g) {
            const float* w = ws_ + ((size_t)g * 128 + tp) * 128; float acc = 0.f;
            for (int s = 0; s <= tp; ++s) acc += w[s] * VN[(mc + s) * 256 + 64 * g + lane];
            o[g] = (float)Z[(size_t)m * ZP + ZC_MU + 64 * g + lane] * (acc + bs[g * 128 + tp]); ss += o[g] * o[g];
        }
        const float r = rsqrtf(wave_sum(ss) * (1.f / 256) + EPS);
#pragma unroll
        for (int g = 0; g < 4; ++g) MIX[(size_t)m * D + 768 + 64 * g + lane] = (f16)(o[g] * r * gain[64 * g + lane]);
    }
}

#define XB_TMO      128
#define XB_XCNT(j)  (256  + 64 * (j))
#define XB_XSUB(j)  (1280 + 64 * (j))
#define XB_XGEN(j)  (2304 + 64 * (j))
#define XB_TOP      3328
#define XB_TOPGEN   3392
#define XCD_BAR_WORDS 3456
#define XB_SPIN_CAP (1u << 18)

__device__ __forceinline__ unsigned xb_ld(unsigned* p)              { return __hip_atomic_load(p, __ATOMIC_RELAXED, __HIP_MEMORY_SCOPE_AGENT); }
__device__ __forceinline__ unsigned xb_add(unsigned* p, unsigned v) { return __hip_atomic_fetch_add(p, v, __ATOMIC_RELAXED, __HIP_MEMORY_SCOPE_AGENT); }
__device__ __forceinline__ unsigned xb_xcc_id() { return (unsigned)__builtin_amdgcn_s_getreg((3 << 11) | 20) & 0xFu; }
#define XB_SPIN(cond, bar) do { unsigned _sp = 0; while (cond) { __builtin_amdgcn_s_sleep(1); \
    if ((++_sp & 255u) == 0u) { if (xb_ld(&(bar)[XB_TMO])) break; if (_sp > XB_SPIN_CAP) { atomicAdd(&(bar)[XB_TMO], 1u); break; } } } } while (0)

struct XcdBarrier {
    unsigned* bar; unsigned x;
    volatile LAS unsigned* st;
};

__device__ __forceinline__ XcdBarrier xcd_barrier_post(unsigned* bar, volatile LAS unsigned* st) {
    XcdBarrier b; b.bar = bar; b.x = xb_xcc_id(); b.st = st;
    if (threadIdx.x == 0) (void)xb_add(&bar[XB_XCNT(b.x)], 1u);
    return b;
}
__device__ __forceinline__ void xcd_barrier_complete(unsigned* bar, unsigned x, unsigned& nloc, unsigned& nx) {
    const unsigned G = gridDim.x * gridDim.y * gridDim.z;
    unsigned sum, cnt, mine, sp = 0u;
    for (;;) {
        sum = 0u; cnt = 0u; mine = 0u;
#pragma unroll
        for (unsigned j = 0; j < 16; ++j) { const unsigned c = xb_ld(&bar[XB_XCNT(j)]); sum += c; cnt += (c > 0u) ? 1u : 0u; mine = (j == x) ? c : mine; }
        if (sum == G) break;
        __builtin_amdgcn_s_sleep(1);
        if ((++sp & 255u) == 0u) { if (xb_ld(&bar[XB_TMO])) break; if (sp > XB_SPIN_CAP) { atomicAdd(&bar[XB_TMO], 1u); break; } }
    }
    nloc = mine > 0u ? mine : 1u; nx = cnt > 0u ? cnt : 1u;
}

__device__ __forceinline__ void xcd_barrier(const XcdBarrier& b) {
    asm volatile("s_waitcnt vmcnt(0)" ::: "memory");
    __syncthreads();
    if (threadIdx.x == 0) {
        unsigned* bar = b.bar;
        __builtin_amdgcn_s_waitcnt(0);
        unsigned nloc = b.st[0], nx = b.st[1];
        if (nloc == 0u) { xcd_barrier_complete(bar, b.x, nloc, nx); b.st[0] = nloc; b.st[1] = nx; }
        const unsigned old = xb_add(&bar[XB_XSUB(b.x)], 1u);
        const unsigned gen = old / nloc;
        if (old + 1u == (gen + 1u) * nloc) {
            __builtin_amdgcn_fence(__ATOMIC_RELEASE, "agent");
            asm volatile("s_waitcnt vmcnt(0)" ::: "memory");
            const unsigned og = xb_add(&bar[XB_TOP], 1u);
            const unsigned tg = og / nx;
            if (og + 1u == (tg + 1u) * nx) xb_add(&bar[XB_TOPGEN], 1u);
            else XB_SPIN(xb_ld(&bar[XB_TOPGEN]) == tg, bar);
            __builtin_amdgcn_fence(__ATOMIC_ACQUIRE, "agent");
            xb_add(&bar[XB_XGEN(b.x)], 1u);
            asm volatile("s_waitcnt vmcnt(0)" ::: "memory");
        } else {
            XB_SPIN(xb_ld(&bar[XB_XGEN(b.x)]) == gen, bar);
            __builtin_amdgcn_fence(__ATOMIC_ACQUIRE, "agent");
            asm volatile("s_waitcnt vmcnt(0)" ::: "memory");
        }
    }
    __syncthreads();
}

constexpr int CW_BAR = 4096;
constexpr int LDS_MISC = LDS_BYTES - 256;
#define LAUNDER(v) asm volatile("" : "+s"(v))
__global__ void __launch_bounds__(NT, 2) k_mega(Ctx Carg) {
    extern __shared__ __attribute__((aligned(16))) unsigned char lds_raw[];
    LAS float* lds = (LAS float*)lds_raw;
    const int bid = blockIdx.x, nblk = gridDim.x;
    for (int u = threadIdx.x; u < 64; u += NT) ((LAS unsigned*)((LAS unsigned char*)lds_raw + LDS_MISC))[u] = 0u;
    __syncthreads();
    const Ctx* Cp = (const Ctx*)__builtin_amdgcn_kernarg_segment_ptr();
    XcdBarrier bar = xcd_barrier_post((unsigned*)(Cp->ws + WS_CTL) + CW_BAR, (volatile LAS unsigned*)((LAS unsigned char*)lds_raw + LDS_MISC + 32));
#ifndef PMASK
#define PMASK 0xFFFFF
#endif
#define SITE(k, body) do { if (!((PMASK >> (k)) & 1)) break; const Ctx* cp_ = Cp; LAUNDER(cp_); const Ctx C = *cp_; int ll = l; LAUNDER(ll); int tid_ = threadIdx.x; asm volatile("" : "+v"(tid_)); int bid_ = bid; LAUNDER(bid_); \
        f16* H = (f16*)(C.ws + WS_H); f16* Zb = (f16*)(C.ws + WS_Z); f16* MIX = (f16*)(C.ws + WS_MIX); f16* Y = (f16*)(C.ws + WS_Y); f16* U = (f16*)(C.ws + WS_BIG); \
        (void)H; (void)Zb; (void)MIX; (void)Y; (void)U; body; } while (0); xcd_barrier(bar)
    int l = 0;
    SITE(0, ph_mod(C, tid_, bid_, nblk); ph_rope(C, tid_, bid_, nblk));
    SITE(1, ph_norm0(C, tid_, bid_, nblk));
    for (l = 0; l < DEPTH; ++l) {
        SITE(2, (gemm_naive<0, true>(H, C.in[3] + (size_t)ll * D * NIN, NIN, D, Zb, ZP, tid_, bid_, nblk, lds)));
        SITE(3, ph_conv(C, ll, tid_, bid_, nblk); ph_rotk(C, tid_, bid_, nblk); ph_cmp1(C, ll, tid_, bid_, nblk); ph_gla1(C, ll, tid_, bid_, nblk); ph_gmlp1(C, tid_, bid_, nblk));
        SITE(4, ph_cmp2(C, ll, tid_, bid_, nblk); ph_gla2(C, tid_, bid_, nblk); ph_gmlp2(C, ll, tid_, bid_, nblk));
        SITE(5, ph_nsa(C, ll, tid_, bid_, nblk, lds); __syncthreads(); ph_gla3(C, tid_, bid_, nblk, lds));
        SITE(6, ph_gla4(C, tid_, bid_, nblk));
        SITE(7, ph_gla5(C, ll, tid_, bid_, nblk));
        SITE(8, (gemm_naive<0, false>(MIX, C.in[13] + (size_t)ll * D * D, D, D, Y, D, tid_, bid_, nblk, lds)));
        SITE(9, ph_resnorm(C, ll, 0, tid_, bid_, nblk));
        SITE(10, (gemm_naive<1, false>(H, C.in[17] + (size_t)ll * D * DFF, DFF, D, U, DFF, tid_, bid_, nblk, lds)));
        SITE(11, (gemm_naive<0, false>(U, C.in[18] + (size_t)ll * DFF * D, D, DFF, Y, D, tid_, bid_, nblk, lds)));
        SITE(12, ph_resnorm(C, ll, 1, tid_, bid_, nblk));
    }
#undef SITE
}

extern "C" void kernel_launch(void* const* d_in, const int* in_sizes, int n_in, void* d_out, int out_size, void* d_ws, size_t ws_size, hipStream_t stream) {
    static int grid = 0;
    if (grid == 0) {
        if (n_in != 19 || ws_size < WS_END) { fprintf(stderr, "kernel_launch: unexpected n_in %d / ws_size %zu\n", n_in, ws_size); grid = -1; return; }
        int dev = 0, cus = 0, per_cu = 0;
        if (hipGetDevice(&dev) != hipSuccess || hipDeviceGetAttribute(&cus, hipDeviceAttributeMultiprocessorCount, dev) != hipSuccess) { grid = -1; return; }
        if (hipFuncSetAttribute((const void*)k_mega, hipFuncAttributeMaxDynamicSharedMemorySize, LDS_BYTES) != hipSuccess) { fprintf(stderr, "hipFuncSetAttribute failed\n"); grid = -1; return; }
        if (hipOccupancyMaxActiveBlocksPerMultiprocessor(&per_cu, (const void*)k_mega, NT, LDS_BYTES) != hipSuccess || per_cu < 1) { fprintf(stderr, "occupancy query: %d\n", per_cu); }
        (void)hipGetLastError();
        grid = cus;
    }
    if (grid < 0) return;
    if (hipMemsetAsync((char*)d_ws + WS_CTL, 0, 1 * MiB, stream) != hipSuccess) return;
    Ctx c{};
    for (int i = 0; i < 19; ++i) c.in[i] = (const float*)d_in[i];
    c.out = (float*)d_out; c.ws = (unsigned char*)d_ws;
    hipLaunchKernelGGL(k_mega, dim3(grid), dim3(NT), LDS_BYTES, stream, c);
}
```

```cpp
#include <hip/hip_runtime.h>
#include <cstdint>
#include <cstdio>

#define LAS __attribute__((address_space(3)))
typedef _Float16 f16;
typedef f16 f16x4 __attribute__((ext_vector_type(4)));
typedef f16 f16x8 __attribute__((ext_vector_type(8)));
typedef float f32x4 __attribute__((ext_vector_type(4)));

constexpr int D = 1024, NB = 8, S = 4096, DEPTH = 4, M = NB * S, DFF = 4096;
constexpr int NIN = 2716, ZP = 2816;
constexpr int ZC_AH = 0, ZC_AB = 256, ZC_AC = 512, ZC_NQ = 768, ZC_KCMP = 1024, ZC_VCMP = 1088, ZC_KSLC = 1152, ZC_VSLC = 1216,
              ZC_KWIN = 1280, ZC_VWIN = 1344, ZC_NG = 1408, ZC_LQ = 1424, ZC_LK = 1552, ZC_LV = 1680, ZC_LG = 1936, ZC_LR = 2192,
              ZC_MU = 2208, ZC_MV = 2464;
constexpr int NCMP = 255;
constexpr float EPS = 1e-6f;
constexpr int NT = 512, NWAVE = 8;

constexpr size_t MiB = 1u << 20;
constexpr size_t WS_CTL = 0;
constexpr size_t WS_MOD = 1 * MiB;
constexpr size_t WS_ROPE = 2 * MiB;
constexpr size_t WS_W16 = 4 * MiB;
constexpr size_t WS_H = 98 * MiB;
constexpr size_t WS_Y = 162 * MiB;
constexpr size_t WS_BIG = 226 * MiB;
constexpr size_t WS_Z = WS_BIG;
constexpr size_t WS_MIX = WS_BIG + 176 * MiB;
constexpr size_t WS_KSR = WS_BIG + 240 * MiB;
constexpr size_t WS_KWR = WS_BIG + 244 * MiB;
constexpr size_t WS_HID = WS_BIG + 248 * MiB;
constexpr size_t WS_KC = WS_BIG + 251 * MiB;
constexpr size_t WS_VC = WS_BIG + 252 * MiB;
constexpr size_t WS_END = 482 * MiB;
constexpr size_t WS_LA = WS_H;
constexpr size_t WS_QE2 = WS_H + 16 * MiB;
constexpr size_t WS_OI = WS_H + 32 * MiB;
constexpr size_t WS_KV = WS_Y;
constexpr size_t WS_SPREV = WS_Y + 16 * MiB;
constexpr size_t WS_VN = WS_Y + 32 * MiB;

constexpr size_t W16_WIN = 0, W16_WO = (size_t)ZP * D * 2, W16_WUP = W16_WO + (size_t)D * D * 2, W16_WDN = W16_WUP + (size_t)DFF * D * 2, W16_LAYER = W16_WDN + (size_t)D * DFF * 2;
static_assert(WS_W16 + DEPTH * W16_LAYER <= WS_H, "weight copies fit below H");

constexpr int LDS_BYTES = 147456;

struct Ctx {
    const float* in[19];
    float* out;
    unsigned char* ws;
    int lo, hi;
};

__device__ __forceinline__ float wave_sum(float v) {
#pragma unroll
    for (int o = 32; o > 0; o >>= 1) v += __shfl_xor(v, o);
    return v;
}
__device__ __forceinline__ float wave_max(float v) {
#pragma unroll
    for (int o = 32; o > 0; o >>= 1) v = fmaxf(v, __shfl_xor(v, o));
    return v;
}
#define WAVE_LDS_SYNC() asm volatile("s_waitcnt lgkmcnt(0)" ::: "memory")
__device__ __forceinline__ float siluf(float v) { return v / (1.f + expf(-v)); }
__device__ __forceinline__ float sigmoidf_(float v) { return 1.f / (1.f + expf(-v)); }

__device__ __forceinline__ void sincos_d(double a, double& s, double& c) {
    const double two_over_pi = 0.63661977236758134308, pio2_hi = 1.57079632679489655800e+00, pio2_lo = 6.12323399573676603587e-17;
    const double kq = rint(a * two_over_pi);
    double r = (a - kq * pio2_hi) - kq * pio2_lo;
    const double r2 = r * r;
    double sp = r * (1.0 + r2 * (-1.0 / 6 + r2 * (1.0 / 120 + r2 * (-1.0 / 5040 + r2 * (1.0 / 362880 + r2 * (-1.0 / 39916800 + r2 * (1.0 / 6227020800.0 + r2 * (-1.0 / 1307674368000.0))))))));
    double cp = 1.0 + r2 * (-0.5 + r2 * (1.0 / 24 + r2 * (-1.0 / 720 + r2 * (1.0 / 40320 + r2 * (-1.0 / 3628800 + r2 * (1.0 / 479001600.0 + r2 * (-1.0 / 87178291200.0 + r2 * (1.0 / 20922789888000.0))))))));
    const int q = ((int)kq) & 3;
    if (q == 0) { s = sp; c = cp; } else if (q == 1) { s = cp; c = -sp; } else if (q == 2) { s = -sp; c = -cp; } else { s = -cp; c = sp; }
}

__device__ __forceinline__ void ph_mod(const Ctx& C, int TID, int bid, int nblk) {
    const float* c = C.in[1]; const float* w_mod = C.in[15]; const float* b_mod = C.in[16];
    float* MOD = (float*)(C.ws + WS_MOD);
    const int total = DEPTH * NB * 6 * D;
    for (int idx = bid * NT + TID; idx < total; idx += nblk * NT) {
        const int n = idx % (6 * D), bb = (idx / (6 * D)) % NB, l = idx / (6 * D * NB);
        float acc = b_mod[l * 6 * D + n];
        const float* w = w_mod + (size_t)l * D * 6 * D + n;
        for (int k = 0; k < D; ++k) { const float cv = c[bb * D + k]; acc += siluf(cv) * w[(size_t)k * 6 * D]; }
        MOD[idx] = acc;
    }
}
__device__ __forceinline__ void ph_rope(const Ctx& C, int TID, int bid, int nblk) {
    const int* pos = (const int*)C.in[2];
    float* RC = (float*)(C.ws + WS_ROPE); float* RS = RC + (size_t)M * 8;
    const double invf[8] = {1.0, 0.19392274474868576, 0.03760603093086393, 0.007292664737217109, 0.001414213562373095, 0.0002742481756762073, 5.318295896944988e-05, 1.031338537721246e-05};
    for (int idx = bid * NT + TID; idx < M * 8; idx += nblk * NT) {
        const int i = idx & 7, m = idx >> 3;
        double f = invf[0];
#pragma unroll
        for (int j = 1; j < 8; ++j) f = (i == j) ? invf[j] : f;
        double s, c; sincos_d((double)pos[m] * f, s, c);
        RC[idx] = (float)c; RS[idx] = (float)s;
    }
}
__device__ __forceinline__ void adaln_row(const float (&xv)[16], const float* g, const float* sc, const float* sh, f16* hrow, int lane) {
    float ss = 0.f;
#pragma unroll
    for (int j = 0; j < 16; ++j) ss += xv[j] * xv[j];
    const float r = rsqrtf(wave_sum(ss) * (1.f / D) + EPS);
#pragma unroll
    for (int j = 0; j < 4; ++j) {
        const int c0 = 256 * j + 4 * lane;
        const f32x4 gv = *(const f32x4*)(g + c0), scv = *(const f32x4*)(sc + c0), shv = *(const f32x4*)(sh + c0);
        f16x4 o;
#pragma unroll
        for (int e = 0; e < 4; ++e) o[e] = (f16)(xv[4 * j + e] * r * gv[e] * (1.f + scv[e]) + shv[e]);
        *(f16x4*)(hrow + c0) = o;
    }
}
__device__ __forceinline__ void ph_norm0(const Ctx& C, int TID, int bid, int nblk) {
    const float* x = C.in[0]; const float* norm_g = C.in[14]; const float* MOD = (const float*)(C.ws + WS_MOD);
    f16* H = (f16*)(C.ws + WS_H);
    const int lane = TID & 63, gw = bid * NWAVE + (TID >> 6), ngw = nblk * NWAVE;
    for (int m = gw; m < M; m += ngw) {
        const int b = m / S;
        float xv[16];
#pragma unroll
        for (int j = 0; j < 4; ++j) { const f32x4 v = *(const f32x4*)(x + (size_t)m * D + 256 * j + 4 * lane); xv[4 * j] = v[0]; xv[4 * j + 1] = v[1]; xv[4 * j + 2] = v[2]; xv[4 * j + 3] = v[3]; }
        const float* mod = MOD + (size_t)(0 * NB + b) * 6 * D;
        adaln_row(xv, norm_g + 0, mod + D, mod + 0, H + (size_t)m * D, lane);
    }
}
__device__ __forceinline__ void ph_resnorm(const Ctx& C, int l, int sub, int TID, int bid, int nblk) {
    const float* norm_g = C.in[14]; const float* MOD = (const float*)(C.ws + WS_MOD);
    const f16* Y = (const f16*)(C.ws + WS_Y); f16* H = (f16*)(C.ws + WS_H);
    const float* xsrc = (l == 0 && sub == 0) ? C.in[0] : C.out;
    const float* ga = norm_g + (size_t)(l * 4 + (sub == 0 ? 1 : 3)) * D;
    const bool has_next = !(l == DEPTH - 1 && sub == 1);
    const int ln = sub == 0 ? l : l + 1;
    const float* gb = norm_g + (size_t)((has_next ? ln : 0) * 4 + (sub == 0 ? 2 : 0)) * D;
    const int lane = TID & 63, gw = bid * NWAVE + (TID >> 6), ngw = nblk * NWAVE;
    for (int m = gw; m < M; m += ngw) {
        const int b = m / S;
        const float* mod = MOD + (size_t)(l * NB + b) * 6 * D;
        const float* gt = mod + (sub == 0 ? 2 : 5) * D;
        float yv[16], xv[16]; float ss = 0.f;
#pragma unroll
        for (int j = 0; j < 4; ++j) {
            const f16x4 v = *(const f16x4*)(Y + (size_t)m * D + 256 * j + 4 * lane);
#pragma unroll
            for (int e = 0; e < 4; ++e) { yv[4 * j + e] = (float)v[e]; ss += yv[4 * j + e] * yv[4 * j + e]; }
        }
        const float r = rsqrtf(wave_sum(ss) * (1.f / D) + EPS);
#pragma unroll
        for (int j = 0; j < 4; ++j) {
            const int c0 = 256 * j + 4 * lane;
            const f32x4 xo = *(const f32x4*)(xsrc + (size_t)m * D + c0), gav = *(const f32x4*)(ga + c0), gtv = *(const f32x4*)(gt + c0);
            f32x4 xn;
#pragma unroll
            for (int e = 0; e < 4; ++e) { xn[e] = xo[e] + gtv[e] * (yv[4 * j + e] * r * gav[e]); xv[4 * j + e] = xn[e]; }
            *(f32x4*)(C.out + (size_t)m * D + c0) = xn;
        }
        if (has_next) {
            const float* modn = MOD + (size_t)(ln * NB + b) * 6 * D;
            adaln_row(xv, gb, modn + (sub == 0 ? 4 : 1) * D, modn + (sub == 0 ? 3 : 0) * D, H + (size_t)m * D, lane);
        }
    }
}

__device__ __forceinline__ void ph_conv(const Ctx& C, int l, int TID, int bid, int nblk) {
    const f16* Z = (const f16*)(C.ws + WS_Z); f16* MIX = (f16*)(C.ws + WS_MIX);
    const float* cw = C.in[4] + (size_t)l * 3 * 256; const float* gain = C.in[12] + (size_t)l * D;
    const int lane = TID & 63, gw = bid * NWAVE + (TID >> 6), ngw = nblk * NWAVE;
    for (int m = gw; m < M; m += ngw) {
        const int t = m % S;
        float o[4]; float ss = 0.f;
#pragma unroll
        for (int j = 0; j < 4; ++j) {
            const int ch = lane + 64 * j; float y = 0.f;
#pragma unroll
            for (int k = 0; k < 3; ++k) {
                const int tt = t - 2 + k;
                if (tt >= 0) { const f16* zr = Z + (size_t)(m - 2 + k) * ZP; y += (float)zr[ZC_AC + ch] * (float)zr[ZC_AH + ch] * cw[k * 256 + ch]; }
            }
            o[j] = (float)Z[(size_t)m * ZP + ZC_AB + ch] * y; ss += o[j] * o[j];
        }
        const float r = rsqrtf(wave_sum(ss) * (1.f / 256) + EPS);
#pragma unroll
        for (int j = 0; j < 4; ++j) { const int ch = lane + 64 * j; MIX[(size_t)m * D + ch] = (f16)(o[j] * r * gain[ch]); }
    }
}
__device__ __forceinline__ void ph_rotk(const Ctx& C, int TID, int bid, int nblk) {
    const f16* Z = (const f16*)(C.ws + WS_Z); f16* KSR = (f16*)(C.ws + WS_KSR); f16* KWR = (f16*)(C.ws + WS_KWR);
    const float* RC = (const float*)(C.ws + WS_ROPE); const float* RS = RC + (size_t)M * 8;
    for (int idx = bid * NT + TID; idx < M * 128; idx += nblk * NT) {
        const int d = idx & 63, which = (idx >> 6) & 1, m = idx >> 7;
        const f16* zr = Z + (size_t)m * ZP + (which ? ZC_KWIN : ZC_KSLC);
        float v = (float)zr[d];
        if (d < 16) { const int i = d & 7; const float cs = RC[m * 8 + i], sn = RS[m * 8 + i];
            if (d < 8) v = v * cs - (float)zr[d + 8] * sn; else v = v * cs + (float)zr[d - 8] * sn; }
        (which ? KWR : KSR)[(size_t)m * 64 + d] = (f16)v;
    }
}
__device__ __forceinline__ void ph_cmp1(const Ctx& C, int l, int TID, int bid, int nblk) {
    const f16* Z = (const f16*)(C.ws + WS_Z); float* HID = (float*)(C.ws + WS_HID);
    const float* cpos = C.in[5] + (size_t)l * 2 * 32 * 64; const float* w1 = C.in[6] + (size_t)l * 2 * 2048 * 128;
    const int total = 2 * NB * NCMP * 128;
    for (int idx = bid * NT + TID; idx < total; idx += nblk * NT) {
        const int o = idx & 127, i = (idx >> 7) % NCMP, b = ((idx >> 7) / NCMP) % NB, j = (idx >> 7) / (NCMP * NB);
        const float* w = w1 + (size_t)j * 2048 * 128 + o; const float* pp = cpos + j * 2048;
        const f16* zb = Z + (size_t)(b * S + 16 * i) * ZP + (j ? ZC_VCMP : ZC_KCMP);
        float acc = 0.f;
        for (int p = 0; p < 32; ++p)
            for (int d = 0; d < 64; ++d) acc += ((float)zb[(size_t)p * ZP + d] + pp[p * 64 + d]) * w[(size_t)(p * 64 + d) * 128];
        HID[idx] = siluf(acc);
    }
}
__device__ __forceinline__ void ph_cmp2(const Ctx& C, int l, int TID, int bid, int nblk) {
    const float* HID = (const float*)(C.ws + WS_HID); float* KC = (float*)(C.ws + WS_KC); float* VC = (float*)(C.ws + WS_VC);
    const float* w2 = C.in[7] + (size_t)l * 2 * 128 * 64;
    const int total = 2 * NB * NCMP * 64;
    for (int idx = bid * NT + TID; idx < total; idx += nblk * NT) {
        const int d = idx & 63, bi = (idx >> 6) % (NB * NCMP), j = (idx >> 6) / (NB * NCMP);
        const float* hrow = HID + ((size_t)j * NB * NCMP + bi) * 128; const float* w = w2 + (size_t)j * 128 * 64 + d;
        float acc = 0.f;
        for (int o = 0; o < 128; ++o) acc += hrow[o] * w[o * 64];
        (j ? VC : KC)[(size_t)bi * 64 + d] = acc;
    }
}
__device__ __forceinline__ void ph_nsa(const Ctx& C, int l, int TID, int bid, int nblk, LAS float* lds) {
    const f16* Z = (const f16*)(C.ws + WS_Z); f16* MIX = (f16*)(C.ws + WS_MIX);
    const f16* KSR = (const f16*)(C.ws + WS_KSR); const f16* KWR = (const f16*)(C.ws + WS_KWR);
    const float* KC = (const float*)(C.ws + WS_KC); const float* VC = (const float*)(C.ws + WS_VC);
    const float* RC = (const float*)(C.ws + WS_ROPE); const float* RS = RC + (size_t)M * 8;
    const float* gain = C.in[12] + (size_t)l * D + 256;
    const int tid = TID, lane = tid & 63, wave = tid >> 6;
    LAS float* kcs = lds;
    LAS float* wsb = lds + 16640 + wave * 1792;
    LAS float* Pc = wsb;
    LAS float* qs = wsb + 1024;
    LAS float* qr = wsb + 1280;
    LAS float* pS = wsb + 1536;
    const float NEG = -__builtin_inff();
    for (int item = bid; item < M / 128; item += nblk) {
        const int m0 = item * 128, b = m0 / S, t0 = m0 % S;
        const int nload = (t0 + 127 >= 31) ? ((t0 + 127 - 31) / 16 + 1 > NCMP ? NCMP : (t0 + 127 - 31) / 16 + 1) : 0;
        __syncthreads();
        for (int idx = tid; idx < nload * 64; idx += NT) kcs[(idx >> 6) * 65 + (idx & 63)] = KC[((size_t)b * NCMP + (idx >> 6)) * 64 + (idx & 63)];
        __syncthreads();
        for (int tt = wave; tt < 128; tt += NWAVE) {
            const int m = m0 + tt, t = t0 + tt;
            const f16* zr = Z + (size_t)m * ZP;
            float q[4];
            const float cs = RC[(size_t)m * 8 + (lane & 7)], sn = RS[(size_t)m * 8 + (lane & 7)];
#pragma unroll
            for (int h = 0; h < 4; ++h) {
                q[h] = (float)zr[ZC_NQ + 64 * h + lane]; qs[h * 64 + lane] = q[h];
                const float pr = __shfl_xor(q[h], 8);
                float r = q[h];
                if (lane < 8) r = q[h] * cs - pr * sn; else if (lane < 16) r = q[h] * cs + pr * sn;
                qr[h * 64 + lane] = r;
            }
            WAVE_LDS_SYNC();
            int ncv = t >= 31 ? (t - 31) / 16 + 1 : 0; if (ncv > NCMP) ncv = NCMP;
            float sc[4][4];
#pragma unroll
            for (int h = 0; h < 4; ++h)
#pragma unroll
                for (int r = 0; r < 4; ++r) sc[h][r] = 0.f;
            for (int d = 0; d < 64; ++d) {
                float kv[4];
#pragma unroll
                for (int r = 0; r < 4; ++r) { const int i = lane + 64 * r; kv[r] = (i < ncv) ? kcs[i * 65 + d] : 0.f; }
#pragma unroll
                for (int h = 0; h < 4; ++h) { const float qv = qs[h * 64 + d];
#pragma unroll
                    for (int r = 0; r < 4; ++r) sc[h][r] += qv * kv[r]; }
            }
#pragma unroll
            for (int h = 0; h < 4; ++h) {
                float mx = NEG;
#pragma unroll
                for (int r = 0; r < 4; ++r) { const int i = lane + 64 * r; sc[h][r] = (i < ncv) ? sc[h][r] * 0.125f : NEG; mx = fmaxf(mx, sc[h][r]); }
                mx = wave_max(mx);
                float e[4], sum = 0.f;
#pragma unroll
                for (int r = 0; r < 4; ++r) { const int i = lane + 64 * r; e[r] = (i < ncv) ? expf(sc[h][r] - mx) : 0.f; sum += e[r]; }
                sum = wave_sum(sum);
                const float inv = ncv > 0 ? 1.f / sum : 0.f;
#pragma unroll
                for (int r = 0; r < 4; ++r) Pc[h * 256 + lane + 64 * r] = e[r] * inv;
            }
            WAVE_LDS_SYNC();
            float ocmp[4] = {0.f, 0.f, 0.f, 0.f};
            for (int i = 0; i < ncv; ++i) { const float vv = VC[((size_t)b * NCMP + i) * 64 + lane];
#pragma unroll
                for (int h = 0; h < 4; ++h) ocmp[h] += Pc[h * 256 + i] * vv; }
            float pslc = 0.f;
#pragma unroll
            for (int h = 0; h < 4; ++h) {
                const LAS float* P = Pc + h * 256 + 4 * lane;
                pslc += (lane > 0 ? P[-1] : 0.f) + 2.f * P[0] + 2.f * P[1] + 2.f * P[2] + P[3];
            }
            const int cur = t >> 6;
            const bool forced = (lane < 1) || (cur - lane >= 0 && cur - lane < 2);
            const float score = (lane <= cur) ? pslc + (forced ? 1e4f : 0.f) : -1e30f;
            int rank = 0;
            for (int jj = 0; jj < 64; ++jj) { const float o = __shfl(score, jj); rank += (o > score || (o == score && jj < lane)) ? 1 : 0; }
            const unsigned long long selmask = __ballot(rank < 16);
            float osel[4] = {0.f, 0.f, 0.f, 0.f}, msel[4] = {NEG, NEG, NEG, NEG}, lsel[4] = {0.f, 0.f, 0.f, 0.f};
            float owin[4] = {0.f, 0.f, 0.f, 0.f}, mwin[4] = {NEG, NEG, NEG, NEG}, lwin[4] = {0.f, 0.f, 0.f, 0.f};
#define NSA_ATTEND(KR, VCOL, KP0, OO, MM, LL) do { \
                const int kp0_ = (KP0); const int kp = kp0_ + lane; const bool valid = kp >= 0 && kp <= t; \
                float s[4] = {0.f, 0.f, 0.f, 0.f}; \
                if (valid) { const f16* kr = (KR) + ((size_t)b * S + kp) * 64; \
                    _Pragma("unroll") for (int d8 = 0; d8 < 8; ++d8) { const f16x8 kv8 = *(const f16x8*)(kr + 8 * d8); \
                        _Pragma("unroll") for (int e = 0; e < 8; ++e) { const float kd = (float)kv8[e]; \
                            _Pragma("unroll") for (int h = 0; h < 4; ++h) s[h] += qr[h * 64 + d8 * 8 + e] * kd; } } } \
                _Pragma("unroll") for (int h = 0; h < 4; ++h) { \
                    const float sv = valid ? s[h] * 0.125f : NEG; \
                    const float mn = fmaxf(MM[h], wave_max(sv)); \
                    const float corr = (MM[h] == NEG) ? 0.f : expf(MM[h] - mn); \
                    const float p = valid ? expf(sv - mn) : 0.f; \
                    LL[h] = LL[h] * corr + wave_sum(p); OO[h] *= corr; MM[h] = mn; \
                    pS[h * 64 + lane] = p; } \
                WAVE_LDS_SYNC(); \
                for (int k = 0; k < 64; ++k) { const int kpk = kp0_ + k; if (kpk < 0 || kpk > t) continue; \
                    const float vv = (float)Z[((size_t)b * S + kpk) * ZP + (VCOL) + lane]; \
                    _Pragma("unroll") for (int h = 0; h < 4; ++h) OO[h] += pS[h * 64 + k] * vv; } \
                WAVE_LDS_SYNC(); } while (0)
            for (int jb = 0; jb <= cur; ++jb) { if (!((selmask >> jb) & 1ull)) continue; NSA_ATTEND(KSR, ZC_VSLC, 64 * jb, osel, msel, lsel); }
            for (int jb = 0; jb < 8; ++jb) { const int kpw = t - 511 + 64 * jb; if (kpw + 63 < 0) continue; NSA_ATTEND(KWR, ZC_VWIN, kpw, owin, mwin, lwin); }
#undef NSA_ATTEND
            float o[4]; float ss = 0.f;
#pragma unroll
            for (int h = 0; h < 4; ++h) {
                const float g0 = sigmoidf_((float)zr[ZC_NG + 3 * h + 0]), g1 = sigmoidf_((float)zr[ZC_NG + 3 * h + 1]), g2 = sigmoidf_((float)zr[ZC_NG + 3 * h + 2]);
                o[h] = g0 * ocmp[h] + g1 * (osel[h] / lsel[h]) + g2 * (owin[h] / lwin[h]);
                ss += o[h] * o[h];
            }
            const float r = rsqrtf(wave_sum(ss) * (1.f / 256) + EPS);
#pragma unroll
            for (int h = 0; h < 4; ++h) MIX[(size_t)m * D + 256 + 64 * h + lane] = (f16)(o[h] * r * gain[64 * h + lane]);
            WAVE_LDS_SYNC();
        }
    }
}
__device__ __forceinline__ void ph_gla1(const Ctx& C, int l, int TID, int bid, int nblk) {
    const f16* Z = (const f16*)(C.ws + WS_Z); float* LA = (float*)(C.ws + WS_LA);
    const float* w2 = C.in[8] + (size_t)l * 16 * 128; const float* gb = C.in[9] + (size_t)l * 128;
    for (int idx = bid * NT + TID; idx < M * 128; idx += nblk * NT) {
        const int dim = idx & 127, m = idx >> 7;
        const f16* lr = Z + (size_t)m * ZP + ZC_LR;
        float a = gb[dim];
#pragma unroll
        for (int r = 0; r < 16; ++r) a += (float)lr[r] * w2[r * 128 + dim];
        const float ls = fminf(a, 0.f) - log1pf(expf(-fabsf(a)));
        LA[idx] = ls * (1.f / 16.f);
    }
}
__device__ __forceinline__ void ph_gla2(const Ctx& C, int TID, int bid, int nblk) {
    float* LA = (float*)(C.ws + WS_LA);
    const int total = (M / 64) * 128;
    for (int idx = bid * NT + TID; idx < total; idx += nblk * NT) {
        const int dim = idx & 127, ch = idx >> 7;
        float run = 0.f;
        for (int tt = 0; tt < 64; ++tt) { float* p = LA + ((size_t)ch * 64 + tt) * 128 + dim; run += *p; *p = run; }
    }
}
__device__ __forceinline__ void ph_gla3(const Ctx& C, int TID, int bid, int nblk, LAS float* lds) {
    const f16* Z = (const f16*)(C.ws + WS_Z); const float* Bc = (const float*)(C.ws + WS_LA);
    float* QE2 = (float*)(C.ws + WS_QE2); float* OI = (float*)(C.ws + WS_OI); float* KV = (float*)(C.ws + WS_KV);
    LAS float* qe = lds; LAS float* ke = lds + 2112; LAS float* k2 = lds + 4224; LAS float* vs = lds + 6336; LAS float* att = lds + 10432;
    const int tid = TID;
    for (int item = bid; item < NB * 4 * 64; item += nblk) {
        const int n = item & 63, h = (item >> 6) & 3, b = item >> 8;
        const size_t m0 = (size_t)b * S + n * 64;
        __syncthreads();
        for (int idx = tid; idx < 2048; idx += NT) {
            const int tt = idx >> 5, d = idx & 31;
            const float bb = Bc[(m0 + tt) * 128 + 32 * h + d], bmid = Bc[(m0 + 32) * 128 + 32 * h + d], blast = Bc[(m0 + 63) * 128 + 32 * h + d];
            const float qv = (float)Z[(m0 + tt) * ZP + ZC_LQ + 32 * h + d] * 0.17677669529663687f, kv = (float)Z[(m0 + tt) * ZP + ZC_LK + 32 * h + d];
            qe[tt * 33 + d] = qv * expf(bb - bmid); ke[tt * 33 + d] = kv * expf(bmid - bb); k2[tt * 33 + d] = kv * expf(blast - bb);
            QE2[(m0 + tt) * 128 + 32 * h + d] = qv * expf(bb);
        }
        for (int idx = tid; idx < 4096; idx += NT) { const int tt = idx >> 6, v = idx & 63; vs[idx] = (float)Z[(m0 + tt) * ZP + ZC_LV + 64 * h + v]; }
        __syncthreads();
        for (int idx = tid; idx < 4096; idx += NT) {
            const int tt = idx >> 6, s = idx & 63; float a = 0.f;
            if (s <= tt) { for (int d = 0; d < 32; ++d) a += qe[tt * 33 + d] * ke[s * 33 + d]; }
            att[tt * 65 + s] = a;
        }
        __syncthreads();
        for (int idx = tid; idx < 4096; idx += NT) {
            const int tt = idx >> 6, v = idx & 63; float o = 0.f;
            for (int s = 0; s <= tt; ++s) o += att[tt * 65 + s] * vs[s * 64 + v];
            OI[(m0 + tt) * 256 + 64 * h + v] = o;
        }
        for (int idx = tid; idx < 2048; idx += NT) {
            const int d = idx >> 6, v = idx & 63; float a = 0.f;
            for (int s = 0; s < 64; ++s) a += k2[s * 33 + d] * vs[s * 64 + v];
            KV[(size_t)item * 2048 + idx] = a;
        }
    }
}
__device__ __forceinline__ void ph_gla4(const Ctx& C, int TID, int bid, int nblk) {
    const float* Bc = (const float*)(C.ws + WS_LA); const float* KV = (const float*)(C.ws + WS_KV); float* SP = (float*)(C.ws + WS_SPREV);
    for (int idx = bid * NT + TID; idx < NB * 4 * 2048; idx += nblk * NT) {
        const int dv = idx & 2047, bh = idx >> 11, d = dv >> 6, h = bh & 3, b = bh >> 2;
        float st = 0.f;
        for (int n = 0; n < 64; ++n) {
            SP[((size_t)bh * 64 + n) * 2048 + dv] = st;
            const float dec = expf(Bc[((size_t)b * S + n * 64 + 63) * 128 + 32 * h + d]);
            st = dec * st + KV[((size_t)bh * 64 + n) * 2048 + dv];
        }
    }
}
__device__ __forceinline__ void ph_gla5(const Ctx& C, int l, int TID, int bid, int nblk) {
    const f16* Z = (const f16*)(C.ws + WS_Z); f16* MIX = (f16*)(C.ws + WS_MIX);
    const float* QE2 = (const float*)(C.ws + WS_QE2); const float* OI = (const float*)(C.ws + WS_OI); const float* SP = (const float*)(C.ws + WS_SPREV);
    const float* gain = C.in[12] + (size_t)l * D + 512;
    const int lane = TID & 63, gw = bid * NWAVE + (TID >> 6), ngw = nblk * NWAVE;
    for (int m = gw; m < M; m += ngw) {
        const int b = m / S, t = m % S, n = t >> 6;
        float og[4]; float ss = 0.f;
#pragma unroll
        for (int h = 0; h < 4; ++h) {
            float o = OI[(size_t)m * 256 + 64 * h + lane];
            const float* sp = SP + ((size_t)(b * 4 + h) * 64 + n) * 2048 + lane; const float* qe = QE2 + (size_t)m * 128 + 32 * h;
            for (int d = 0; d < 32; ++d) o += qe[d] * sp[d * 64];
            const float ms = wave_sum(o * o) * (1.f / 64);
            const float gv = (float)Z[(size_t)m * ZP + ZC_LG + 64 * h + lane];
            og[h] = siluf(gv) * (o * rsqrtf(ms + EPS)); ss += og[h] * og[h];
        }
        const float r = rsqrtf(wave_sum(ss) * (1.f / 256) + EPS);
#pragma unroll
        for (int h = 0; h < 4; ++h) MIX[(size_t)m * D + 512 + 64 * h + lane] = (f16)(og[h] * r * gain[64 * h + lane]);
    }
}
__device__ __forceinline__ void ph_gmlp1(const Ctx& C, int TID, int bid, int nblk) {
    const f16* Z = (const f16*)(C.ws + WS_Z); float* VN = (float*)(C.ws + WS_VN);
    const int lane = TID & 63, gw = bid * NWAVE + (TID >> 6), ngw = nblk * NWAVE;
    for (int m = gw; m < M; m += ngw) {
#pragma unroll
        for (int g = 0; g < 4; ++g) {
            const float v = (float)Z[(size_t)m * ZP + ZC_MV + 64 * g + lane];
            const float mu = wave_sum(v) * (1.f / 64), dv = v - mu, var = wave_sum(dv * dv) * (1.f / 64);
            VN[(size_t)m * 256 + 64 * g + lane] = dv * rsqrtf(var + EPS);
        }
    }
}
__device__ __forceinline__ void ph_gmlp2(const Ctx& C, int l, int TID, int bid, int nblk) {
    const f16* Z = (const f16*)(C.ws + WS_Z); f16* MIX = (f16*)(C.ws + WS_MIX); const float* VN = (const float*)(C.ws + WS_VN);
    const float* ws_ = C.in[10] + (size_t)l * 4 * 128 * 128; const float* bs = C.in[11] + (size_t)l * 4 * 128; const float* gain = C.in[12] + (size_t)l * D + 768;
    const int lane = TID & 63, gw = bid * NWAVE + (TID >> 6), ngw = nblk * NWAVE;
    for (int m = gw; m < M; m += ngw) {
        const int tp = m & 127; const size_t mc = (size_t)(m - tp);
        float o[4]; float ss = 0.f;
#pragma unroll
        for (int g = 0; g < 4; ++g) {
            const float* w = ws_ + ((size_t)g * 128 + tp) * 128; float acc = 0.f;
            for (int s = 0; s <= tp; ++s) acc += w[s] * VN[(mc + s) * 256 + 64 * g + lane];
            o[g] = (float)Z[(size_t)m * ZP + ZC_MU + 64 * g + lane] * (acc + bs[g * 128 + tp]); ss += o[g] * o[g];
        }
        const float r = rsqrtf(wave_sum(ss) * (1.f / 256) + EPS);
#pragma unroll
        for (int g = 0; g < 4; ++g) MIX[(size_t)m * D + 768 + 64 * g + lane] = (f16)(o[g] * r * gain[64 * g + lane]);
    }
}

__device__ __forceinline__ void cvt_item(const float* W, int K, int N, f16* WT, bool remap, LAS float* scr, int item, int lane) {
    const int nb_ = (N + 31) / 32, kb = item / nb_, nb = item % nb_, k0 = 64 * kb, n0 = 32 * nb;
#pragma unroll 8
    for (int i = 0; i < 32; ++i) { const int kk = 2 * i + (lane >> 5), n = n0 + (lane & 31); scr[kk * 33 + (lane & 31)] = n < N ? W[(size_t)(k0 + kk) * N + n] : 0.f; }
    WAVE_LDS_SYNC();
    const int c = lane & 7;
#pragma unroll
    for (int j = 0; j < 4; ++j) {
        const int nn = (lane >> 3) + 8 * j, n = n0 + nn;
        if (n < N) {
            const int row = remap ? n + (n >= 1420 ? 4 : 0) : n; const LAS float* s = scr + (8 * c) * 33 + nn;
            f16x8 o;
#pragma unroll
            for (int e = 0; e < 8; ++e) o[e] = (f16)s[e * 33];
            *(f16x8*)(WT + (size_t)row * K + k0 + 8 * c) = o;
        }
    }
    WAVE_LDS_SYNC();
}
__device__ __forceinline__ void ph_wcvt(const Ctx& C, int TID, int bid, int nblk, LAS float* lds) {
    const int lane = TID & 63, wave = TID >> 6, gw = bid * NWAVE + wave, ngw = nblk * NWAVE;
    LAS float* scr = lds + wave * 4096;
    constexpr int I_IN = (D / 64) * ((NIN + 31) / 32), I_O = (D / 64) * (D / 32), I_UP = (D / 64) * (DFF / 32), I_DN = (DFF / 64) * (D / 32), I_PAD = 100, I_L = I_IN + I_O + I_UP + I_DN + I_PAD;
    for (int it = gw; it < DEPTH * I_L; it += ngw) {
        const int l = it / I_L; int r = it % I_L;
        unsigned char* wl = C.ws + WS_W16 + (size_t)l * W16_LAYER;
        if (r < I_IN) { cvt_item(C.in[3] + (size_t)l * D * NIN, D, NIN, (f16*)(wl + W16_WIN), true, scr, r, lane); continue; } r -= I_IN;
        if (r < I_O) { cvt_item(C.in[13] + (size_t)l * D * D, D, D, (f16*)(wl + W16_WO), false, scr, r, lane); continue; } r -= I_O;
        if (r < I_UP) { cvt_item(C.in[17] + (size_t)l * D * DFF, D, DFF, (f16*)(wl + W16_WUP), false, scr, r, lane); continue; } r -= I_UP;
        if (r < I_DN) { cvt_item(C.in[18] + (size_t)l * DFF * D, DFF, D, (f16*)(wl + W16_WDN), false, scr, r, lane); continue; } r -= I_DN;
        const int row = r < 4 ? 1420 + r : 2720 + (r - 4);
        f16x8 z; for (int e = 0; e < 8; ++e) z[e] = (f16)0.f;
        f16* p = (f16*)(wl + W16_WIN) + (size_t)row * D;
        *(f16x8*)(p + 8 * lane) = z; *(f16x8*)(p + 512 + 8 * lane) = z;
    }
}

namespace pg8 {
#define PG8_LAS __attribute__((address_space(3)))
typedef _Float16 bf16_t;
typedef _Float16 bf16x8 __attribute__((ext_vector_type(8)));
typedef float f32x4 __attribute__((ext_vector_type(4)));
typedef unsigned u32x4 __attribute__((ext_vector_type(4)));
constexpr int BM = 256, BK = 64, HALF = 128, HTB = HALF * BK * 2  , STAGE_BYTES = 8 * HTB, NXCD = 8, WGM = 8;

__host__ __device__ __forceinline__ int lds_byte(int r, int c) { const int st = (r >> 4) * 2 + (c >> 5), rr = r & 15, cc = c & 31, ob = rr * 64 + cc * 2; return st * 1024 + (ob ^ (((ob >> 9) & 1) << 5)); }
__host__ __device__ __forceinline__ void stage_rc(int b, int& R, int& C) { const int st = b / 1024, sb = b % 1024, swz = sb ^ (((sb >> 9) & 1) << 5); R = (st >> 1) * 16 + swz / 64; C = (st & 1) * 32 + (swz % 64) / 2; }
__host__ __device__ __forceinline__ int perm32(int rho) { const int n = rho >> 4, i = rho & 15; return 8 * (i >> 2) + 4 * n + (i & 3); }

struct Unit { int pm, pn; };
struct Gemm { const bf16_t* A; const bf16_t* Bt; int M, N, K; };

struct StaticOrder {
    int nM, nN, nwg, G, c;
    __host__ __device__ void init(int M, int N, int G_, int c_) { nM = M / BM; nN = N / BM; nwg = nM * nN; G = G_; c = c_; }
    __host__ __device__ bool next(int i, Unit& u) const {
        const long L = (long)i * G + c; if (L >= nwg) return false;
        int wgid = (int)L; { const int q = nwg / NXCD, r = nwg % NXCD, xcd = wgid % NXCD, off = wgid / NXCD; wgid = (xcd < r ? xcd * (q + 1) : r * (q + 1) + (xcd - r) * q) + off; }
        const int nig = WGM * nN, gid = wgid / nig, fm = gid * WGM, gsz = (nM - fm) < WGM ? (nM - fm) : WGM;
        u.pm = fm + ((wgid % nig) % gsz); u.pn = (wgid % nig) / gsz; return true;
    }
    __device__ __forceinline__ void a_ready(const Unit&) const {}
    __device__ __forceinline__ void done(const Unit&) const {}
};


template <int ACT> struct EpiF16 {
    static constexpr bool PERM = true, AFTER_DRAIN = false;
    bf16_t* O; int ldc;
    __device__ __forceinline__ void operator()(const f32x4 (&acc)[2][2][4][2], const Unit& u, int wr, int wc, int fr, int fq) const {
        const int row0 = u.pm * BM + wr * 64 + fr, col0 = u.pn * BM + wc * 32 + 8 * fq;
#pragma unroll
        for (int ai = 0; ai < 2; ++ai)
#pragma unroll
            for (int m = 0; m < 4; ++m) { bf16_t* rowp = O + (size_t)(row0 + ai * HALF + m * 16) * ldc + col0;
#pragma unroll
                for (int bj = 0; bj < 2; ++bj) { f32x4 v0 = acc[ai][bj][m][0], v1 = acc[ai][bj][m][1];
                    if (ACT == 1) {
#pragma unroll
                        for (int e = 0; e < 4; ++e) { const float a = fmaxf(v0[e], 0.f), b = fmaxf(v1[e], 0.f); v0[e] = a * a; v1[e] = b * b; } }
                    bf16x8 w; w[0] = (bf16_t)v0[0]; w[1] = (bf16_t)v0[1]; w[2] = (bf16_t)v0[2]; w[3] = (bf16_t)v0[3]; w[4] = (bf16_t)v1[0]; w[5] = (bf16_t)v1[1]; w[6] = (bf16_t)v1[2]; w[7] = (bf16_t)v1[3];
                    *(bf16x8*)(rowp + bj * HALF) = w; } }
    }
};
template <class Epi, class Sched, bool ALIGN_EPI = false, bool SP2 = false>
__device__ __forceinline__ void gemm_phase(PG8_LAS unsigned char* lds, const Gemm g, const Sched& S, const Epi& E, const int tid) {
    const int  wid = __builtin_amdgcn_readfirstlane(tid >> 6), lane = tid & 63, wr = wid >> 2, wc = wid & 3, fr = lane & 15, fq = lane >> 4;
    const int K = g.K, nt = K / BK;
    unsigned voffA[2], voffB[2];
#pragma unroll
    for (int i = 0; i < 2; ++i) { int R, C; stage_rc(tid * 16 + i * 8192, R, C); const int Rb = Epi::PERM ? ((R & ~31) + perm32(R & 31)) : R;
        voffA[i] = (unsigned)(R * K + C) * 2u; voffB[i] = (unsigned)(Rb * K + C) * 2u; }
    const size_t kstep = (size_t)(BK * 2);
    const size_t hstep = (size_t)HALF * K * 2;
    const size_t tstep = 2 * hstep;
    const unsigned ldsw = (unsigned)wid * 1024u;
    const int aoff = lds_byte(wr * 64 + fr, fq * 8), boff = lds_byte(wc * 32 + fr, fq * 8);
#define PG8_SA(b, h) (((b) * 2 + (h)) * HTB)
#define PG8_SB(b, h) ((4 + (b) * 2 + (h)) * HTB)
#define PG8_STAGE(bufoff, gbase, voff) do { _Pragma("unroll") for (int _i = 0; _i < 2; ++_i) \
        __builtin_amdgcn_global_load_lds((const unsigned*)((const char*)(gbase) + (voff)[_i]), (PG8_LAS unsigned*)(lds + (bufoff) + ldsw + _i * 8192), 16, 0, 0); } while (0)
#define PG8_LDA(dst, b, h) do { _Pragma("unroll") for (int m = 0; m < 4; ++m) _Pragma("unroll") for (int k = 0; k < 2; ++k) dst[m][k] = *(const PG8_LAS bf16x8*)(lds + PG8_SA(b, h) + aoff + m * 2048 + k * 1024); } while (0)
#define PG8_LDB(dst, b, h) do { _Pragma("unroll") for (int n = 0; n < 2; ++n) _Pragma("unroll") for (int k = 0; k < 2; ++k) dst[n][k] = *(const PG8_LAS bf16x8*)(lds + PG8_SB(b, h) + boff + n * 2048 + k * 1024); } while (0)
#define PG8_MMA(ai, bj, At, Bt) do { __builtin_amdgcn_s_setprio(1); _Pragma("unroll") for (int m = 0; m < 4; ++m) _Pragma("unroll") for (int n = 0; n < 2; ++n) _Pragma("unroll") for (int k = 0; k < 2; ++k) \
        acc[ai][bj][m][n] = __builtin_amdgcn_mfma_f32_16x16x32_f16(Bt[n][k], At[m][k], acc[ai][bj][m][n], 0, 0, 0); __builtin_amdgcn_s_setprio(0); } while (0)
#define PG8_WAIT_V(n) asm volatile("s_waitcnt vmcnt(" #n ")" ::: "memory")
#define PG8_WAIT_L(n) asm volatile("s_waitcnt lgkmcnt(" #n ")" ::: "memory")
#define PG8_BAR __builtin_amdgcn_s_barrier()
#define PG8_SCHED __builtin_amdgcn_sched_barrier(0)
    Unit cur, nxt; int ui = 0;
    if (!S.next(0, cur)) return;
    f32x4 acc[2][2][4][2];
#pragma unroll
    for (int a = 0; a < 2; ++a)
#pragma unroll
        for (int b = 0; b < 2; ++b)
#pragma unroll
            for (int m = 0; m < 4; ++m)
#pragma unroll
                for (int n = 0; n < 2; ++n) acc[a][b][m][n] = (f32x4){0.f, 0.f, 0.f, 0.f};
    bf16x8 At[4][2], B0[2][2], B1[2][2];
    const char* cA = (const char*)g.A + (size_t)cur.pm * tstep; const char* cB = (const char*)g.Bt + (size_t)cur.pn * tstep;
    S.a_ready(cur);
    if constexpr (SP2) {
        PG8_STAGE(PG8_SB(0, 0), cB, voffB); PG8_STAGE(PG8_SB(0, 1), cB + hstep, voffB); PG8_STAGE(PG8_SA(0, 0), cA, voffA); PG8_STAGE(PG8_SA(0, 1), cA + hstep, voffA);
        if (wr == 1) PG8_BAR;
        PG8_WAIT_V(2); PG8_BAR;
        PG8_STAGE(PG8_SB(1, 0), cB + kstep, voffB); PG8_STAGE(PG8_SA(1, 0), cA + kstep, voffA); PG8_STAGE(PG8_SB(1, 1), cB + hstep + kstep, voffB);
        PG8_WAIT_V(6); PG8_BAR;
    } else {
        PG8_STAGE(PG8_SB(0, 0), cB, voffB); PG8_STAGE(PG8_SA(0, 0), cA, voffA); PG8_STAGE(PG8_SB(0, 1), cB + hstep, voffB); PG8_STAGE(PG8_SA(0, 1), cA + hstep, voffA);
        if (wr == 1) PG8_BAR;
        PG8_WAIT_V(4); PG8_BAR;
        PG8_STAGE(PG8_SB(1, 0), cB + kstep, voffB); PG8_STAGE(PG8_SA(1, 0), cA + kstep, voffA); PG8_STAGE(PG8_SB(1, 1), cB + hstep + kstep, voffB);
        PG8_WAIT_V(6); PG8_BAR;
    }
    for (;;) {
        const bool has_next = S.next(ui + 1, nxt);
        const char* nA = has_next ? (const char*)g.A + (size_t)nxt.pm * tstep : cA; const char* nB = has_next ? (const char*)g.Bt + (size_t)nxt.pn * tstep : cB;
        for (int t = 0; t < nt; t += 2) {
            const bool last = (t == nt - 2);
            const char* a1 = cA + (size_t)(t + 1) * kstep;
            const char* a2 = last ? nA : cA + (size_t)(t + 2) * kstep; const char* b2 = last ? nB : cB + (size_t)(t + 2) * kstep;
            const char* a3 = a2 + kstep; const char* b3 = b2 + kstep;
            if (last && has_next) S.a_ready(nxt);
            if constexpr (SP2) {
            PG8_LDB(B0, 0, 0); PG8_LDB(B1, 0, 1); PG8_SCHED; PG8_LDA(At, 0, 0); PG8_STAGE(PG8_SA(1, 1), a1 + hstep, voffA);
            PG8_WAIT_V(8); PG8_WAIT_L(0); PG8_BAR; PG8_MMA(0, 0, At, B0); PG8_MMA(0, 1, At, B1); PG8_BAR; PG8_SCHED;
            PG8_LDA(At, 0, 1); PG8_STAGE(PG8_SB(0, 0), b2, voffB); PG8_STAGE(PG8_SB(0, 1), b2 + hstep, voffB); PG8_STAGE(PG8_SA(0, 0), a2, voffA);
            PG8_WAIT_V(8); PG8_WAIT_L(0); PG8_BAR; PG8_MMA(1, 0, At, B0); PG8_MMA(1, 1, At, B1); PG8_BAR; PG8_SCHED;
            PG8_LDB(B0, 1, 0); PG8_LDB(B1, 1, 1); PG8_SCHED; PG8_LDA(At, 1, 0); PG8_STAGE(PG8_SA(0, 1), a2 + hstep, voffA);
            PG8_WAIT_V(8); PG8_WAIT_L(0); PG8_BAR; PG8_MMA(0, 0, At, B0); PG8_MMA(0, 1, At, B1); PG8_BAR; PG8_SCHED;
            PG8_LDA(At, 1, 1); PG8_STAGE(PG8_SB(1, 0), b3, voffB); PG8_STAGE(PG8_SB(1, 1), b3 + hstep, voffB); PG8_STAGE(PG8_SA(1, 0), a3, voffA);
            PG8_WAIT_V(8); PG8_WAIT_L(0); PG8_BAR; PG8_MMA(1, 0, At, B0); PG8_MMA(1, 1, At, B1); PG8_BAR; PG8_SCHED;
            } else {
            PG8_LDB(B0, 0, 0); PG8_SCHED; PG8_LDA(At, 0, 0); PG8_STAGE(PG8_SA(1, 1), a1 + hstep, voffA);
            PG8_WAIT_L(8); PG8_BAR; PG8_WAIT_L(0); PG8_MMA(0, 0, At, B0); PG8_BAR; PG8_SCHED;
            PG8_LDB(B1, 0, 1); PG8_STAGE(PG8_SB(0, 0), b2, voffB);
            PG8_BAR; PG8_WAIT_L(0); PG8_MMA(0, 1, At, B1); PG8_BAR;
            PG8_LDA(At, 0, 1); PG8_STAGE(PG8_SA(0, 0), a2, voffA);
            PG8_BAR; PG8_WAIT_L(0); PG8_MMA(1, 0, At, B0); PG8_BAR; PG8_SCHED;
            PG8_STAGE(PG8_SB(0, 1), b2 + hstep, voffB);
            PG8_WAIT_V(6); PG8_BAR; PG8_MMA(1, 1, At, B1); PG8_BAR;
            PG8_LDB(B0, 1, 0); PG8_SCHED; PG8_LDA(At, 1, 0); PG8_STAGE(PG8_SA(0, 1), a2 + hstep, voffA);
            PG8_WAIT_L(8); PG8_BAR; PG8_WAIT_L(0); PG8_MMA(0, 0, At, B0); PG8_BAR; PG8_SCHED;
            PG8_LDB(B1, 1, 1); PG8_STAGE(PG8_SB(1, 0), b3, voffB);
            PG8_BAR; PG8_WAIT_L(0); PG8_MMA(0, 1, At, B1); PG8_BAR;
            PG8_LDA(At, 1, 1); PG8_STAGE(PG8_SA(1, 0), a3, voffA);
            PG8_BAR; PG8_WAIT_L(0); PG8_MMA(1, 0, At, B0); PG8_BAR; PG8_SCHED;
            PG8_STAGE(PG8_SB(1, 1), b3 + hstep, voffB);
            PG8_WAIT_V(6); PG8_BAR; PG8_MMA(1, 1, At, B1); PG8_BAR;
            }
        }
        if constexpr (ALIGN_EPI) { if (wr == 0) PG8_BAR; }
        if constexpr (!Epi::AFTER_DRAIN) { E(acc, cur, wr, wc, fr, fq); S.done(cur); }
        if (!has_next) break;
#pragma unroll
        for (int a = 0; a < 2; ++a)
#pragma unroll
            for (int b = 0; b < 2; ++b)
#pragma unroll
                for (int m = 0; m < 4; ++m)
#pragma unroll
                    for (int n = 0; n < 2; ++n) acc[a][b][m][n] = (f32x4){0.f, 0.f, 0.f, 0.f};
        cur = nxt; cA = nA; cB = nB; ++ui;
        if constexpr (ALIGN_EPI) { if (wr == 1) PG8_BAR; }
    }
    PG8_WAIT_V(0);
    if constexpr (!ALIGN_EPI) { if (wr == 0) PG8_BAR; }
    PG8_BAR;
    if constexpr (Epi::AFTER_DRAIN) { E.fused(acc, cur, wr, wc, fr, fq, lds, wid, lane); S.done(cur); }
#undef PG8_SA
#undef PG8_SB
#undef PG8_STAGE
#undef PG8_LDA
#undef PG8_LDB
#undef PG8_MMA
#undef PG8_WAIT_V
#undef PG8_WAIT_L
#undef PG8_BAR
#undef PG8_SCHED
}
}

#define XB_TMO      128
#define XB_XCNT(j)  (256  + 64 * (j))
#define XB_XSUB(j)  (1280 + 64 * (j))
#define XB_XGEN(j)  (2304 + 64 * (j))
#define XB_TOP      3328
#define XB_TOPGEN   3392
#define XCD_BAR_WORDS 3456
#define XB_SPIN_CAP (1u << 18)

__device__ __forceinline__ unsigned xb_ld(unsigned* p)              { return __hip_atomic_load(p, __ATOMIC_RELAXED, __HIP_MEMORY_SCOPE_AGENT); }
__device__ __forceinline__ unsigned xb_add(unsigned* p, unsigned v) { return __hip_atomic_fetch_add(p, v, __ATOMIC_RELAXED, __HIP_MEMORY_SCOPE_AGENT); }
__device__ __forceinline__ unsigned xb_xcc_id() { return (unsigned)__builtin_amdgcn_s_getreg((3 << 11) | 20) & 0xFu; }
#define XB_SPIN(cond, bar) do { unsigned _sp = 0; while (cond) { __builtin_amdgcn_s_sleep(1); \
    if ((++_sp & 255u) == 0u) { if (xb_ld(&(bar)[XB_TMO])) break; if (_sp > XB_SPIN_CAP) { atomicAdd(&(bar)[XB_TMO], 1u); break; } } } } while (0)

struct XcdBarrier {
    unsigned* bar; unsigned x;
    volatile LAS unsigned* st;
};

__device__ __forceinline__ XcdBarrier xcd_barrier_post(unsigned* bar, volatile LAS unsigned* st) {
    XcdBarrier b; b.bar = bar; b.x = xb_xcc_id(); b.st = st;
    if (threadIdx.x == 0) (void)xb_add(&bar[XB_XCNT(b.x)], 1u);
    return b;
}
__device__ __forceinline__ void xcd_barrier_complete(unsigned* bar, unsigned x, unsigned& nloc, unsigned& nx) {
    const unsigned G = gridDim.x * gridDim.y * gridDim.z;
    unsigned sum, cnt, mine, sp = 0u;
    for (;;) {
        sum = 0u; cnt = 0u; mine = 0u;
#pragma unroll
        for (unsigned j = 0; j < 16; ++j) { const unsigned c = xb_ld(&bar[XB_XCNT(j)]); sum += c; cnt += (c > 0u) ? 1u : 0u; mine = (j == x) ? c : mine; }
        if (sum == G) break;
        __builtin_amdgcn_s_sleep(1);
        if ((++sp & 255u) == 0u) { if (xb_ld(&bar[XB_TMO])) break; if (sp > XB_SPIN_CAP) { atomicAdd(&bar[XB_TMO], 1u); break; } }
    }
    nloc = mine > 0u ? mine : 1u; nx = cnt > 0u ? cnt : 1u;
}

__device__ __forceinline__ void xcd_barrier(const XcdBarrier& b) {
    asm volatile("s_waitcnt vmcnt(0)" ::: "memory");
    __syncthreads();
    if (threadIdx.x == 0) {
        unsigned* bar = b.bar;
        __builtin_amdgcn_s_waitcnt(0);
        unsigned nloc = b.st[0], nx = b.st[1];
        if (nloc == 0u) { xcd_barrier_complete(bar, b.x, nloc, nx); b.st[0] = nloc; b.st[1] = nx; }
        const unsigned old = xb_add(&bar[XB_XSUB(b.x)], 1u);
        const unsigned gen = old / nloc;
        if (old + 1u == (gen + 1u) * nloc) {
            __builtin_amdgcn_fence(__ATOMIC_RELEASE, "agent");
            asm volatile("s_waitcnt vmcnt(0)" ::: "memory");
            const unsigned og = xb_add(&bar[XB_TOP], 1u);
            const unsigned tg = og / nx;
            if (og + 1u == (tg + 1u) * nx) xb_add(&bar[XB_TOPGEN], 1u);
            else XB_SPIN(xb_ld(&bar[XB_TOPGEN]) == tg, bar);
            __builtin_amdgcn_fence(__ATOMIC_ACQUIRE, "agent");
            xb_add(&bar[XB_XGEN(b.x)], 1u);
            asm volatile("s_waitcnt vmcnt(0)" ::: "memory");
        } else {
            XB_SPIN(xb_ld(&bar[XB_XGEN(b.x)]) == gen, bar);
            __builtin_amdgcn_fence(__ATOMIC_ACQUIRE, "agent");
            asm volatile("s_waitcnt vmcnt(0)" ::: "memory");
        }
    }
    __syncthreads();
}

constexpr int CW_BAR = 4096;
constexpr int LDS_MISC = LDS_BYTES - 256;
#define LAUNDER(v) asm volatile("" : "+s"(v))
__global__ void __launch_bounds__(NT, 2) k_mega(Ctx Carg) {
    extern __shared__ __attribute__((aligned(16))) unsigned char lds_raw[];
    LAS float* lds = (LAS float*)lds_raw;
    const int bid = blockIdx.x, nblk = gridDim.x;
    for (int u = threadIdx.x; u < 64; u += NT) ((LAS unsigned*)((LAS unsigned char*)lds_raw + LDS_MISC))[u] = 0u;
    __syncthreads();
    const Ctx* Cp = (const Ctx*)__builtin_amdgcn_kernarg_segment_ptr();
    XcdBarrier bar = xcd_barrier_post((unsigned*)(Cp->ws + WS_CTL) + CW_BAR, (volatile LAS unsigned*)((LAS unsigned char*)lds_raw + LDS_MISC + 32));
#ifndef PMASK
#define PMASK 0xFFFFF
#endif
#define SITE(k, ...) do { if (!((PMASK >> (k)) & 1)) break; const Ctx* cp_ = Cp; LAUNDER(cp_); const Ctx C = *cp_; int ll = l; LAUNDER(ll); int tid_ = threadIdx.x; asm volatile("" : "+v"(tid_)); int bid_ = bid; LAUNDER(bid_); int nblk_ = nblk; LAUNDER(nblk_); \
        f16* H = (f16*)(C.ws + WS_H); f16* Zb = (f16*)(C.ws + WS_Z); f16* MIX = (f16*)(C.ws + WS_MIX); f16* Y = (f16*)(C.ws + WS_Y); f16* U = (f16*)(C.ws + WS_BIG); \
        (void)H; (void)Zb; (void)MIX; (void)Y; (void)U; __VA_ARGS__; } while (0); { XcdBarrier b_ = bar; LAUNDER(b_.x); LAUNDER(b_.bar); xcd_barrier(b_); }
    int l = 0;
    SITE(0, ph_mod(C, tid_, bid_, nblk_); ph_rope(C, tid_, bid_, nblk_); ph_wcvt(C, tid_, bid_, nblk_, lds));
    SITE(1, ph_norm0(C, tid_, bid_, nblk_));
    for (l = 0; l < DEPTH; ++l) {
        SITE(2, { pg8::Gemm g{H, (const f16*)(C.ws + WS_W16 + (size_t)ll * W16_LAYER + W16_WIN), M, ZP, D}; pg8::StaticOrder S; S.init(M, ZP, nblk_, bid_); pg8::EpiF16<0> E{Zb, ZP}; pg8::gemm_phase<pg8::EpiF16<0>, pg8::StaticOrder, true, true>((LAS unsigned char*)lds, g, S, E, tid_); });
        SITE(3, ph_conv(C, ll, tid_, bid_, nblk_); ph_rotk(C, tid_, bid_, nblk_); ph_cmp1(C, ll, tid_, bid_, nblk_); ph_gla1(C, ll, tid_, bid_, nblk_); ph_gmlp1(C, tid_, bid_, nblk_));
        SITE(4, ph_cmp2(C, ll, tid_, bid_, nblk_); ph_gla2(C, tid_, bid_, nblk_); ph_gmlp2(C, ll, tid_, bid_, nblk_));
        SITE(5, ph_nsa(C, ll, tid_, bid_, nblk_, lds); __syncthreads(); ph_gla3(C, tid_, bid_, nblk_, lds));
        SITE(6, ph_gla4(C, tid_, bid_, nblk_));
        SITE(7, ph_gla5(C, ll, tid_, bid_, nblk_));
        SITE(8, { pg8::Gemm g{MIX, (const f16*)(C.ws + WS_W16 + (size_t)ll * W16_LAYER + W16_WO), M, D, D}; pg8::StaticOrder S; S.init(M, D, nblk_, bid_); pg8::EpiF16<0> E{Y, D}; pg8::gemm_phase<pg8::EpiF16<0>, pg8::StaticOrder, true, true>((LAS unsigned char*)lds, g, S, E, tid_); });
        SITE(9, ph_resnorm(C, ll, 0, tid_, bid_, nblk_));
        SITE(10, { pg8::Gemm g{H, (const f16*)(C.ws + WS_W16 + (size_t)ll * W16_LAYER + W16_WUP), M, DFF, D}; pg8::StaticOrder S; S.init(M, DFF, nblk_, bid_); pg8::EpiF16<1> E{U, DFF}; pg8::gemm_phase<pg8::EpiF16<1>, pg8::StaticOrder, true, true>((LAS unsigned char*)lds, g, S, E, tid_); });
        SITE(11, { pg8::Gemm g{U, (const f16*)(C.ws + WS_W16 + (size_t)ll * W16_LAYER + W16_WDN), M, D, DFF}; pg8::StaticOrder S; S.init(M, D, nblk_, bid_); pg8::EpiF16<0> E{Y, D}; pg8::gemm_phase<pg8::EpiF16<0>, pg8::StaticOrder, true, true>((LAS unsigned char*)lds, g, S, E, tid_); });
        SITE(12, ph_resnorm(C, ll, 1, tid_, bid_, nblk_));
    }
#undef SITE
}

extern "C" void kernel_launch(void* const* d_in, const int* in_sizes, int n_in, void* d_out, int out_size, void* d_ws, size_t ws_size, hipStream_t stream) {
    static int grid = 0;
    if (grid == 0) {
        if (n_in != 19 || ws_size < WS_END) { fprintf(stderr, "kernel_launch: unexpected n_in %d / ws_size %zu\n", n_in, ws_size); grid = -1; return; }
        int dev = 0, cus = 0, per_cu = 0;
        if (hipGetDevice(&dev) != hipSuccess || hipDeviceGetAttribute(&cus, hipDeviceAttributeMultiprocessorCount, dev) != hipSuccess) { grid = -1; return; }
        if (hipFuncSetAttribute((const void*)k_mega, hipFuncAttributeMaxDynamicSharedMemorySize, LDS_BYTES) != hipSuccess) { fprintf(stderr, "hipFuncSetAttribute failed\n"); grid = -1; return; }
        if (hipOccupancyMaxActiveBlocksPerMultiprocessor(&per_cu, (const void*)k_mega, NT, LDS_BYTES) != hipSuccess || per_cu < 1) { fprintf(stderr, "occupancy query: %d\n", per_cu); }
        (void)hipGetLastError();
        grid = cus;
    }
    if (grid < 0) return;
    if (hipMemsetAsync((char*)d_ws + WS_CTL, 0, 1 * MiB, stream) != hipSuccess) return;
    Ctx c{};
    for (int i = 0; i < 19; ++i) c.in[i] = (const float*)d_in[i];
    c.out = (float*)d_out; c.ws = (unsigned char*)d_ws;
    hipLaunchKernelGGL(k_mega, dim3(grid), dim3(NT), LDS_BYTES, stream, c);
}
```

```cpp
#include <hip/hip_runtime.h>
#include <cstdint>
#include <cstdio>

#define LAS __attribute__((address_space(3)))
typedef _Float16 f16;
typedef f16 f16x4 __attribute__((ext_vector_type(4)));
typedef f16 f16x8 __attribute__((ext_vector_type(8)));
typedef float f32x4 __attribute__((ext_vector_type(4)));

constexpr int D = 1024, NB = 8, S = 4096, DEPTH = 4, M = NB * S, DFF = 4096;
constexpr int NIN = 2716, ZP = 2816;
constexpr int ZC_AH = 0, ZC_AB = 256, ZC_AC = 512, ZC_NQ = 768, ZC_KCMP = 1024, ZC_VCMP = 1088, ZC_KSLC = 1152, ZC_VSLC = 1216,
              ZC_KWIN = 1280, ZC_VWIN = 1344, ZC_NG = 1408, ZC_LQ = 1424, ZC_LK = 1552, ZC_LV = 1680, ZC_LG = 1936, ZC_LR = 2192,
              ZC_MU = 2208, ZC_MV = 2464;
constexpr int NCMP = 255;
constexpr float EPS = 1e-6f;
constexpr int NT = 512, NWAVE = 8;

constexpr size_t MiB = 1u << 20;
constexpr size_t WS_CTL = 0;
constexpr size_t WS_MOD = 1 * MiB;
constexpr size_t WS_ROPE = 2 * MiB;
constexpr size_t WS_W16 = 4 * MiB;
constexpr size_t WS_H = 98 * MiB;
constexpr size_t WS_Y = 162 * MiB;
constexpr size_t WS_BIG = 226 * MiB;
constexpr size_t WS_Z = WS_BIG;
constexpr size_t WS_MIX = WS_BIG + 176 * MiB;
constexpr size_t WS_KSR = WS_BIG + 240 * MiB;
constexpr size_t WS_KWR = WS_BIG + 244 * MiB;
constexpr size_t WS_HID = WS_BIG + 248 * MiB;
constexpr size_t WS_KC = WS_BIG + 251 * MiB;
constexpr size_t WS_VC = WS_BIG + 252 * MiB;
constexpr size_t WS_OCMP = 482 * MiB;
constexpr size_t WS_END = 498 * MiB;
constexpr size_t WS_LA = WS_H;
constexpr size_t WS_QE2 = WS_H + 16 * MiB;
constexpr size_t WS_OI = WS_H + 32 * MiB;
constexpr size_t WS_KV = WS_Y;
constexpr size_t WS_SPREV = WS_Y + 16 * MiB;
constexpr size_t WS_VN = WS_Y + 32 * MiB;

constexpr size_t W16_WIN = 0, W16_WO = (size_t)ZP * D * 2, W16_WUP = W16_WO + (size_t)D * D * 2, W16_WDN = W16_WUP + (size_t)DFF * D * 2, W16_LAYER = W16_WDN + (size_t)D * DFF * 2;
static_assert(WS_W16 + DEPTH * W16_LAYER <= WS_H, "weight copies fit below H");

constexpr int LDS_BYTES = 147456;

struct Ctx {
    const float* in[19];
    float* out;
    unsigned char* ws;
    int lo, hi;
};

__device__ __forceinline__ float wave_sum(float v) {
#pragma unroll
    for (int o = 32; o > 0; o >>= 1) v += __shfl_xor(v, o);
    return v;
}
__device__ __forceinline__ float wave_max(float v) {
#pragma unroll
    for (int o = 32; o > 0; o >>= 1) v = fmaxf(v, __shfl_xor(v, o));
    return v;
}
#define WAVE_LDS_SYNC() asm volatile("s_waitcnt lgkmcnt(0)" ::: "memory")
__device__ __forceinline__ float siluf(float v) { return v / (1.f + expf(-v)); }
__device__ __forceinline__ float sigmoidf_(float v) { return 1.f / (1.f + expf(-v)); }

__device__ __forceinline__ void sincos_d(double a, double& s, double& c) {
    const double two_over_pi = 0.63661977236758134308, pio2_hi = 1.57079632679489655800e+00, pio2_lo = 6.12323399573676603587e-17;
    const double kq = rint(a * two_over_pi);
    double r = (a - kq * pio2_hi) - kq * pio2_lo;
    const double r2 = r * r;
    double sp = r * (1.0 + r2 * (-1.0 / 6 + r2 * (1.0 / 120 + r2 * (-1.0 / 5040 + r2 * (1.0 / 362880 + r2 * (-1.0 / 39916800 + r2 * (1.0 / 6227020800.0 + r2 * (-1.0 / 1307674368000.0))))))));
    double cp = 1.0 + r2 * (-0.5 + r2 * (1.0 / 24 + r2 * (-1.0 / 720 + r2 * (1.0 / 40320 + r2 * (-1.0 / 3628800 + r2 * (1.0 / 479001600.0 + r2 * (-1.0 / 87178291200.0 + r2 * (1.0 / 20922789888000.0))))))));
    const int q = ((int)kq) & 3;
    if (q == 0) { s = sp; c = cp; } else if (q == 1) { s = cp; c = -sp; } else if (q == 2) { s = -sp; c = -cp; } else { s = -cp; c = sp; }
}

__device__ __forceinline__ void ph_mod(const Ctx& C, int TID, int bid, int nblk) {
    const float* c = C.in[1]; const float* w_mod = C.in[15]; const float* b_mod = C.in[16];
    float* MOD = (float*)(C.ws + WS_MOD);
    const int total = DEPTH * NB * 6 * D;
    for (int idx = bid * NT + TID; idx < total; idx += nblk * NT) {
        const int n = idx % (6 * D), bb = (idx / (6 * D)) % NB, l = idx / (6 * D * NB);
        float acc = b_mod[l * 6 * D + n];
        const float* w = w_mod + (size_t)l * D * 6 * D + n;
        for (int k = 0; k < D; ++k) { const float cv = c[bb * D + k]; acc += siluf(cv) * w[(size_t)k * 6 * D]; }
        MOD[idx] = acc;
    }
}
__device__ __forceinline__ void ph_rope(const Ctx& C, int TID, int bid, int nblk) {
    const int* pos = (const int*)C.in[2];
    float* RC = (float*)(C.ws + WS_ROPE); float* RS = RC + (size_t)M * 8;
    const double invf[8] = {1.0, 0.19392274474868576, 0.03760603093086393, 0.007292664737217109, 0.001414213562373095, 0.0002742481756762073, 5.318295896944988e-05, 1.031338537721246e-05};
    for (int idx = bid * NT + TID; idx < M * 8; idx += nblk * NT) {
        const int i = idx & 7, m = idx >> 3;
        double f = invf[0];
#pragma unroll
        for (int j = 1; j < 8; ++j) f = (i == j) ? invf[j] : f;
        double s, c; sincos_d((double)pos[m] * f, s, c);
        RC[idx] = (float)c; RS[idx] = (float)s;
    }
}
__device__ __forceinline__ void adaln_row(const float (&xv)[16], const float* g, const float* sc, const float* sh, f16* hrow, int lane) {
    float ss = 0.f;
#pragma unroll
    for (int j = 0; j < 16; ++j) ss += xv[j] * xv[j];
    const float r = rsqrtf(wave_sum(ss) * (1.f / D) + EPS);
#pragma unroll
    for (int j = 0; j < 4; ++j) {
        const int c0 = 256 * j + 4 * lane;
        const f32x4 gv = *(const f32x4*)(g + c0), scv = *(const f32x4*)(sc + c0), shv = *(const f32x4*)(sh + c0);
        f16x4 o;
#pragma unroll
        for (int e = 0; e < 4; ++e) o[e] = (f16)(xv[4 * j + e] * r * gv[e] * (1.f + scv[e]) + shv[e]);
        *(f16x4*)(hrow + c0) = o;
    }
}
__device__ __forceinline__ void ph_norm0(const Ctx& C, int TID, int bid, int nblk) {
    const float* x = C.in[0]; const float* norm_g = C.in[14]; const float* MOD = (const float*)(C.ws + WS_MOD);
    f16* H = (f16*)(C.ws + WS_H);
    const int lane = TID & 63, gw = bid * NWAVE + (TID >> 6), ngw = nblk * NWAVE;
    for (int m = gw; m < M; m += ngw) {
        const int b = m / S;
        float xv[16];
#pragma unroll
        for (int j = 0; j < 4; ++j) { const f32x4 v = *(const f32x4*)(x + (size_t)m * D + 256 * j + 4 * lane); xv[4 * j] = v[0]; xv[4 * j + 1] = v[1]; xv[4 * j + 2] = v[2]; xv[4 * j + 3] = v[3]; }
        const float* mod = MOD + (size_t)(0 * NB + b) * 6 * D;
        adaln_row(xv, norm_g + 0, mod + D, mod + 0, H + (size_t)m * D, lane);
    }
}
__device__ __forceinline__ void ph_resnorm(const Ctx& C, int l, int sub, int TID, int bid, int nblk) {
    const float* norm_g = C.in[14]; const float* MOD = (const float*)(C.ws + WS_MOD);
    const f16* Y = (const f16*)(C.ws + WS_Y); f16* H = (f16*)(C.ws + WS_H);
    const float* xsrc = (l == 0 && sub == 0) ? C.in[0] : C.out;
    const float* ga = norm_g + (size_t)(l * 4 + (sub == 0 ? 1 : 3)) * D;
    const bool has_next = !(l == DEPTH - 1 && sub == 1);
    const int ln = sub == 0 ? l : l + 1;
    const float* gb = norm_g + (size_t)((has_next ? ln : 0) * 4 + (sub == 0 ? 2 : 0)) * D;
    const int lane = TID & 63, gw = bid * NWAVE + (TID >> 6), ngw = nblk * NWAVE;
    for (int m = gw; m < M; m += ngw) {
        const int b = m / S;
        const float* mod = MOD + (size_t)(l * NB + b) * 6 * D;
        const float* gt = mod + (sub == 0 ? 2 : 5) * D;
        float yv[16], xv[16]; float ss = 0.f;
#pragma unroll
        for (int j = 0; j < 4; ++j) {
            const f16x4 v = *(const f16x4*)(Y + (size_t)m * D + 256 * j + 4 * lane);
#pragma unroll
            for (int e = 0; e < 4; ++e) { yv[4 * j + e] = (float)v[e]; ss += yv[4 * j + e] * yv[4 * j + e]; }
        }
        const float r = rsqrtf(wave_sum(ss) * (1.f / D) + EPS);
#pragma unroll
        for (int j = 0; j < 4; ++j) {
            const int c0 = 256 * j + 4 * lane;
            const f32x4 xo = *(const f32x4*)(xsrc + (size_t)m * D + c0), gav = *(const f32x4*)(ga + c0), gtv = *(const f32x4*)(gt + c0);
            f32x4 xn;
#pragma unroll
            for (int e = 0; e < 4; ++e) { xn[e] = xo[e] + gtv[e] * (yv[4 * j + e] * r * gav[e]); xv[4 * j + e] = xn[e]; }
            *(f32x4*)(C.out + (size_t)m * D + c0) = xn;
        }
        if (has_next) {
            const float* modn = MOD + (size_t)(ln * NB + b) * 6 * D;
            adaln_row(xv, gb, modn + (sub == 0 ? 4 : 1) * D, modn + (sub == 0 ? 3 : 0) * D, H + (size_t)m * D, lane);
        }
    }
}

__device__ __forceinline__ void ph_conv(const Ctx& C, int l, int TID, int bid, int nblk) {
    const f16* Z = (const f16*)(C.ws + WS_Z); f16* MIX = (f16*)(C.ws + WS_MIX);
    const float* cw = C.in[4] + (size_t)l * 3 * 256; const float* gain = C.in[12] + (size_t)l * D;
    const int lane = TID & 63, gw = bid * NWAVE + (TID >> 6), ngw = nblk * NWAVE;
    for (int m = gw; m < M; m += ngw) {
        const int t = m % S;
        float o[4]; float ss = 0.f;
#pragma unroll
        for (int j = 0; j < 4; ++j) {
            const int ch = lane + 64 * j; float y = 0.f;
#pragma unroll
            for (int k = 0; k < 3; ++k) {
                const int tt = t - 2 + k;
                if (tt >= 0) { const f16* zr = Z + (size_t)(m - 2 + k) * ZP; y += (float)zr[ZC_AC + ch] * (float)zr[ZC_AH + ch] * cw[k * 256 + ch]; }
            }
            o[j] = (float)Z[(size_t)m * ZP + ZC_AB + ch] * y; ss += o[j] * o[j];
        }
        const float r = rsqrtf(wave_sum(ss) * (1.f / 256) + EPS);
#pragma unroll
        for (int j = 0; j < 4; ++j) { const int ch = lane + 64 * j; MIX[(size_t)m * D + ch] = (f16)(o[j] * r * gain[ch]); }
    }
}
__device__ __forceinline__ void ph_rotk(const Ctx& C, int TID, int bid, int nblk) {
    const f16* Z = (const f16*)(C.ws + WS_Z); f16* KSR = (f16*)(C.ws + WS_KSR); f16* KWR = (f16*)(C.ws + WS_KWR);
    const float* RC = (const float*)(C.ws + WS_ROPE); const float* RS = RC + (size_t)M * 8;
    for (int idx = bid * NT + TID; idx < M * 128; idx += nblk * NT) {
        const int d = idx & 63, which = (idx >> 6) & 1, m = idx >> 7;
        const f16* zr = Z + (size_t)m * ZP + (which ? ZC_KWIN : ZC_KSLC);
        float v = (float)zr[d];
        if (d < 16) { const int i = d & 7; const float cs = RC[m * 8 + i], sn = RS[m * 8 + i];
            if (d < 8) v = v * cs - (float)zr[d + 8] * sn; else v = v * cs + (float)zr[d - 8] * sn; }
        (which ? KWR : KSR)[(size_t)m * 64 + d] = (f16)v;
    }
}
__device__ __forceinline__ void ph_cmp1(const Ctx& C, int l, int TID, int bid, int nblk) {
    const f16* Z = (const f16*)(C.ws + WS_Z); float* HID = (float*)(C.ws + WS_HID);
    const float* cpos = C.in[5] + (size_t)l * 2 * 32 * 64; const float* w1 = C.in[6] + (size_t)l * 2 * 2048 * 128;
    const int total = 2 * NB * NCMP * 128;
    for (int idx = bid * NT + TID; idx < total; idx += nblk * NT) {
        const int o = idx & 127, i = (idx >> 7) % NCMP, b = ((idx >> 7) / NCMP) % NB, j = (idx >> 7) / (NCMP * NB);
        const float* w = w1 + (size_t)j * 2048 * 128 + o; const float* pp = cpos + j * 2048;
        const f16* zb = Z + (size_t)(b * S + 16 * i) * ZP + (j ? ZC_VCMP : ZC_KCMP);
        float acc = 0.f;
        for (int p = 0; p < 32; ++p)
            for (int d = 0; d < 64; ++d) acc += ((float)zb[(size_t)p * ZP + d] + pp[p * 64 + d]) * w[(size_t)(p * 64 + d) * 128];
        HID[idx] = siluf(acc);
    }
}
__device__ __forceinline__ void ph_cmp2(const Ctx& C, int l, int TID, int bid, int nblk) {
    const float* HID = (const float*)(C.ws + WS_HID); float* KC = (float*)(C.ws + WS_KC); float* VC = (float*)(C.ws + WS_VC);
    const float* w2 = C.in[7] + (size_t)l * 2 * 128 * 64;
    const int total = 2 * NB * NCMP * 64;
    for (int idx = bid * NT + TID; idx < total; idx += nblk * NT) {
        const int d = idx & 63, bi = (idx >> 6) % (NB * NCMP), j = (idx >> 6) / (NB * NCMP);
        const float* hrow = HID + ((size_t)j * NB * NCMP + bi) * 128; const float* w = w2 + (size_t)j * 128 * 64 + d;
        float acc = 0.f;
        for (int o = 0; o < 128; ++o) acc += hrow[o] * w[o * 64];
        (j ? VC : KC)[(size_t)bi * 64 + d] = acc;
    }
}
typedef float f32x16 __attribute__((ext_vector_type(16)));
typedef short s16x4 __attribute__((ext_vector_type(4)));
typedef unsigned u32x4 __attribute__((ext_vector_type(4)));
__device__ __forceinline__ int crow(int r, int hi) { return (r & 3) + 8 * (r >> 2) + 4 * hi; }
__device__ __forceinline__ float pl32_max(float v) { auto rr = __builtin_amdgcn_permlane32_swap(__float_as_uint(v), __float_as_uint(v), false, false); return fmaxf(__uint_as_float(rr[0]), __uint_as_float(rr[1])); }
__device__ __forceinline__ float pl32_sum(float v) { auto rr = __builtin_amdgcn_permlane32_swap(__float_as_uint(v), __float_as_uint(v), false, false); return __uint_as_float(rr[0]) + __uint_as_float(rr[1]); }
__device__ __forceinline__ unsigned pl32_other(unsigned v, int hi) { auto rr = __builtin_amdgcn_permlane32_swap(v, v, false, false); return hi ? rr[0] : rr[1]; }
__device__ __forceinline__ s16x4 vtr(const LAS unsigned char* p) { return __builtin_bit_cast(s16x4, __builtin_amdgcn_ds_read_tr16_b64_v4i16((LAS s16x4*)p)); }
constexpr int NSA_SEL_OFF = 131072;
constexpr int NSA_WSF_OFF = 32768;
constexpr float NSA_C2 = 0.125f * 1.4426950408889634f;

__device__ __forceinline__ void nsa_cmp_unit(const Ctx& C, int b, int c, int TID, LAS float* lds) {
    const f16* Z = (const f16*)(C.ws + WS_Z); f16* OCMP = (f16*)(C.ws + WS_OCMP);
    const float* KC = (const float*)(C.ws + WS_KC); const float* VC = (const float*)(C.ws + WS_VC);
    const int tid = TID, lane = tid & 63, wave = tid >> 6;
    LAS float* kcs = lds;
    LAS float* wsb = lds + 16640 + wave * 1280;
    LAS float* Pc = wsb;
    LAS float* qs = wsb + 1024;
    LAS unsigned long long* SELS = (LAS unsigned long long*)((LAS unsigned char*)lds + NSA_SEL_OFF);
    const float NEG = -__builtin_inff();
    const int t0 = 64 * c; const size_t m0 = (size_t)b * S + t0;
    int nload = (t0 + 63 >= 31) ? (t0 + 63 - 31) / 16 + 1 : 0; if (nload > NCMP) nload = NCMP;
    for (int idx = tid; idx < nload * 64; idx += NT) kcs[(idx >> 6) * 65 + (idx & 63)] = KC[((size_t)b * NCMP + (idx >> 6)) * 64 + (idx & 63)];
    __syncthreads();
    for (int ti = 0; ti < 8; ++ti) {
        const int tt = 8 * wave + ti, t = t0 + tt; const size_t m = m0 + tt;
        const f16* zr = Z + m * ZP;
#pragma unroll
        for (int h = 0; h < 4; ++h) qs[h * 64 + lane] = (float)zr[ZC_NQ + 64 * h + lane];
        WAVE_LDS_SYNC();
        int ncv = t >= 31 ? (t - 31) / 16 + 1 : 0; if (ncv > NCMP) ncv = NCMP;
        float sc[4][4];
#pragma unroll
        for (int h = 0; h < 4; ++h)
#pragma unroll
            for (int r = 0; r < 4; ++r) sc[h][r] = 0.f;
        for (int d = 0; d < 64; ++d) {
            float kv[4];
#pragma unroll
            for (int r = 0; r < 4; ++r) { const int i = lane + 64 * r; kv[r] = (i < ncv) ? kcs[i * 65 + d] : 0.f; }
#pragma unroll
            for (int h = 0; h < 4; ++h) { const float qv = qs[h * 64 + d];
#pragma unroll
                for (int r = 0; r < 4; ++r) sc[h][r] += qv * kv[r]; }
        }
#pragma unroll
        for (int h = 0; h < 4; ++h) {
            float mx = NEG;
#pragma unroll
            for (int r = 0; r < 4; ++r) { const int i = lane + 64 * r; sc[h][r] = (i < ncv) ? sc[h][r] * 0.125f : NEG; mx = fmaxf(mx, sc[h][r]); }
            mx = wave_max(mx);
            float e[4], sum = 0.f;
#pragma unroll
            for (int r = 0; r < 4; ++r) { const int i = lane + 64 * r; e[r] = (i < ncv) ? expf(sc[h][r] - mx) : 0.f; sum += e[r]; }
            sum = wave_sum(sum);
            const float inv = ncv > 0 ? 1.f / sum : 0.f;
#pragma unroll
            for (int r = 0; r < 4; ++r) Pc[h * 256 + lane + 64 * r] = e[r] * inv;
        }
        WAVE_LDS_SYNC();
        float ocmp[4] = {0.f, 0.f, 0.f, 0.f};
        for (int i = 0; i < ncv; ++i) { const float vv = VC[((size_t)b * NCMP + i) * 64 + lane];
#pragma unroll
            for (int h = 0; h < 4; ++h) ocmp[h] += Pc[h * 256 + i] * vv; }
#pragma unroll
        for (int h = 0; h < 4; ++h) { const float g0 = sigmoidf_((float)zr[ZC_NG + 3 * h + 0]); OCMP[m * 256 + 64 * h + lane] = (f16)(g0 * ocmp[h]); }
        float pslc = 0.f;
#pragma unroll
        for (int h = 0; h < 4; ++h) {
            const LAS float* P = Pc + h * 256 + 4 * lane;
            pslc += (lane > 0 ? P[-1] : 0.f) + 2.f * P[0] + 2.f * P[1] + 2.f * P[2] + P[3];
        }
        const int cur = t >> 6;
        const bool forced = (lane < 1) || (cur - lane >= 0 && cur - lane < 2);
        const float score = (lane <= cur) ? pslc + (forced ? 1e4f : 0.f) : -1e30f;
        int rank = 0;
        for (int jj = 0; jj < 64; ++jj) { const float o = __shfl(score, jj); rank += (o > score || (o == score && jj < lane)) ? 1 : 0; }
        const unsigned long long selmask = __ballot(rank < 16);
        if (lane == 0) SELS[tt] = selmask;
        WAVE_LDS_SYNC();
    }
}

#define NSA_ISSUE(jt, slot) do { \
        const f16* ksrc_ = Kg + (size_t)(64 * (jt) + lane) * 64 + wid * 8; \
        const f16* vsrc_ = Vg + (size_t)(64 * (jt) + 16 * (wid & 3) + (lane >> 2)) * ZP + (wid >> 2) * 32 + (lane & 3) * 8; \
        __builtin_amdgcn_global_load_lds((const unsigned*)ksrc_, (LAS unsigned*)(lds + (slot) * 8192 + wid * 1024), 16, 0, 0); \
        __builtin_amdgcn_global_load_lds((const unsigned*)vsrc_, (LAS unsigned*)(lds + 16384 + (slot) * 8192 + wid * 1024), 16, 0, 0); } while (0)

template <int MODE>
__device__ __forceinline__ void nsa_branch(const f16* Kg, const f16* Vg, int c, unsigned long long sel, int tokw, const f16x8 (&qf)[4], f32x16 (&o)[2], float& lsum,
                                           LAS unsigned char* lds, int wid, int lane, int r32, int hi) {
    const float NEG = -__builtin_inff();
    float m = NEG; lsum = 0.f;
#pragma unroll
    for (int r = 0; r < 16; ++r) { o[0][r] = 0.f; o[1][r] = 0.f; }
    LAS float* wsf = (LAS float*)(lds + NSA_WSF_OFF) + wid * 64;
    const int ntiles = MODE == 0 ? c + 1 : (c < 8 ? c + 1 : 9);
    const LAS unsigned char* vlane = lds + 16384 + ((lane >> 4) & 1) * 32 + (lane & 3) * 8 + (4 * hi + ((lane & 15) >> 2)) * 64;
    NSA_ISSUE((MODE == 0 ? 0 : c), 0);
    for (int i = 0; i < ntiles; ++i) {
        const int j = MODE == 0 ? i : c - i, slot = i & 1;
        asm volatile("s_waitcnt vmcnt(0)" ::: "memory");
        __syncthreads();
        if (i + 1 < ntiles) { const int jn = MODE == 0 ? i + 1 : c - i - 1; NSA_ISSUE(jn, slot ^ 1); }
        f32x16 p0, p1;
#pragma unroll
        for (int r = 0; r < 16; ++r) { p0[r] = 0.f; p1[r] = 0.f; }
        const LAS unsigned char* kb = lds + slot * 8192 + hi * 1024 + r32 * 16;
#pragma unroll
        for (int d0 = 0; d0 < 4; ++d0) {
            const f16x8 k0 = *(const LAS f16x8*)(kb + d0 * 2048), k1 = *(const LAS f16x8*)(kb + d0 * 2048 + 512);
            p0 = __builtin_amdgcn_mfma_f32_32x32x16_f16(k0, qf[d0], p0, 0, 0, 0);
            p1 = __builtin_amdgcn_mfma_f32_32x32x16_f16(k1, qf[d0], p1, 0, 0, 0);
        }
        if (j == c) {
#pragma unroll
            for (int r = 0; r < 16; ++r) { const int kk = crow(r, hi); if (kk > tokw) p0[r] = NEG; if (kk + 32 > tokw) p1[r] = NEG; }
        }
        if (MODE == 1 && j == c - 8) {
#pragma unroll
            for (int r = 0; r < 16; ++r) { const int kk = crow(r, hi); if (kk <= tokw) p0[r] = NEG; if (kk + 32 <= tokw) p1[r] = NEG; }
        }
        if (MODE == 0) {
            const bool rowsel = (sel >> j) & 1ull;
#pragma unroll
            for (int r = 0; r < 16; ++r) { p0[r] = rowsel ? p0[r] : NEG; p1[r] = rowsel ? p1[r] : NEG; }
        }
        float rm = fmaxf(p0[0], p1[0]);
#pragma unroll
        for (int r = 1; r < 16; ++r) rm = fmaxf(rm, fmaxf(p0[r], p1[r]));
        rm = pl32_max(rm);
        const float mnew = fmaxf(m, rm);
        const float corr = __builtin_amdgcn_exp2f(m - mnew);
        float ps = 0.f;
#pragma unroll
        for (int r = 0; r < 16; ++r) { p0[r] = __builtin_amdgcn_exp2f(p0[r] - mnew); p1[r] = __builtin_amdgcn_exp2f(p1[r] - mnew); ps += p0[r] + p1[r]; }
        lsum = lsum * corr + ps; m = mnew;
        if (__any(corr != 1.0f)) {
            if (hi == 0) wsf[r32] = corr;
            WAVE_LDS_SYNC();
#pragma unroll
            for (int r = 0; r < 16; ++r) { const float f = wsf[crow(r, hi)]; o[0][r] *= f; o[1][r] *= f; }
            WAVE_LDS_SYNC();
        }
        f16x8 pa[4];
#pragma unroll
        for (int e = 0; e < 8; ++e) { pa[0][e] = (f16)p0[e]; pa[1][e] = (f16)p0[8 + e]; pa[2][e] = (f16)p1[e]; pa[3][e] = (f16)p1[8 + e]; }
        const LAS unsigned char* vs = vlane + slot * 8192;
#pragma unroll
        for (int d0 = 0; d0 < 2; ++d0)
#pragma unroll
            for (int ks = 0; ks < 4; ++ks) {
                const s16x4 lo = vtr(vs + d0 * 4096 + ks * 1024), hh = vtr(vs + d0 * 4096 + ks * 1024 + 512);
                typedef short s16x8 __attribute__((ext_vector_type(8)));
                const s16x8 bv = {lo[0], lo[1], lo[2], lo[3], hh[0], hh[1], hh[2], hh[3]};
                o[d0] = __builtin_amdgcn_mfma_f32_32x32x16_f16(pa[ks], __builtin_bit_cast(f16x8, bv), o[d0], 0, 0, 0);
            }
    }
    __syncthreads();
}

__device__ __forceinline__ void nsa_attn_unit(const Ctx& C, int l, int b, int c, int TID, LAS unsigned char* lds) {
    const f16* Z = (const f16*)(C.ws + WS_Z); f16* MIX = (f16*)(C.ws + WS_MIX); const f16* OCMP = (const f16*)(C.ws + WS_OCMP);
    const f16* KSR = (const f16*)(C.ws + WS_KSR); const f16* KWR = (const f16*)(C.ws + WS_KWR);
    const float* RC = (const float*)(C.ws + WS_ROPE); const float* RS = RC + (size_t)M * 8;
    const float* gain = C.in[12] + (size_t)l * D + 256;
    const int tid = TID, lane = tid & 63, wid = __builtin_amdgcn_readfirstlane(tid >> 6), r32 = lane & 31, hi = lane >> 5;
    const size_t m0 = (size_t)b * S + 64 * c;
    const int tokw = 8 * wid + (r32 >> 2), head = r32 & 3;
    const size_t mrow = m0 + tokw;
    const LAS unsigned long long* SELS = (const LAS unsigned long long*)(lds + NSA_SEL_OFF);
    const unsigned long long sel = SELS[tokw];
    f16x8 qf[4];
#pragma unroll
    for (int d0 = 0; d0 < 4; ++d0) qf[d0] = *(const f16x8*)(Z + mrow * ZP + ZC_NQ + 64 * head + 16 * d0 + 8 * hi);
    {
        const u32x4 w = __builtin_bit_cast(u32x4, qf[0]); u32x4 ow;
#pragma unroll
        for (int k = 0; k < 4; ++k) ow[k] = pl32_other(w[k], hi);
        const f16x8 of = __builtin_bit_cast(f16x8, ow);
        const f32x4 c0 = *(const f32x4*)(RC + mrow * 8), c1 = *(const f32x4*)(RC + mrow * 8 + 4), s0 = *(const f32x4*)(RS + mrow * 8), s1 = *(const f32x4*)(RS + mrow * 8 + 4);
#pragma unroll
        for (int i = 0; i < 8; ++i) {
            const float cs = i < 4 ? c0[i & 3] : c1[i & 3], sn = i < 4 ? s0[i & 3] : s1[i & 3];
            const float a = (float)qf[0][i], bq = (float)of[i];
            const float r = hi ? a * cs + bq * sn : a * cs - bq * sn;
            qf[0][i] = (f16)(r * NSA_C2);
        }
#pragma unroll
        for (int d0 = 1; d0 < 4; ++d0)
#pragma unroll
            for (int i = 0; i < 8; ++i) qf[d0][i] = (f16)((float)qf[d0][i] * NSA_C2);
    }
    LAS float* wsf = (LAS float*)(lds + NSA_WSF_OFF) + wid * 64;
    f32x16 tot[2], o[2]; float lsum;
#pragma unroll
    for (int r = 0; r < 16; ++r) { tot[0][r] = 0.f; tot[1][r] = 0.f; }
    const f16* zrow = Z + mrow * ZP;
    nsa_branch<0>(KSR + (size_t)b * S * 64, Z + (size_t)b * S * ZP + ZC_VSLC, c, sel, tokw, qf, o, lsum, lds, wid, lane, r32, hi);
    {
        const float f = sigmoidf_((float)zrow[ZC_NG + 3 * head + 1]) / pl32_sum(lsum);
        if (hi == 0) wsf[r32] = f;
        WAVE_LDS_SYNC();
#pragma unroll
        for (int r = 0; r < 16; ++r) { const float fr = wsf[crow(r, hi)]; tot[0][r] += o[0][r] * fr; tot[1][r] += o[1][r] * fr; }
        WAVE_LDS_SYNC();
    }
    nsa_branch<1>(KWR + (size_t)b * S * 64, Z + (size_t)b * S * ZP + ZC_VWIN, c, sel, tokw, qf, o, lsum, lds, wid, lane, r32, hi);
    {
        const float f = sigmoidf_((float)zrow[ZC_NG + 3 * head + 2]) / pl32_sum(lsum);
        if (hi == 0) wsf[r32] = f;
        WAVE_LDS_SYNC();
#pragma unroll
        for (int r = 0; r < 16; ++r) { const float fr = wsf[crow(r, hi)]; tot[0][r] += o[0][r] * fr; tot[1][r] += o[1][r] * fr; }
        WAVE_LDS_SYNC();
    }
#pragma unroll
    for (int k = 0; k < 4; ++k) {
        const size_t mm = m0 + 8 * wid + 2 * k + hi;
        float ss = 0.f;
#pragma unroll
        for (int hd = 0; hd < 4; ++hd)
#pragma unroll
            for (int d0 = 0; d0 < 2; ++d0) { const float v = tot[d0][4 * k + hd] + (float)OCMP[mm * 256 + 64 * hd + 32 * d0 + r32]; tot[d0][4 * k + hd] = v; ss += v * v; }
#pragma unroll
        for (int off = 1; off < 32; off <<= 1) ss += __shfl_xor(ss, off);
        const float rinv = rsqrtf(ss * (1.f / 256) + EPS);
#pragma unroll
        for (int hd = 0; hd < 4; ++hd)
#pragma unroll
            for (int d0 = 0; d0 < 2; ++d0) MIX[mm * D + 256 + 64 * hd + 32 * d0 + r32] = (f16)(tot[d0][4 * k + hd] * rinv * gain[64 * hd + 32 * d0 + r32]);
    }
}
__device__ __forceinline__ void ph_nsa(const Ctx& C, int l, int TID, int bid, int nblk, LAS float* lds) {
    for (int item = bid; item < 256; item += nblk) {
        const int b = item >> 5, s = item & 31;
        for (int u = 0; u < 2; ++u) {
            const int c = u == 0 ? s : 63 - s;
            __syncthreads();
            nsa_cmp_unit(C, b, c, TID, lds);
            __syncthreads();
            nsa_attn_unit(C, l, b, c, TID, (LAS unsigned char*)lds);
        }
    }
}
__device__ __forceinline__ void ph_gla1(const Ctx& C, int l, int TID, int bid, int nblk) {
    const f16* Z = (const f16*)(C.ws + WS_Z); float* LA = (float*)(C.ws + WS_LA);
    const float* w2 = C.in[8] + (size_t)l * 16 * 128; const float* gb = C.in[9] + (size_t)l * 128;
    for (int idx = bid * NT + TID; idx < M * 128; idx += nblk * NT) {
        const int dim = idx & 127, m = idx >> 7;
        const f16* lr = Z + (size_t)m * ZP + ZC_LR;
        float a = gb[dim];
#pragma unroll
        for (int r = 0; r < 16; ++r) a += (float)lr[r] * w2[r * 128 + dim];
        const float ls = fminf(a, 0.f) - log1pf(expf(-fabsf(a)));
        LA[idx] = ls * (1.f / 16.f);
    }
}
__device__ __forceinline__ void ph_gla2(const Ctx& C, int TID, int bid, int nblk) {
    float* LA = (float*)(C.ws + WS_LA);
    const int total = (M / 64) * 128;
    for (int idx = bid * NT + TID; idx < total; idx += nblk * NT) {
        const int dim = idx & 127, ch = idx >> 7;
        float run = 0.f;
        for (int tt = 0; tt < 64; ++tt) { float* p = LA + ((size_t)ch * 64 + tt) * 128 + dim; run += *p; *p = run; }
    }
}
__device__ __forceinline__ void ph_gla3(const Ctx& C, int TID, int bid, int nblk, LAS float* lds) {
    const f16* Z = (const f16*)(C.ws + WS_Z); const float* Bc = (const float*)(C.ws + WS_LA);
    float* QE2 = (float*)(C.ws + WS_QE2); float* OI = (float*)(C.ws + WS_OI); float* KV = (float*)(C.ws + WS_KV);
    LAS float* qe = lds; LAS float* ke = lds + 2112; LAS float* k2 = lds + 4224; LAS float* vs = lds + 6336; LAS float* att = lds + 10432;
    const int tid = TID;
    for (int item = bid; item < NB * 4 * 64; item += nblk) {
        const int n = item & 63, h = (item >> 6) & 3, b = item >> 8;
        const size_t m0 = (size_t)b * S + n * 64;
        __syncthreads();
        for (int idx = tid; idx < 2048; idx += NT) {
            const int tt = idx >> 5, d = idx & 31;
            const float bb = Bc[(m0 + tt) * 128 + 32 * h + d], bmid = Bc[(m0 + 32) * 128 + 32 * h + d], blast = Bc[(m0 + 63) * 128 + 32 * h + d];
            const float qv = (float)Z[(m0 + tt) * ZP + ZC_LQ + 32 * h + d] * 0.17677669529663687f, kv = (float)Z[(m0 + tt) * ZP + ZC_LK + 32 * h + d];
            qe[tt * 33 + d] = qv * expf(bb - bmid); ke[tt * 33 + d] = kv * expf(bmid - bb); k2[tt * 33 + d] = kv * expf(blast - bb);
            QE2[(m0 + tt) * 128 + 32 * h + d] = qv * expf(bb);
        }
        for (int idx = tid; idx < 4096; idx += NT) { const int tt = idx >> 6, v = idx & 63; vs[idx] = (float)Z[(m0 + tt) * ZP + ZC_LV + 64 * h + v]; }
        __syncthreads();
        for (int idx = tid; idx < 4096; idx += NT) {
            const int tt = idx >> 6, s = idx & 63; float a = 0.f;
            if (s <= tt) { for (int d = 0; d < 32; ++d) a += qe[tt * 33 + d] * ke[s * 33 + d]; }
            att[tt * 65 + s] = a;
        }
        __syncthreads();
        for (int idx = tid; idx < 4096; idx += NT) {
            const int tt = idx >> 6, v = idx & 63; float o = 0.f;
            for (int s = 0; s <= tt; ++s) o += att[tt * 65 + s] * vs[s * 64 + v];
            OI[(m0 + tt) * 256 + 64 * h + v] = o;
        }
        for (int idx = tid; idx < 2048; idx += NT) {
            const int d = idx >> 6, v = idx & 63; float a = 0.f;
            for (int s = 0; s < 64; ++s) a += k2[s * 33 + d] * vs[s * 64 + v];
            KV[(size_t)item * 2048 + idx] = a;
        }
    }
}
__device__ __forceinline__ void ph_gla4(const Ctx& C, int TID, int bid, int nblk) {
    const float* Bc = (const float*)(C.ws + WS_LA); const float* KV = (const float*)(C.ws + WS_KV); float* SP = (float*)(C.ws + WS_SPREV);
    for (int idx = bid * NT + TID; idx < NB * 4 * 2048; idx += nblk * NT) {
        const int dv = idx & 2047, bh = idx >> 11, d = dv >> 6, h = bh & 3, b = bh >> 2;
        float st = 0.f;
        for (int n = 0; n < 64; ++n) {
            SP[((size_t)bh * 64 + n) * 2048 + dv] = st;
            const float dec = expf(Bc[((size_t)b * S + n * 64 + 63) * 128 + 32 * h + d]);
            st = dec * st + KV[((size_t)bh * 64 + n) * 2048 + dv];
        }
    }
}
__device__ __forceinline__ void ph_gla5(const Ctx& C, int l, int TID, int bid, int nblk) {
    const f16* Z = (const f16*)(C.ws + WS_Z); f16* MIX = (f16*)(C.ws + WS_MIX);
    const float* QE2 = (const float*)(C.ws + WS_QE2); const float* OI = (const float*)(C.ws + WS_OI); const float* SP = (const float*)(C.ws + WS_SPREV);
    const float* gain = C.in[12] + (size_t)l * D + 512;
    const int lane = TID & 63, gw = bid * NWAVE + (TID >> 6), ngw = nblk * NWAVE;
    for (int m = gw; m < M; m += ngw) {
        const int b = m / S, t = m % S, n = t >> 6;
        float og[4]; float ss = 0.f;
#pragma unroll
        for (int h = 0; h < 4; ++h) {
            float o = OI[(size_t)m * 256 + 64 * h + lane];
            const float* sp = SP + ((size_t)(b * 4 + h) * 64 + n) * 2048 + lane; const float* qe = QE2 + (size_t)m * 128 + 32 * h;
            for (int d = 0; d < 32; ++d) o += qe[d] * sp[d * 64];
            const float ms = wave_sum(o * o) * (1.f / 64);
            const float gv = (float)Z[(size_t)m * ZP + ZC_LG + 64 * h + lane];
            og[h] = siluf(gv) * (o * rsqrtf(ms + EPS)); ss += og[h] * og[h];
        }
        const float r = rsqrtf(wave_sum(ss) * (1.f / 256) + EPS);
#pragma unroll
        for (int h = 0; h < 4; ++h) MIX[(size_t)m * D + 512 + 64 * h + lane] = (f16)(og[h] * r * gain[64 * h + lane]);
    }
}
__device__ __forceinline__ void ph_gmlp1(const Ctx& C, int TID, int bid, int nblk) {
    const f16* Z = (const f16*)(C.ws + WS_Z); float* VN = (float*)(C.ws + WS_VN);
    const int lane = TID & 63, gw = bid * NWAVE + (TID >> 6), ngw = nblk * NWAVE;
    for (int m = gw; m < M; m += ngw) {
#pragma unroll
        for (int g = 0; g < 4; ++g) {
            const float v = (float)Z[(size_t)m * ZP + ZC_MV + 64 * g + lane];
            const float mu = wave_sum(v) * (1.f / 64), dv = v - mu, var = wave_sum(dv * dv) * (1.f / 64);
            VN[(size_t)m * 256 + 64 * g + lane] = dv * rsqrtf(var + EPS);
        }
    }
}
__device__ __forceinline__ void ph_gmlp2(const Ctx& C, int l, int TID, int bid, int nblk) {
    const f16* Z = (const f16*)(C.ws + WS_Z); f16* MIX = (f16*)(C.ws + WS_MIX); const float* VN = (const float*)(C.ws + WS_VN);
    const float* ws_ = C.in[10] + (size_t)l * 4 * 128 * 128; const float* bs = C.in[11] + (size_t)l * 4 * 128; const float* gain = C.in[12] + (size_t)l * D + 768;
    const int lane = TID & 63, gw = bid * NWAVE + (TID >> 6), ngw = nblk * NWAVE;
    for (int m = gw; m < M; m += ngw) {
        const int tp = m & 127; const size_t mc = (size_t)(m - tp);
        float o[4]; float ss = 0.f;
#pragma unroll
        for (int g = 0; g < 4; ++g) {
            const float* w = ws_ + ((size_t)g * 128 + tp) * 128; float acc = 0.f;
            for (int s = 0; s <= tp; ++s) acc += w[s] * VN[(mc + s) * 256 + 64 * g + lane];
            o[g] = (float)Z[(size_t)m * ZP + ZC_MU + 64 * g + lane] * (acc + bs[g * 128 + tp]); ss += o[g] * o[g];
        }
        const float r = rsqrtf(wave_sum(ss) * (1.f / 256) + EPS);
#pragma unroll
        for (int g = 0; g < 4; ++g) MIX[(size_t)m * D + 768 + 64 * g + lane] = (f16)(o[g] * r * gain[64 * g + lane]);
    }
}

__device__ __forceinline__ void cvt_item(const float* W, int K, int N, f16* WT, bool remap, LAS float* scr, int item, int lane) {
    const int nb_ = (N + 31) / 32, kb = item / nb_, nb = item % nb_, k0 = 64 * kb, n0 = 32 * nb;
#pragma unroll 8
    for (int i = 0; i < 32; ++i) { const int kk = 2 * i + (lane >> 5), n = n0 + (lane & 31); scr[kk * 33 + (lane & 31)] = n < N ? W[(size_t)(k0 + kk) * N + n] : 0.f; }
    WAVE_LDS_SYNC();
    const int c = lane & 7;
#pragma unroll
    for (int j = 0; j < 4; ++j) {
        const int nn = (lane >> 3) + 8 * j, n = n0 + nn;
        if (n < N) {
            const int row = remap ? n + (n >= 1420 ? 4 : 0) : n; const LAS float* s = scr + (8 * c) * 33 + nn;
            f16x8 o;
#pragma unroll
            for (int e = 0; e < 8; ++e) o[e] = (f16)s[e * 33];
            *(f16x8*)(WT + (size_t)row * K + k0 + 8 * c) = o;
        }
    }
    WAVE_LDS_SYNC();
}
__device__ __forceinline__ void ph_wcvt(const Ctx& C, int TID, int bid, int nblk, LAS float* lds) {
    const int lane = TID & 63, wave = TID >> 6, gw = bid * NWAVE + wave, ngw = nblk * NWAVE;
    LAS float* scr = lds + wave * 4096;
    constexpr int I_IN = (D / 64) * ((NIN + 31) / 32), I_O = (D / 64) * (D / 32), I_UP = (D / 64) * (DFF / 32), I_DN = (DFF / 64) * (D / 32), I_PAD = 100, I_L = I_IN + I_O + I_UP + I_DN + I_PAD;
    for (int it = gw; it < DEPTH * I_L; it += ngw) {
        const int l = it / I_L; int r = it % I_L;
        unsigned char* wl = C.ws + WS_W16 + (size_t)l * W16_LAYER;
        if (r < I_IN) { cvt_item(C.in[3] + (size_t)l * D * NIN, D, NIN, (f16*)(wl + W16_WIN), true, scr, r, lane); continue; } r -= I_IN;
        if (r < I_O) { cvt_item(C.in[13] + (size_t)l * D * D, D, D, (f16*)(wl + W16_WO), false, scr, r, lane); continue; } r -= I_O;
        if (r < I_UP) { cvt_item(C.in[17] + (size_t)l * D * DFF, D, DFF, (f16*)(wl + W16_WUP), false, scr, r, lane); continue; } r -= I_UP;
        if (r < I_DN) { cvt_item(C.in[18] + (size_t)l * DFF * D, DFF, D, (f16*)(wl + W16_WDN), false, scr, r, lane); continue; } r -= I_DN;
        const int row = r < 4 ? 1420 + r : 2720 + (r - 4);
        f16x8 z; for (int e = 0; e < 8; ++e) z[e] = (f16)0.f;
        f16* p = (f16*)(wl + W16_WIN) + (size_t)row * D;
        *(f16x8*)(p + 8 * lane) = z; *(f16x8*)(p + 512 + 8 * lane) = z;
    }
}

namespace pg8 {
#define PG8_LAS __attribute__((address_space(3)))
typedef _Float16 bf16_t;
typedef _Float16 bf16x8 __attribute__((ext_vector_type(8)));
typedef float f32x4 __attribute__((ext_vector_type(4)));
typedef unsigned u32x4 __attribute__((ext_vector_type(4)));
constexpr int BM = 256, BK = 64, HALF = 128, HTB = HALF * BK * 2  , STAGE_BYTES = 8 * HTB, NXCD = 8, WGM = 8;

__host__ __device__ __forceinline__ int lds_byte(int r, int c) { const int st = (r >> 4) * 2 + (c >> 5), rr = r & 15, cc = c & 31, ob = rr * 64 + cc * 2; return st * 1024 + (ob ^ (((ob >> 9) & 1) << 5)); }
__host__ __device__ __forceinline__ void stage_rc(int b, int& R, int& C) { const int st = b / 1024, sb = b % 1024, swz = sb ^ (((sb >> 9) & 1) << 5); R = (st >> 1) * 16 + swz / 64; C = (st & 1) * 32 + (swz % 64) / 2; }
__host__ __device__ __forceinline__ int perm32(int rho) { const int n = rho >> 4, i = rho & 15; return 8 * (i >> 2) + 4 * n + (i & 3); }

struct Unit { int pm, pn; };
struct Gemm { const bf16_t* A; const bf16_t* Bt; int M, N, K; };

struct StaticOrder {
    int nM, nN, nwg, G, c;
    __host__ __device__ void init(int M, int N, int G_, int c_) { nM = M / BM; nN = N / BM; nwg = nM * nN; G = G_; c = c_; }
    __host__ __device__ bool next(int i, Unit& u) const {
        const long L = (long)i * G + c; if (L >= nwg) return false;
        int wgid = (int)L; { const int q = nwg / NXCD, r = nwg % NXCD, xcd = wgid % NXCD, off = wgid / NXCD; wgid = (xcd < r ? xcd * (q + 1) : r * (q + 1) + (xcd - r) * q) + off; }
        const int nig = WGM * nN, gid = wgid / nig, fm = gid * WGM, gsz = (nM - fm) < WGM ? (nM - fm) : WGM;
        u.pm = fm + ((wgid % nig) % gsz); u.pn = (wgid % nig) / gsz; return true;
    }
    __device__ __forceinline__ void a_ready(const Unit&) const {}
    __device__ __forceinline__ void done(const Unit&) const {}
};


template <int ACT> struct EpiF16 {
    static constexpr bool PERM = true, AFTER_DRAIN = false;
    bf16_t* O; int ldc;
    __device__ __forceinline__ void operator()(const f32x4 (&acc)[2][2][4][2], const Unit& u, int wr, int wc, int fr, int fq) const {
        const int row0 = u.pm * BM + wr * 64 + fr, col0 = u.pn * BM + wc * 32 + 8 * fq;
#pragma unroll
        for (int ai = 0; ai < 2; ++ai)
#pragma unroll
            for (int m = 0; m < 4; ++m) { bf16_t* rowp = O + (size_t)(row0 + ai * HALF + m * 16) * ldc + col0;
#pragma unroll
                for (int bj = 0; bj < 2; ++bj) { f32x4 v0 = acc[ai][bj][m][0], v1 = acc[ai][bj][m][1];
                    if (ACT == 1) {
#pragma unroll
                        for (int e = 0; e < 4; ++e) { const float a = fmaxf(v0[e], 0.f), b = fmaxf(v1[e], 0.f); v0[e] = a * a; v1[e] = b * b; } }
                    bf16x8 w; w[0] = (bf16_t)v0[0]; w[1] = (bf16_t)v0[1]; w[2] = (bf16_t)v0[2]; w[3] = (bf16_t)v0[3]; w[4] = (bf16_t)v1[0]; w[5] = (bf16_t)v1[1]; w[6] = (bf16_t)v1[2]; w[7] = (bf16_t)v1[3];
                    *(bf16x8*)(rowp + bj * HALF) = w; } }
    }
};
template <class Epi, class Sched, bool ALIGN_EPI = false, bool SP2 = false>
__device__ __forceinline__ void gemm_phase(PG8_LAS unsigned char* lds, const Gemm g, const Sched& S, const Epi& E, const int tid) {
    const int  wid = __builtin_amdgcn_readfirstlane(tid >> 6), lane = tid & 63, wr = wid >> 2, wc = wid & 3, fr = lane & 15, fq = lane >> 4;
    const int K = g.K, nt = K / BK;
    unsigned voffA[2], voffB[2];
#pragma unroll
    for (int i = 0; i < 2; ++i) { int R, C; stage_rc(tid * 16 + i * 8192, R, C); const int Rb = Epi::PERM ? ((R & ~31) + perm32(R & 31)) : R;
        voffA[i] = (unsigned)(R * K + C) * 2u; voffB[i] = (unsigned)(Rb * K + C) * 2u; }
    const size_t kstep = (size_t)(BK * 2);
    const size_t hstep = (size_t)HALF * K * 2;
    const size_t tstep = 2 * hstep;
    const unsigned ldsw = (unsigned)wid * 1024u;
    const int aoff = lds_byte(wr * 64 + fr, fq * 8), boff = lds_byte(wc * 32 + fr, fq * 8);
#define PG8_SA(b, h) (((b) * 2 + (h)) * HTB)
#define PG8_SB(b, h) ((4 + (b) * 2 + (h)) * HTB)
#define PG8_STAGE(bufoff, gbase, voff) do { _Pragma("unroll") for (int _i = 0; _i < 2; ++_i) \
        __builtin_amdgcn_global_load_lds((const unsigned*)((const char*)(gbase) + (voff)[_i]), (PG8_LAS unsigned*)(lds + (bufoff) + ldsw + _i * 8192), 16, 0, 0); } while (0)
#define PG8_LDA(dst, b, h) do { _Pragma("unroll") for (int m = 0; m < 4; ++m) _Pragma("unroll") for (int k = 0; k < 2; ++k) dst[m][k] = *(const PG8_LAS bf16x8*)(lds + PG8_SA(b, h) + aoff + m * 2048 + k * 1024); } while (0)
#define PG8_LDB(dst, b, h) do { _Pragma("unroll") for (int n = 0; n < 2; ++n) _Pragma("unroll") for (int k = 0; k < 2; ++k) dst[n][k] = *(const PG8_LAS bf16x8*)(lds + PG8_SB(b, h) + boff + n * 2048 + k * 1024); } while (0)
#define PG8_MMA(ai, bj, At, Bt) do { __builtin_amdgcn_s_setprio(1); _Pragma("unroll") for (int m = 0; m < 4; ++m) _Pragma("unroll") for (int n = 0; n < 2; ++n) _Pragma("unroll") for (int k = 0; k < 2; ++k) \
        acc[ai][bj][m][n] = __builtin_amdgcn_mfma_f32_16x16x32_f16(Bt[n][k], At[m][k], acc[ai][bj][m][n], 0, 0, 0); __builtin_amdgcn_s_setprio(0); } while (0)
#define PG8_WAIT_V(n) asm volatile("s_waitcnt vmcnt(" #n ")" ::: "memory")
#define PG8_WAIT_L(n) asm volatile("s_waitcnt lgkmcnt(" #n ")" ::: "memory")
#define PG8_BAR __builtin_amdgcn_s_barrier()
#define PG8_SCHED __builtin_amdgcn_sched_barrier(0)
    Unit cur, nxt; int ui = 0;
    if (!S.next(0, cur)) return;
    f32x4 acc[2][2][4][2];
#pragma unroll
    for (int a = 0; a < 2; ++a)
#pragma unroll
        for (int b = 0; b < 2; ++b)
#pragma unroll
            for (int m = 0; m < 4; ++m)
#pragma unroll
                for (int n = 0; n < 2; ++n) acc[a][b][m][n] = (f32x4){0.f, 0.f, 0.f, 0.f};
    bf16x8 At[4][2], B0[2][2], B1[2][2];
    const char* cA = (const char*)g.A + (size_t)cur.pm * tstep; const char* cB = (const char*)g.Bt + (size_t)cur.pn * tstep;
    S.a_ready(cur);
    if constexpr (SP2) {
        PG8_STAGE(PG8_SB(0, 0), cB, voffB); PG8_STAGE(PG8_SB(0, 1), cB + hstep, voffB); PG8_STAGE(PG8_SA(0, 0), cA, voffA); PG8_STAGE(PG8_SA(0, 1), cA + hstep, voffA);
        if (wr == 1) PG8_BAR;
        PG8_WAIT_V(2); PG8_BAR;
        PG8_STAGE(PG8_SB(1, 0), cB + kstep, voffB); PG8_STAGE(PG8_SA(1, 0), cA + kstep, voffA); PG8_STAGE(PG8_SB(1, 1), cB + hstep + kstep, voffB);
        PG8_WAIT_V(6); PG8_BAR;
    } else {
        PG8_STAGE(PG8_SB(0, 0), cB, voffB); PG8_STAGE(PG8_SA(0, 0), cA, voffA); PG8_STAGE(PG8_SB(0, 1), cB + hstep, voffB); PG8_STAGE(PG8_SA(0, 1), cA + hstep, voffA);
        if (wr == 1) PG8_BAR;
        PG8_WAIT_V(4); PG8_BAR;
        PG8_STAGE(PG8_SB(1, 0), cB + kstep, voffB); PG8_STAGE(PG8_SA(1, 0), cA + kstep, voffA); PG8_STAGE(PG8_SB(1, 1), cB + hstep + kstep, voffB);
        PG8_WAIT_V(6); PG8_BAR;
    }
    for (;;) {
        const bool has_next = S.next(ui + 1, nxt);
        const char* nA = has_next ? (const char*)g.A + (size_t)nxt.pm * tstep : cA; const char* nB = has_next ? (const char*)g.Bt + (size_t)nxt.pn * tstep : cB;
        for (int t = 0; t < nt; t += 2) {
            const bool last = (t == nt - 2);
            const char* a1 = cA + (size_t)(t + 1) * kstep;
            const char* a2 = last ? nA : cA + (size_t)(t + 2) * kstep; const char* b2 = last ? nB : cB + (size_t)(t + 2) * kstep;
            const char* a3 = a2 + kstep; const char* b3 = b2 + kstep;
            if (last && has_next) S.a_ready(nxt);
            if constexpr (SP2) {
            PG8_LDB(B0, 0, 0); PG8_LDB(B1, 0, 1); PG8_SCHED; PG8_LDA(At, 0, 0); PG8_STAGE(PG8_SA(1, 1), a1 + hstep, voffA);
            PG8_WAIT_V(8); PG8_WAIT_L(0); PG8_BAR; PG8_MMA(0, 0, At, B0); PG8_MMA(0, 1, At, B1); PG8_BAR; PG8_SCHED;
            PG8_LDA(At, 0, 1); PG8_STAGE(PG8_SB(0, 0), b2, voffB); PG8_STAGE(PG8_SB(0, 1), b2 + hstep, voffB); PG8_STAGE(PG8_SA(0, 0), a2, voffA);
            PG8_WAIT_V(8); PG8_WAIT_L(0); PG8_BAR; PG8_MMA(1, 0, At, B0); PG8_MMA(1, 1, At, B1); PG8_BAR; PG8_SCHED;
            PG8_LDB(B0, 1, 0); PG8_LDB(B1, 1, 1); PG8_SCHED; PG8_LDA(At, 1, 0); PG8_STAGE(PG8_SA(0, 1), a2 + hstep, voffA);
            PG8_WAIT_V(8); PG8_WAIT_L(0); PG8_BAR; PG8_MMA(0, 0, At, B0); PG8_MMA(0, 1, At, B1); PG8_BAR; PG8_SCHED;
            PG8_LDA(At, 1, 1); PG8_STAGE(PG8_SB(1, 0), b3, voffB); PG8_STAGE(PG8_SB(1, 1), b3 + hstep, voffB); PG8_STAGE(PG8_SA(1, 0), a3, voffA);
            PG8_WAIT_V(8); PG8_WAIT_L(0); PG8_BAR; PG8_MMA(1, 0, At, B0); PG8_MMA(1, 1, At, B1); PG8_BAR; PG8_SCHED;
            } else {
            PG8_LDB(B0, 0, 0); PG8_SCHED; PG8_LDA(At, 0, 0); PG8_STAGE(PG8_SA(1, 1), a1 + hstep, voffA);
            PG8_WAIT_L(8); PG8_BAR; PG8_WAIT_L(0); PG8_MMA(0, 0, At, B0); PG8_BAR; PG8_SCHED;
            PG8_LDB(B1, 0, 1); PG8_STAGE(PG8_SB(0, 0), b2, voffB);
            PG8_BAR; PG8_WAIT_L(0); PG8_MMA(0, 1, At, B1); PG8_BAR;
            PG8_LDA(At, 0, 1); PG8_STAGE(PG8_SA(0, 0), a2, voffA);
            PG8_BAR; PG8_WAIT_L(0); PG8_MMA(1, 0, At, B0); PG8_BAR; PG8_SCHED;
            PG8_STAGE(PG8_SB(0, 1), b2 + hstep, voffB);
            PG8_WAIT_V(6); PG8_BAR; PG8_MMA(1, 1, At, B1); PG8_BAR;
            PG8_LDB(B0, 1, 0); PG8_SCHED; PG8_LDA(At, 1, 0); PG8_STAGE(PG8_SA(0, 1), a2 + hstep, voffA);
            PG8_WAIT_L(8); PG8_BAR; PG8_WAIT_L(0); PG8_MMA(0, 0, At, B0); PG8_BAR; PG8_SCHED;
            PG8_LDB(B1, 1, 1); PG8_STAGE(PG8_SB(1, 0), b3, voffB);
            PG8_BAR; PG8_WAIT_L(0); PG8_MMA(0, 1, At, B1); PG8_BAR;
            PG8_LDA(At, 1, 1); PG8_STAGE(PG8_SA(1, 0), a3, voffA);
            PG8_BAR; PG8_WAIT_L(0); PG8_MMA(1, 0, At, B0); PG8_BAR; PG8_SCHED;
            PG8_STAGE(PG8_SB(1, 1), b3 + hstep, voffB);
            PG8_WAIT_V(6); PG8_BAR; PG8_MMA(1, 1, At, B1); PG8_BAR;
            }
        }
        if constexpr (ALIGN_EPI) { if (wr == 0) PG8_BAR; }
        if constexpr (!Epi::AFTER_DRAIN) { E(acc, cur, wr, wc, fr, fq); S.done(cur); }
        if (!has_next) break;
#pragma unroll
        for (int a = 0; a < 2; ++a)
#pragma unroll
            for (int b = 0; b < 2; ++b)
#pragma unroll
                for (int m = 0; m < 4; ++m)
#pragma unroll
                    for (int n = 0; n < 2; ++n) acc[a][b][m][n] = (f32x4){0.f, 0.f, 0.f, 0.f};
        cur = nxt; cA = nA; cB = nB; ++ui;
        if constexpr (ALIGN_EPI) { if (wr == 1) PG8_BAR; }
    }
    PG8_WAIT_V(0);
    if constexpr (!ALIGN_EPI) { if (wr == 0) PG8_BAR; }
    PG8_BAR;
    if constexpr (Epi::AFTER_DRAIN) { E.fused(acc, cur, wr, wc, fr, fq, lds, wid, lane); S.done(cur); }
#undef PG8_SA
#undef PG8_SB
#undef PG8_STAGE
#undef PG8_LDA
#undef PG8_LDB
#undef PG8_MMA
#undef PG8_WAIT_V
#undef PG8_WAIT_L
#undef PG8_BAR
#undef PG8_SCHED
}
}

#define XB_TMO      128
#define XB_XCNT(j)  (256  + 64 * (j))
#define XB_XSUB(j)  (1280 + 64 * (j))
#define XB_XGEN(j)  (2304 + 64 * (j))
#define XB_TOP      3328
#define XB_TOPGEN   3392
#define XCD_BAR_WORDS 3456
#define XB_SPIN_CAP (1u << 18)

__device__ __forceinline__ unsigned xb_ld(unsigned* p)              { return __hip_atomic_load(p, __ATOMIC_RELAXED, __HIP_MEMORY_SCOPE_AGENT); }
__device__ __forceinline__ unsigned xb_add(unsigned* p, unsigned v) { return __hip_atomic_fetch_add(p, v, __ATOMIC_RELAXED, __HIP_MEMORY_SCOPE_AGENT); }
__device__ __forceinline__ unsigned xb_xcc_id() { return (unsigned)__builtin_amdgcn_s_getreg((3 << 11) | 20) & 0xFu; }
#define XB_SPIN(cond, bar) do { unsigned _sp = 0; while (cond) { __builtin_amdgcn_s_sleep(1); \
    if ((++_sp & 255u) == 0u) { if (xb_ld(&(bar)[XB_TMO])) break; if (_sp > XB_SPIN_CAP) { atomicAdd(&(bar)[XB_TMO], 1u); break; } } } } while (0)

struct XcdBarrier {
    unsigned* bar; unsigned x;
    volatile LAS unsigned* st;
};

__device__ __forceinline__ XcdBarrier xcd_barrier_post(unsigned* bar, volatile LAS unsigned* st) {
    XcdBarrier b; b.bar = bar; b.x = xb_xcc_id(); b.st = st;
    if (threadIdx.x == 0) (void)xb_add(&bar[XB_XCNT(b.x)], 1u);
    return b;
}
__device__ __forceinline__ void xcd_barrier_complete(unsigned* bar, unsigned x, unsigned& nloc, unsigned& nx) {
    const unsigned G = gridDim.x * gridDim.y * gridDim.z;
    unsigned sum, cnt, mine, sp = 0u;
    for (;;) {
        sum = 0u; cnt = 0u; mine = 0u;
#pragma unroll
        for (unsigned j = 0; j < 16; ++j) { const unsigned c = xb_ld(&bar[XB_XCNT(j)]); sum += c; cnt += (c > 0u) ? 1u : 0u; mine = (j == x) ? c : mine; }
        if (sum == G) break;
        __builtin_amdgcn_s_sleep(1);
        if ((++sp & 255u) == 0u) { if (xb_ld(&bar[XB_TMO])) break; if (sp > XB_SPIN_CAP) { atomicAdd(&bar[XB_TMO], 1u); break; } }
    }
    nloc = mine > 0u ? mine : 1u; nx = cnt > 0u ? cnt : 1u;
}

__device__ __forceinline__ void xcd_barrier(const XcdBarrier& b) {
    asm volatile("s_waitcnt vmcnt(0)" ::: "memory");
    __syncthreads();
    if (threadIdx.x == 0) {
        unsigned* bar = b.bar;
        __builtin_amdgcn_s_waitcnt(0);
        unsigned nloc = b.st[0], nx = b.st[1];
        if (nloc == 0u) { xcd_barrier_complete(bar, b.x, nloc, nx); b.st[0] = nloc; b.st[1] = nx; }
        const unsigned old = xb_add(&bar[XB_XSUB(b.x)], 1u);
        const unsigned gen = old / nloc;
        if (old + 1u == (gen + 1u) * nloc) {
            __builtin_amdgcn_fence(__ATOMIC_RELEASE, "agent");
            asm volatile("s_waitcnt vmcnt(0)" ::: "memory");
            const unsigned og = xb_add(&bar[XB_TOP], 1u);
            const unsigned tg = og / nx;
            if (og + 1u == (tg + 1u) * nx) xb_add(&bar[XB_TOPGEN], 1u);
            else XB_SPIN(xb_ld(&bar[XB_TOPGEN]) == tg, bar);
            __builtin_amdgcn_fence(__ATOMIC_ACQUIRE, "agent");
            xb_add(&bar[XB_XGEN(b.x)], 1u);
            asm volatile("s_waitcnt vmcnt(0)" ::: "memory");
        } else {
            XB_SPIN(xb_ld(&bar[XB_XGEN(b.x)]) == gen, bar);
            __builtin_amdgcn_fence(__ATOMIC_ACQUIRE, "agent");
            asm volatile("s_waitcnt vmcnt(0)" ::: "memory");
        }
    }
    __syncthreads();
}

constexpr int CW_BAR = 4096;
constexpr int LDS_MISC = LDS_BYTES - 256;
#define LAUNDER(v) asm volatile("" : "+s"(v))
__global__ void __launch_bounds__(NT, 2) k_mega(Ctx Carg) {
    extern __shared__ __attribute__((aligned(16))) unsigned char lds_raw[];
    LAS float* lds = (LAS float*)lds_raw;
    const int bid = blockIdx.x, nblk = gridDim.x;
    for (int u = threadIdx.x; u < 64; u += NT) ((LAS unsigned*)((LAS unsigned char*)lds_raw + LDS_MISC))[u] = 0u;
    __syncthreads();
    const Ctx* Cp = (const Ctx*)__builtin_amdgcn_kernarg_segment_ptr();
    XcdBarrier bar = xcd_barrier_post((unsigned*)(Cp->ws + WS_CTL) + CW_BAR, (volatile LAS unsigned*)((LAS unsigned char*)lds_raw + LDS_MISC + 32));
#ifndef PMASK
#define PMASK 0xFFFFF
#endif
#define SITE(k, ...) do { if (!((PMASK >> (k)) & 1)) break; const Ctx* cp_ = Cp; LAUNDER(cp_); const Ctx C = *cp_; int ll = l; LAUNDER(ll); int tid_ = threadIdx.x; asm volatile("" : "+v"(tid_)); int bid_ = bid; LAUNDER(bid_); int nblk_ = nblk; LAUNDER(nblk_); \
        f16* H = (f16*)(C.ws + WS_H); f16* Zb = (f16*)(C.ws + WS_Z); f16* MIX = (f16*)(C.ws + WS_MIX); f16* Y = (f16*)(C.ws + WS_Y); f16* U = (f16*)(C.ws + WS_BIG); \
        (void)H; (void)Zb; (void)MIX; (void)Y; (void)U; __VA_ARGS__; } while (0); { XcdBarrier b_ = bar; LAUNDER(b_.x); LAUNDER(b_.bar); xcd_barrier(b_); }
    int l = 0;
    SITE(0, ph_mod(C, tid_, bid_, nblk_); ph_rope(C, tid_, bid_, nblk_); ph_wcvt(C, tid_, bid_, nblk_, lds));
    SITE(1, ph_norm0(C, tid_, bid_, nblk_));
    for (l = 0; l < DEPTH; ++l) {
        SITE(2, { pg8::Gemm g{H, (const f16*)(C.ws + WS_W16 + (size_t)ll * W16_LAYER + W16_WIN), M, ZP, D}; pg8::StaticOrder S; S.init(M, ZP, nblk_, bid_); pg8::EpiF16<0> E{Zb, ZP}; pg8::gemm_phase<pg8::EpiF16<0>, pg8::StaticOrder, true, true>((LAS unsigned char*)lds, g, S, E, tid_); });
        SITE(3, ph_conv(C, ll, tid_, bid_, nblk_); ph_rotk(C, tid_, bid_, nblk_); ph_cmp1(C, ll, tid_, bid_, nblk_); ph_gla1(C, ll, tid_, bid_, nblk_); ph_gmlp1(C, tid_, bid_, nblk_));
        SITE(4, ph_cmp2(C, ll, tid_, bid_, nblk_); ph_gla2(C, tid_, bid_, nblk_); ph_gmlp2(C, ll, tid_, bid_, nblk_));
        SITE(5, ph_nsa(C, ll, tid_, bid_, nblk_, lds); __syncthreads(); ph_gla3(C, tid_, bid_, nblk_, lds));
        SITE(6, ph_gla4(C, tid_, bid_, nblk_));
        SITE(7, ph_gla5(C, ll, tid_, bid_, nblk_));
        SITE(8, { pg8::Gemm g{MIX, (const f16*)(C.ws + WS_W16 + (size_t)ll * W16_LAYER + W16_WO), M, D, D}; pg8::StaticOrder S; S.init(M, D, nblk_, bid_); pg8::EpiF16<0> E{Y, D}; pg8::gemm_phase<pg8::EpiF16<0>, pg8::StaticOrder, true, true>((LAS unsigned char*)lds, g, S, E, tid_); });
        SITE(9, ph_resnorm(C, ll, 0, tid_, bid_, nblk_));
        SITE(10, { pg8::Gemm g{H, (const f16*)(C.ws + WS_W16 + (size_t)ll * W16_LAYER + W16_WUP), M, DFF, D}; pg8::StaticOrder S; S.init(M, DFF, nblk_, bid_); pg8::EpiF16<1> E{U, DFF}; pg8::gemm_phase<pg8::EpiF16<1>, pg8::StaticOrder, true, true>((LAS unsigned char*)lds, g, S, E, tid_); });
        SITE(11, { pg8::Gemm g{U, (const f16*)(C.ws + WS_W16 + (size_t)ll * W16_LAYER + W16_WDN), M, D, DFF}; pg8::StaticOrder S; S.init(M, D, nblk_, bid_); pg8::EpiF16<0> E{Y, D}; pg8::gemm_phase<pg8::EpiF16<0>, pg8::StaticOrder, true, true>((LAS unsigned char*)lds, g, S, E, tid_); });
        SITE(12, ph_resnorm(C, ll, 1, tid_, bid_, nblk_));
    }
#undef SITE
}

extern "C" void kernel_launch(void* const* d_in, const int* in_sizes, int n_in, void* d_out, int out_size, void* d_ws, size_t ws_size, hipStream_t stream) {
    static int grid = 0;
    if (grid == 0) {
        if (n_in != 19 || ws_size < WS_END) { fprintf(stderr, "kernel_launch: unexpected n_in %d / ws_size %zu\n", n_in, ws_size); grid = -1; return; }
        int dev = 0, cus = 0, per_cu = 0;
        if (hipGetDevice(&dev) != hipSuccess || hipDeviceGetAttribute(&cus, hipDeviceAttributeMultiprocessorCount, dev) != hipSuccess) { grid = -1; return; }
        if (hipFuncSetAttribute((const void*)k_mega, hipFuncAttributeMaxDynamicSharedMemorySize, LDS_BYTES) != hipSuccess) { fprintf(stderr, "hipFuncSetAttribute failed\n"); grid = -1; return; }
        if (hipOccupancyMaxActiveBlocksPerMultiprocessor(&per_cu, (const void*)k_mega, NT, LDS_BYTES) != hipSuccess || per_cu < 1) { fprintf(stderr, "occupancy query: %d\n", per_cu); }
        (void)hipGetLastError();
        grid = cus;
    }
    if (grid < 0) return;
    if (hipMemsetAsync((char*)d_ws + WS_CTL, 0, 1 * MiB, stream) != hipSuccess) return;
    Ctx c{};
    for (int i = 0; i < 19; ++i) c.in[i] = (const float*)d_in[i];
    c.out = (float*)d_out; c.ws = (unsigned char*)d_ws;
    hipLaunchKernelGGL(k_mega, dim3(grid), dim3(NT), LDS_BYTES, stream, c);
}
```

```cpp
#include <hip/hip_runtime.h>
#include <cstdint>
#include <cstdio>

#define LAS __attribute__((address_space(3)))
typedef _Float16 f16;
typedef f16 f16x4 __attribute__((ext_vector_type(4)));
typedef f16 f16x8 __attribute__((ext_vector_type(8)));
typedef float f32x4 __attribute__((ext_vector_type(4)));

constexpr int D = 1024, NB = 8, S = 4096, DEPTH = 4, M = NB * S, DFF = 4096;
constexpr int NIN = 2716, ZP = 2816;
constexpr int ZC_AH = 0, ZC_AB = 256, ZC_AC = 512, ZC_NQ = 768, ZC_KCMP = 1024, ZC_VCMP = 1088, ZC_KSLC = 1152, ZC_VSLC = 1216,
              ZC_KWIN = 1280, ZC_VWIN = 1344, ZC_NG = 1408, ZC_LQ = 1424, ZC_LK = 1552, ZC_LV = 1680, ZC_LG = 1936, ZC_LR = 2192,
              ZC_MU = 2208, ZC_MV = 2464;
constexpr int NCMP = 255;
constexpr float EPS = 1e-6f;
constexpr int NT = 512, NWAVE = 8;

constexpr size_t MiB = 1u << 20;
constexpr size_t WS_CTL = 0;
constexpr size_t WS_MOD = 1 * MiB;
constexpr size_t WS_ROPE = 2 * MiB;
constexpr size_t WS_W16 = 4 * MiB;
constexpr size_t WS_H = 98 * MiB;
constexpr size_t WS_Y = 162 * MiB;
constexpr size_t WS_BIG = 226 * MiB;
constexpr size_t WS_Z = WS_BIG;
constexpr size_t WS_MIX = WS_BIG + 176 * MiB;
constexpr size_t WS_KSR = WS_BIG + 240 * MiB;
constexpr size_t WS_KWR = WS_BIG + 244 * MiB;
constexpr size_t WS_HID = WS_BIG + 248 * MiB;
constexpr size_t WS_KC = WS_BIG + 251 * MiB;
constexpr size_t WS_VC = WS_BIG + 252 * MiB;
constexpr size_t WS_OCMP = 482 * MiB;
constexpr size_t WS_W1T = 498 * MiB;
constexpr size_t WS_WS16 = 502 * MiB;
constexpr size_t WS_PCB = 502 * MiB + 512 * 1024;
constexpr size_t WS_G = 503 * MiB;
constexpr size_t WS_END = 507 * MiB;
constexpr size_t WS_LA = WS_H;
constexpr size_t WS_QE2 = WS_H + 16 * MiB;
constexpr size_t WS_OI = WS_H + 32 * MiB;
constexpr size_t WS_KV = WS_Y;
constexpr size_t WS_SPREV = WS_Y + 16 * MiB;
constexpr size_t WS_VN = WS_Y + 32 * MiB;

constexpr size_t W16_WIN = 0, W16_WO = (size_t)ZP * D * 2, W16_WUP = W16_WO + (size_t)D * D * 2, W16_WDN = W16_WUP + (size_t)DFF * D * 2, W16_LAYER = W16_WDN + (size_t)D * DFF * 2;
static_assert(WS_W16 + DEPTH * W16_LAYER <= WS_H, "weight copies fit below H");

constexpr int LDS_BYTES = 147456;

struct Ctx {
    const float* in[19];
    float* out;
    unsigned char* ws;
    int lo, hi;
};

__device__ __forceinline__ float wave_sum(float v) {
#pragma unroll
    for (int o = 32; o > 0; o >>= 1) v += __shfl_xor(v, o);
    return v;
}
__device__ __forceinline__ float wave_max(float v) {
#pragma unroll
    for (int o = 32; o > 0; o >>= 1) v = fmaxf(v, __shfl_xor(v, o));
    return v;
}
#define WAVE_LDS_SYNC() asm volatile("s_waitcnt lgkmcnt(0)" ::: "memory")
__device__ __forceinline__ float siluf(float v) { return v / (1.f + expf(-v)); }
__device__ __forceinline__ float sigmoidf_(float v) { return 1.f / (1.f + expf(-v)); }

typedef float f32x16 __attribute__((ext_vector_type(16)));
typedef short s16x4 __attribute__((ext_vector_type(4)));
typedef unsigned u32x4 __attribute__((ext_vector_type(4)));
__device__ __forceinline__ int crow(int r, int hi) { return (r & 3) + 8 * (r >> 2) + 4 * hi; }
__device__ __forceinline__ float pl32_max(float v) { auto rr = __builtin_amdgcn_permlane32_swap(__float_as_uint(v), __float_as_uint(v), false, false); return fmaxf(__uint_as_float(rr[0]), __uint_as_float(rr[1])); }
__device__ __forceinline__ float pl32_sum(float v) { auto rr = __builtin_amdgcn_permlane32_swap(__float_as_uint(v), __float_as_uint(v), false, false); return __uint_as_float(rr[0]) + __uint_as_float(rr[1]); }
__device__ __forceinline__ unsigned pl32_other(unsigned v, int hi) { auto rr = __builtin_amdgcn_permlane32_swap(v, v, false, false); return hi ? rr[0] : rr[1]; }
__device__ __forceinline__ s16x4 vtr(const LAS unsigned char* p) { return __builtin_bit_cast(s16x4, __builtin_amdgcn_ds_read_tr16_b64_v4i16((LAS s16x4*)p)); }
__device__ __forceinline__ void sincos_d(double a, double& s, double& c) {
    const double two_over_pi = 0.63661977236758134308, pio2_hi = 1.57079632679489655800e+00, pio2_lo = 6.12323399573676603587e-17;
    const double kq = rint(a * two_over_pi);
    double r = (a - kq * pio2_hi) - kq * pio2_lo;
    const double r2 = r * r;
    double sp = r * (1.0 + r2 * (-1.0 / 6 + r2 * (1.0 / 120 + r2 * (-1.0 / 5040 + r2 * (1.0 / 362880 + r2 * (-1.0 / 39916800 + r2 * (1.0 / 6227020800.0 + r2 * (-1.0 / 1307674368000.0))))))));
    double cp = 1.0 + r2 * (-0.5 + r2 * (1.0 / 24 + r2 * (-1.0 / 720 + r2 * (1.0 / 40320 + r2 * (-1.0 / 3628800 + r2 * (1.0 / 479001600.0 + r2 * (-1.0 / 87178291200.0 + r2 * (1.0 / 20922789888000.0))))))));
    const int q = ((int)kq) & 3;
    if (q == 0) { s = sp; c = cp; } else if (q == 1) { s = cp; c = -sp; } else if (q == 2) { s = -sp; c = -cp; } else { s = -cp; c = sp; }
}

__device__ __forceinline__ void ph_mod(const Ctx& C, int TID, int bid, int nblk, LAS float* lds) {
    const float* c = C.in[1]; const float* w_mod = C.in[15]; const float* b_mod = C.in[16];
    float* MOD = (float*)(C.ws + WS_MOD);
    LAS float* cs = lds;
    LAS float* red = lds + 8192;
    const int tid = TID, nn = tid & 63, kg = tid >> 6;
    __syncthreads();
    for (int idx = tid; idx < NB * D; idx += NT) cs[idx] = siluf(c[idx]);
    __syncthreads();
    for (int item = bid; item < DEPTH * (6 * D / 64); item += nblk) {
        const int l = item / (6 * D / 64), n = (item % (6 * D / 64)) * 64 + nn;
        const float* w = w_mod + (size_t)l * D * 6 * D + n;
        float acc[8];
#pragma unroll
        for (int b = 0; b < 8; ++b) acc[b] = 0.f;
        for (int k0 = kg * 128; k0 < kg * 128 + 128; k0 += 16) {
            float wv[16];
#pragma unroll
            for (int i = 0; i < 16; ++i) wv[i] = w[(size_t)(k0 + i) * 6 * D];
#pragma unroll
            for (int i = 0; i < 16; ++i)
#pragma unroll
                for (int b = 0; b < 8; ++b) acc[b] += cs[b * D + k0 + i] * wv[i];
        }
#pragma unroll
        for (int b = 0; b < 8; ++b) red[(kg * 8 + b) * 64 + nn] = acc[b];
        __syncthreads();
        { const int b = tid >> 6; float s = b_mod[l * 6 * D + n];
#pragma unroll
          for (int g = 0; g < 8; ++g) s += red[(g * 8 + b) * 64 + nn];
          MOD[(size_t)(l * NB + b) * 6 * D + n] = s; }
        __syncthreads();
    }
}
__device__ __forceinline__ void ph_rope(const Ctx& C, int TID, int bid, int nblk) {
    const int* pos = (const int*)C.in[2];
    float* RC = (float*)(C.ws + WS_ROPE); float* RS = RC + (size_t)M * 8;
    const double invf[8] = {1.0, 0.19392274474868576, 0.03760603093086393, 0.007292664737217109, 0.001414213562373095, 0.0002742481756762073, 5.318295896944988e-05, 1.031338537721246e-05};
    for (int idx = bid * NT + TID; idx < M * 8; idx += nblk * NT) {
        const int i = idx & 7, m = idx >> 3;
        double f = invf[0];
#pragma unroll
        for (int j = 1; j < 8; ++j) f = (i == j) ? invf[j] : f;
        double s, c; sincos_d((double)pos[m] * f, s, c);
        RC[idx] = (float)c; RS[idx] = (float)s;
    }
}
__device__ __forceinline__ void adaln_row(const float (&xv)[16], const float* g, const float* sc, const float* sh, f16* hrow, int lane) {
    float ss = 0.f;
#pragma unroll
    for (int j = 0; j < 16; ++j) ss += xv[j] * xv[j];
    const float r = rsqrtf(wave_sum(ss) * (1.f / D) + EPS);
#pragma unroll
    for (int j = 0; j < 4; ++j) {
        const int c0 = 256 * j + 4 * lane;
        const f32x4 gv = *(const f32x4*)(g + c0), scv = *(const f32x4*)(sc + c0), shv = *(const f32x4*)(sh + c0);
        f16x4 o;
#pragma unroll
        for (int e = 0; e < 4; ++e) o[e] = (f16)(xv[4 * j + e] * r * gv[e] * (1.f + scv[e]) + shv[e]);
        *(f16x4*)(hrow + c0) = o;
    }
}
__device__ __forceinline__ void ph_norm0(const Ctx& C, int TID, int bid, int nblk) {
    const float* x = C.in[0]; const float* norm_g = C.in[14]; const float* MOD = (const float*)(C.ws + WS_MOD);
    f16* H = (f16*)(C.ws + WS_H);
    const int lane = TID & 63, gw = bid * NWAVE + (TID >> 6), ngw = nblk * NWAVE;
    for (int m = gw; m < M; m += ngw) {
        const int b = m / S;
        float xv[16];
#pragma unroll
        for (int j = 0; j < 4; ++j) { const f32x4 v = *(const f32x4*)(x + (size_t)m * D + 256 * j + 4 * lane); xv[4 * j] = v[0]; xv[4 * j + 1] = v[1]; xv[4 * j + 2] = v[2]; xv[4 * j + 3] = v[3]; }
        const float* mod = MOD + (size_t)(0 * NB + b) * 6 * D;
        adaln_row(xv, norm_g + 0, mod + D, mod + 0, H + (size_t)m * D, lane);
    }
}
__device__ __forceinline__ void ph_resnorm(const Ctx& C, int l, int sub, int TID, int bid, int nblk) {
    const float* norm_g = C.in[14]; const float* MOD = (const float*)(C.ws + WS_MOD);
    const f16* Y = (const f16*)(C.ws + WS_Y); f16* H = (f16*)(C.ws + WS_H);
    const float* xsrc = (l == 0 && sub == 0) ? C.in[0] : C.out;
    const float* ga = norm_g + (size_t)(l * 4 + (sub == 0 ? 1 : 3)) * D;
    const bool has_next = !(l == DEPTH - 1 && sub == 1);
    const int ln = sub == 0 ? l : l + 1;
    const float* gb = norm_g + (size_t)((has_next ? ln : 0) * 4 + (sub == 0 ? 2 : 0)) * D;
    const int lane = TID & 63, gw = bid * NWAVE + (TID >> 6), ngw = nblk * NWAVE;
    for (int m = gw; m < M; m += ngw) {
        const int b = m / S;
        const float* mod = MOD + (size_t)(l * NB + b) * 6 * D;
        const float* gt = mod + (sub == 0 ? 2 : 5) * D;
        float yv[16], xv[16]; float ss = 0.f;
#pragma unroll
        for (int j = 0; j < 4; ++j) {
            const f16x4 v = *(const f16x4*)(Y + (size_t)m * D + 256 * j + 4 * lane);
#pragma unroll
            for (int e = 0; e < 4; ++e) { yv[4 * j + e] = (float)v[e]; ss += yv[4 * j + e] * yv[4 * j + e]; }
        }
        const float r = rsqrtf(wave_sum(ss) * (1.f / D) + EPS);
#pragma unroll
        for (int j = 0; j < 4; ++j) {
            const int c0 = 256 * j + 4 * lane;
            const f32x4 xo = *(const f32x4*)(xsrc + (size_t)m * D + c0), gav = *(const f32x4*)(ga + c0), gtv = *(const f32x4*)(gt + c0);
            f32x4 xn;
#pragma unroll
            for (int e = 0; e < 4; ++e) { xn[e] = xo[e] + gtv[e] * (yv[4 * j + e] * r * gav[e]); xv[4 * j + e] = xn[e]; }
            *(f32x4*)(C.out + (size_t)m * D + c0) = xn;
        }
        if (has_next) {
            const float* modn = MOD + (size_t)(ln * NB + b) * 6 * D;
            adaln_row(xv, gb, modn + (sub == 0 ? 4 : 1) * D, modn + (sub == 0 ? 3 : 0) * D, H + (size_t)m * D, lane);
        }
    }
}

__device__ __forceinline__ void ph_conv(const Ctx& C, int l, int TID, int bid, int nblk) {
    const f16* Z = (const f16*)(C.ws + WS_Z); f16* MIX = (f16*)(C.ws + WS_MIX);
    const float* cw = C.in[4] + (size_t)l * 3 * 256; const float* gain = C.in[12] + (size_t)l * D;
    const int lane = TID & 63, gw = bid * NWAVE + (TID >> 6), ngw = nblk * NWAVE;
    for (int m = gw; m < M; m += ngw) {
        const int t = m % S;
        float o[4]; float ss = 0.f;
#pragma unroll
        for (int j = 0; j < 4; ++j) {
            const int ch = lane + 64 * j; float y = 0.f;
#pragma unroll
            for (int k = 0; k < 3; ++k) {
                const int tt = t - 2 + k;
                if (tt >= 0) { const f16* zr = Z + (size_t)(m - 2 + k) * ZP; y += (float)zr[ZC_AC + ch] * (float)zr[ZC_AH + ch] * cw[k * 256 + ch]; }
            }
            o[j] = (float)Z[(size_t)m * ZP + ZC_AB + ch] * y; ss += o[j] * o[j];
        }
        const float r = rsqrtf(wave_sum(ss) * (1.f / 256) + EPS);
#pragma unroll
        for (int j = 0; j < 4; ++j) { const int ch = lane + 64 * j; MIX[(size_t)m * D + ch] = (f16)(o[j] * r * gain[ch]); }
    }
}
__device__ __forceinline__ void ph_rotk(const Ctx& C, int TID, int bid, int nblk) {
    const f16* Z = (const f16*)(C.ws + WS_Z); f16* KSR = (f16*)(C.ws + WS_KSR); f16* KWR = (f16*)(C.ws + WS_KWR);
    const float* RC = (const float*)(C.ws + WS_ROPE); const float* RS = RC + (size_t)M * 8;
    for (int idx = bid * NT + TID; idx < M * 128; idx += nblk * NT) {
        const int d = idx & 63, which = (idx >> 6) & 1, m = idx >> 7;
        const f16* zr = Z + (size_t)m * ZP + (which ? ZC_KWIN : ZC_KSLC);
        float v = (float)zr[d];
        if (d < 16) { const int i = d & 7; const float cs = RC[m * 8 + i], sn = RS[m * 8 + i];
            if (d < 8) v = v * cs - (float)zr[d + 8] * sn; else v = v * cs + (float)zr[d - 8] * sn; }
        (which ? KWR : KSR)[(size_t)m * 64 + d] = (f16)v;
    }
}
__device__ __forceinline__ void ph_cmp1(const Ctx& C, int l, int TID, int bid, int nblk) {
    const f16* Z = (const f16*)(C.ws + WS_Z); float* G = (float*)(C.ws + WS_G);
    const f16* W1T = (const f16*)(C.ws + WS_W1T) + (size_t)l * 2 * 256 * 1024;
    const int lane = TID & 63, r32 = lane & 31, hi = lane >> 5, gw = bid * NWAVE + (TID >> 6), ngw = nblk * NWAVE;
    for (int it = gw; it < 2 * 64 * 8; it += ngw) {
        const int ct = it & 7, rt = (it >> 3) & 63, j = it >> 9;
        const int row = rt * 32 + r32;
        const f16* ap = Z + ((size_t)(row >> 8) * S + 16 * (row & 255)) * ZP + (j ? ZC_VCMP : ZC_KCMP) + 8 * hi;
        const f16* bp = W1T + ((size_t)j * 256 + ct * 32 + r32) * 1024 + 8 * hi;
        f32x16 acc;
#pragma unroll
        for (int r = 0; r < 16; ++r) acc[r] = 0.f;
        for (int k8 = 0; k8 < 64; k8 += 8) {
            f16x8 av[8], bv[8];
#pragma unroll
            for (int i = 0; i < 8; ++i) { const int ks = k8 + i; av[i] = *(const f16x8*)(ap + (size_t)(ks >> 2) * ZP + (ks & 3) * 16); bv[i] = *(const f16x8*)(bp + ks * 16); }
#pragma unroll
            for (int i = 0; i < 8; ++i) acc = __builtin_amdgcn_mfma_f32_32x32x16_f16(av[i], bv[i], acc, 0, 0, 0);
        }
        float* gp = G + ((size_t)j * 2048 + rt * 32) * 256 + ct * 32 + r32;
#pragma unroll
        for (int r = 0; r < 16; ++r) gp[(size_t)crow(r, hi) * 256] = acc[r];
    }
}
__device__ __forceinline__ void ph_cmp2(const Ctx& C, int l, int TID, int bid, int nblk, LAS float* lds) {
    const float* G = (const float*)(C.ws + WS_G); const float* PCB = (const float*)(C.ws + WS_PCB) + (size_t)l * 2 * 32 * 128;
    float* KC = (float*)(C.ws + WS_KC); float* VC = (float*)(C.ws + WS_VC);
    const float* w2 = C.in[7] + (size_t)l * 2 * 128 * 64;
    LAS float* w2s = lds;
    LAS float* cbs = lds + 16384;
    LAS float* hs = lds + 16640 + (TID >> 6) * 128;
    const int tid = TID, lane = tid & 63, gw = bid * NWAVE + (tid >> 6), ngw = nblk * NWAVE;
    __syncthreads();
    for (int idx = tid; idx < 2 * 128 * 64; idx += NT) w2s[idx] = w2[idx];
    if (tid < 256) { float s = 0.f; for (int q = 0; q < 32; ++q) s += PCB[((tid >> 7) * 32 + q) * 128 + (tid & 127)]; cbs[tid] = s; }
    __syncthreads();
    for (int it = gw; it < 2 * NB * NCMP; it += ngw) {
        const int j = it / (NB * NCMP), bi = it % (NB * NCMP), b = bi / NCMP, i = bi % NCMP;
        const float* g0 = G + ((size_t)j * 2048 + b * 256 + i) * 256;
#pragma unroll
        for (int q = 0; q < 2; ++q) { const int o = lane + 64 * q; hs[o] = siluf(g0[o] + g0[256 + 128 + o] + cbs[j * 128 + o]); }
        WAVE_LDS_SYNC();
        float acc = 0.f;
#pragma unroll 16
        for (int o = 0; o < 128; ++o) acc += hs[o] * w2s[(j * 128 + o) * 64 + lane];
        (j ? VC : KC)[(size_t)bi * 64 + lane] = acc;
        WAVE_LDS_SYNC();
    }
}
constexpr int NSA_SEL_OFF = 143360;
constexpr int NSA_WSF_OFF = 32768;
constexpr float NSA_C2 = 0.125f * 1.4426950408889634f;

__device__ __forceinline__ void nsa_cmp_unit(const Ctx& C, int b, int c, int TID, LAS float* lds) {
    const f16* Z = (const f16*)(C.ws + WS_Z); f16* OCMP = (f16*)(C.ws + WS_OCMP);
    const float* KC = (const float*)(C.ws + WS_KC); const float* VC = (const float*)(C.ws + WS_VC);
    const int tid = TID, lane = tid & 63, wave = tid >> 6;
    LAS float* kcs = lds;
    LAS f16* vcs = (LAS f16*)(lds + 16640);
    LAS float* wsb = lds + 24832 + wave * 1280;
    LAS float* Pc = wsb;
    LAS float* qs = wsb + 1024;
    LAS unsigned long long* SELS = (LAS unsigned long long*)((LAS unsigned char*)lds + NSA_SEL_OFF);
    const float NEG = -__builtin_inff();
    const int t0 = 64 * c; const size_t m0 = (size_t)b * S + t0;
    int nload = (t0 + 63 >= 31) ? (t0 + 63 - 31) / 16 + 1 : 0; if (nload > NCMP) nload = NCMP;
    for (int idx = tid; idx < nload * 64; idx += NT) { kcs[(idx >> 6) * 65 + (idx & 63)] = KC[((size_t)b * NCMP + (idx >> 6)) * 64 + (idx & 63)]; vcs[idx] = (f16)VC[(size_t)b * NCMP * 64 + idx]; }
    __syncthreads();
    for (int ti = 0; ti < 8; ++ti) {
        const int tt = 8 * wave + ti, t = t0 + tt; const size_t m = m0 + tt;
        const f16* zr = Z + m * ZP;
#pragma unroll
        for (int h = 0; h < 4; ++h) qs[h * 64 + lane] = (float)zr[ZC_NQ + 64 * h + lane];
        WAVE_LDS_SYNC();
        int ncv = t >= 31 ? (t - 31) / 16 + 1 : 0; if (ncv > NCMP) ncv = NCMP;
        float sc[4][4];
#pragma unroll
        for (int h = 0; h < 4; ++h)
#pragma unroll
            for (int r = 0; r < 4; ++r) sc[h][r] = 0.f;
        for (int d = 0; d < 64; ++d) {
            float kv[4];
#pragma unroll
            for (int r = 0; r < 4; ++r) { const int i = lane + 64 * r; kv[r] = (i < ncv) ? kcs[i * 65 + d] : 0.f; }
#pragma unroll
            for (int h = 0; h < 4; ++h) { const float qv = qs[h * 64 + d];
#pragma unroll
                for (int r = 0; r < 4; ++r) sc[h][r] += qv * kv[r]; }
        }
#pragma unroll
        for (int h = 0; h < 4; ++h) {
            float mx = NEG;
#pragma unroll
            for (int r = 0; r < 4; ++r) { const int i = lane + 64 * r; sc[h][r] = (i < ncv) ? sc[h][r] * 0.125f : NEG; mx = fmaxf(mx, sc[h][r]); }
            mx = wave_max(mx);
            float e[4], sum = 0.f;
#pragma unroll
            for (int r = 0; r < 4; ++r) { const int i = lane + 64 * r; e[r] = (i < ncv) ? expf(sc[h][r] - mx) : 0.f; sum += e[r]; }
            sum = wave_sum(sum);
            const float inv = ncv > 0 ? 1.f / sum : 0.f;
#pragma unroll
            for (int r = 0; r < 4; ++r) Pc[h * 256 + lane + 64 * r] = e[r] * inv;
        }
        WAVE_LDS_SYNC();
        float ocmp[4] = {0.f, 0.f, 0.f, 0.f};
        for (int i = 0; i < ncv; ++i) { const float vv = (float)vcs[i * 64 + lane];
#pragma unroll
            for (int h = 0; h < 4; ++h) ocmp[h] += Pc[h * 256 + i] * vv; }
#pragma unroll
        for (int h = 0; h < 4; ++h) { const float g0 = sigmoidf_((float)zr[ZC_NG + 3 * h + 0]); OCMP[m * 256 + 64 * h + lane] = (f16)(g0 * ocmp[h]); }
        float pslc = 0.f;
#pragma unroll
        for (int h = 0; h < 4; ++h) {
            const LAS float* P = Pc + h * 256 + 4 * lane;
            pslc += (lane > 0 ? P[-1] : 0.f) + 2.f * P[0] + 2.f * P[1] + 2.f * P[2] + P[3];
        }
        const int cur = t >> 6;
        const bool forced = (lane < 1) || (cur - lane >= 0 && cur - lane < 2);
        const float score = (lane <= cur) ? pslc + (forced ? 1e4f : 0.f) : -1e30f;
        int rank = 0;
        for (int jj = 0; jj < 64; ++jj) { const float o = __shfl(score, jj); rank += (o > score || (o == score && jj < lane)) ? 1 : 0; }
        const unsigned long long selmask = __ballot(rank < 16);
        if (lane == 0) SELS[tt] = selmask;
        WAVE_LDS_SYNC();
    }
}

#define NSA_ISSUE(jt, slot) do { \
        const f16* ksrc_ = Kg + (size_t)(64 * (jt) + lane) * 64 + wid * 8; \
        const f16* vsrc_ = Vg + (size_t)(64 * (jt) + 16 * (wid & 3) + (lane >> 2)) * ZP + (wid >> 2) * 32 + (lane & 3) * 8; \
        __builtin_amdgcn_global_load_lds((const unsigned*)ksrc_, (LAS unsigned*)(lds + (slot) * 8192 + wid * 1024), 16, 0, 0); \
        __builtin_amdgcn_global_load_lds((const unsigned*)vsrc_, (LAS unsigned*)(lds + 16384 + (slot) * 8192 + wid * 1024), 16, 0, 0); } while (0)

template <int MODE>
__device__ __forceinline__ void nsa_branch(const f16* Kg, const f16* Vg, int c, unsigned long long sel, int tokw, const f16x8 (&qf)[4], f32x16 (&o)[2], float& lsum,
                                           LAS unsigned char* lds, int wid, int lane, int r32, int hi) {
    const float NEG = -__builtin_inff();
    float m = NEG; lsum = 0.f;
#pragma unroll
    for (int r = 0; r < 16; ++r) { o[0][r] = 0.f; o[1][r] = 0.f; }
    LAS float* wsf = (LAS float*)(lds + NSA_WSF_OFF) + wid * 64;
    const int ntiles = MODE == 0 ? c + 1 : (c < 8 ? c + 1 : 9);
    const LAS unsigned char* vlane = lds + 16384 + ((lane >> 4) & 1) * 32 + (lane & 3) * 8 + (4 * hi + ((lane & 15) >> 2)) * 64;
    NSA_ISSUE((MODE == 0 ? 0 : c), 0);
    for (int i = 0; i < ntiles; ++i) {
        const int j = MODE == 0 ? i : c - i, slot = i & 1;
        asm volatile("s_waitcnt vmcnt(0)" ::: "memory");
        __syncthreads();
        if (i + 1 < ntiles) { const int jn = MODE == 0 ? i + 1 : c - i - 1; NSA_ISSUE(jn, slot ^ 1); }
        f32x16 p0, p1;
#pragma unroll
        for (int r = 0; r < 16; ++r) { p0[r] = 0.f; p1[r] = 0.f; }
        const LAS unsigned char* kb = lds + slot * 8192 + hi * 1024 + r32 * 16;
#pragma unroll
        for (int d0 = 0; d0 < 4; ++d0) {
            const f16x8 k0 = *(const LAS f16x8*)(kb + d0 * 2048), k1 = *(const LAS f16x8*)(kb + d0 * 2048 + 512);
            p0 = __builtin_amdgcn_mfma_f32_32x32x16_f16(k0, qf[d0], p0, 0, 0, 0);
            p1 = __builtin_amdgcn_mfma_f32_32x32x16_f16(k1, qf[d0], p1, 0, 0, 0);
        }
        if (j == c) {
#pragma unroll
            for (int r = 0; r < 16; ++r) { const int kk = crow(r, hi); if (kk > tokw) p0[r] = NEG; if (kk + 32 > tokw) p1[r] = NEG; }
        }
        if (MODE == 1 && j == c - 8) {
#pragma unroll
            for (int r = 0; r < 16; ++r) { const int kk = crow(r, hi); if (kk <= tokw) p0[r] = NEG; if (kk + 32 <= tokw) p1[r] = NEG; }
        }
        if (MODE == 0) {
            const bool rowsel = (sel >> j) & 1ull;
#pragma unroll
            for (int r = 0; r < 16; ++r) { p0[r] = rowsel ? p0[r] : NEG; p1[r] = rowsel ? p1[r] : NEG; }
        }
        float rm = fmaxf(p0[0], p1[0]);
#pragma unroll
        for (int r = 1; r < 16; ++r) rm = fmaxf(rm, fmaxf(p0[r], p1[r]));
        rm = pl32_max(rm);
        const float mnew = fmaxf(m, rm);
        const float corr = __builtin_amdgcn_exp2f(m - mnew);
        float ps = 0.f;
#pragma unroll
        for (int r = 0; r < 16; ++r) { p0[r] = __builtin_amdgcn_exp2f(p0[r] - mnew); p1[r] = __builtin_amdgcn_exp2f(p1[r] - mnew); ps += p0[r] + p1[r]; }
        lsum = lsum * corr + ps; m = mnew;
        if (__any(corr != 1.0f)) {
            if (hi == 0) wsf[r32] = corr;
            WAVE_LDS_SYNC();
#pragma unroll
            for (int r = 0; r < 16; ++r) { const float f = wsf[crow(r, hi)]; o[0][r] *= f; o[1][r] *= f; }
            WAVE_LDS_SYNC();
        }
        f16x8 pa[4];
#pragma unroll
        for (int e = 0; e < 8; ++e) { pa[0][e] = (f16)p0[e]; pa[1][e] = (f16)p0[8 + e]; pa[2][e] = (f16)p1[e]; pa[3][e] = (f16)p1[8 + e]; }
        const LAS unsigned char* vs = vlane + slot * 8192;
#pragma unroll
        for (int d0 = 0; d0 < 2; ++d0)
#pragma unroll
            for (int ks = 0; ks < 4; ++ks) {
                const s16x4 lo = vtr(vs + d0 * 4096 + ks * 1024), hh = vtr(vs + d0 * 4096 + ks * 1024 + 512);
                typedef short s16x8 __attribute__((ext_vector_type(8)));
                const s16x8 bv = {lo[0], lo[1], lo[2], lo[3], hh[0], hh[1], hh[2], hh[3]};
                o[d0] = __builtin_amdgcn_mfma_f32_32x32x16_f16(pa[ks], __builtin_bit_cast(f16x8, bv), o[d0], 0, 0, 0);
            }
    }
    __syncthreads();
}

__device__ __forceinline__ void nsa_attn_unit(const Ctx& C, int l, int b, int c, int TID, LAS unsigned char* lds) {
    const f16* Z = (const f16*)(C.ws + WS_Z); f16* MIX = (f16*)(C.ws + WS_MIX); const f16* OCMP = (const f16*)(C.ws + WS_OCMP);
    const f16* KSR = (const f16*)(C.ws + WS_KSR); const f16* KWR = (const f16*)(C.ws + WS_KWR);
    const float* RC = (const float*)(C.ws + WS_ROPE); const float* RS = RC + (size_t)M * 8;
    const float* gain = C.in[12] + (size_t)l * D + 256;
    const int tid = TID, lane = tid & 63, wid = __builtin_amdgcn_readfirstlane(tid >> 6), r32 = lane & 31, hi = lane >> 5;
    const size_t m0 = (size_t)b * S + 64 * c;
    const int tokw = 8 * wid + (r32 >> 2), head = r32 & 3;
    const size_t mrow = m0 + tokw;
    const LAS unsigned long long* SELS = (const LAS unsigned long long*)(lds + NSA_SEL_OFF);
    const unsigned long long sel = SELS[tokw];
    f16x8 qf[4];
#pragma unroll
    for (int d0 = 0; d0 < 4; ++d0) qf[d0] = *(const f16x8*)(Z + mrow * ZP + ZC_NQ + 64 * head + 16 * d0 + 8 * hi);
    {
        const u32x4 w = __builtin_bit_cast(u32x4, qf[0]); u32x4 ow;
#pragma unroll
        for (int k = 0; k < 4; ++k) ow[k] = pl32_other(w[k], hi);
        const f16x8 of = __builtin_bit_cast(f16x8, ow);
        const f32x4 c0 = *(const f32x4*)(RC + mrow * 8), c1 = *(const f32x4*)(RC + mrow * 8 + 4), s0 = *(const f32x4*)(RS + mrow * 8), s1 = *(const f32x4*)(RS + mrow * 8 + 4);
#pragma unroll
        for (int i = 0; i < 8; ++i) {
            const float cs = i < 4 ? c0[i & 3] : c1[i & 3], sn = i < 4 ? s0[i & 3] : s1[i & 3];
            const float a = (float)qf[0][i], bq = (float)of[i];
            const float r = hi ? a * cs + bq * sn : a * cs - bq * sn;
            qf[0][i] = (f16)(r * NSA_C2);
        }
#pragma unroll
        for (int d0 = 1; d0 < 4; ++d0)
#pragma unroll
            for (int i = 0; i < 8; ++i) qf[d0][i] = (f16)((float)qf[d0][i] * NSA_C2);
    }
    LAS float* wsf = (LAS float*)(lds + NSA_WSF_OFF) + wid * 64;
    f32x16 tot[2], o[2]; float lsum;
#pragma unroll
    for (int r = 0; r < 16; ++r) { tot[0][r] = 0.f; tot[1][r] = 0.f; }
    const f16* zrow = Z + mrow * ZP;
    nsa_branch<0>(KSR + (size_t)b * S * 64, Z + (size_t)b * S * ZP + ZC_VSLC, c, sel, tokw, qf, o, lsum, lds, wid, lane, r32, hi);
    {
        const float f = sigmoidf_((float)zrow[ZC_NG + 3 * head + 1]) / pl32_sum(lsum);
        if (hi == 0) wsf[r32] = f;
        WAVE_LDS_SYNC();
#pragma unroll
        for (int r = 0; r < 16; ++r) { const float fr = wsf[crow(r, hi)]; tot[0][r] += o[0][r] * fr; tot[1][r] += o[1][r] * fr; }
        WAVE_LDS_SYNC();
    }
    nsa_branch<1>(KWR + (size_t)b * S * 64, Z + (size_t)b * S * ZP + ZC_VWIN, c, sel, tokw, qf, o, lsum, lds, wid, lane, r32, hi);
    {
        const float f = sigmoidf_((float)zrow[ZC_NG + 3 * head + 2]) / pl32_sum(lsum);
        if (hi == 0) wsf[r32] = f;
        WAVE_LDS_SYNC();
#pragma unroll
        for (int r = 0; r < 16; ++r) { const float fr = wsf[crow(r, hi)]; tot[0][r] += o[0][r] * fr; tot[1][r] += o[1][r] * fr; }
        WAVE_LDS_SYNC();
    }
#pragma unroll
    for (int k = 0; k < 4; ++k) {
        const size_t mm = m0 + 8 * wid + 2 * k + hi;
        float ss = 0.f;
#pragma unroll
        for (int hd = 0; hd < 4; ++hd)
#pragma unroll
            for (int d0 = 0; d0 < 2; ++d0) { const float v = tot[d0][4 * k + hd] + (float)OCMP[mm * 256 + 64 * hd + 32 * d0 + r32]; tot[d0][4 * k + hd] = v; ss += v * v; }
#pragma unroll
        for (int off = 1; off < 32; off <<= 1) ss += __shfl_xor(ss, off);
        const float rinv = rsqrtf(ss * (1.f / 256) + EPS);
#pragma unroll
        for (int hd = 0; hd < 4; ++hd)
#pragma unroll
            for (int d0 = 0; d0 < 2; ++d0) MIX[mm * D + 256 + 64 * hd + 32 * d0 + r32] = (f16)(tot[d0][4 * k + hd] * rinv * gain[64 * hd + 32 * d0 + r32]);
    }
}
__device__ __forceinline__ void ph_nsa(const Ctx& C, int l, int TID, int bid, int nblk, LAS float* lds) {
    for (int item = bid; item < 256; item += nblk) {
        const int b = item >> 5, s = item & 31;
        for (int u = 0; u < 2; ++u) {
            const int c = u == 0 ? s : 63 - s;
            __syncthreads();
            nsa_cmp_unit(C, b, c, TID, lds);
            __syncthreads();
            nsa_attn_unit(C, l, b, c, TID, (LAS unsigned char*)lds);
        }
    }
}
__device__ __forceinline__ void ph_gla1(const Ctx& C, int l, int TID, int bid, int nblk) {
    const f16* Z = (const f16*)(C.ws + WS_Z); float* LA = (float*)(C.ws + WS_LA);
    const float* w2 = C.in[8] + (size_t)l * 16 * 128; const float* gb = C.in[9] + (size_t)l * 128;
    for (int idx = bid * NT + TID; idx < M * 128; idx += nblk * NT) {
        const int dim = idx & 127, m = idx >> 7;
        const f16* lr = Z + (size_t)m * ZP + ZC_LR;
        float a = gb[dim];
#pragma unroll
        for (int r = 0; r < 16; ++r) a += (float)lr[r] * w2[r * 128 + dim];
        const float ls = fminf(a, 0.f) - log1pf(expf(-fabsf(a)));
        LA[idx] = ls * (1.f / 16.f);
    }
}
__device__ __forceinline__ void ph_gla2(const Ctx& C, int TID, int bid, int nblk) {
    float* LA = (float*)(C.ws + WS_LA);
    const int total = (M / 64) * 128;
    for (int idx = bid * NT + TID; idx < total; idx += nblk * NT) {
        const int dim = idx & 127, ch = idx >> 7;
        float run = 0.f;
        for (int t0 = 0; t0 < 64; t0 += 16) {
            float v[16];
#pragma unroll
            for (int i = 0; i < 16; ++i) v[i] = LA[((size_t)ch * 64 + t0 + i) * 128 + dim];
#pragma unroll
            for (int i = 0; i < 16; ++i) { run += v[i]; LA[((size_t)ch * 64 + t0 + i) * 128 + dim] = run; }
        }
    }
}
__device__ __forceinline__ void ph_gla3(const Ctx& C, int TID, int bid, int nblk, LAS float* lds) {
    const f16* Z = (const f16*)(C.ws + WS_Z); const float* Bc = (const float*)(C.ws + WS_LA);
    float* QE2 = (float*)(C.ws + WS_QE2); float* OI = (float*)(C.ws + WS_OI); float* KV = (float*)(C.ws + WS_KV);
    LAS float* qe = lds; LAS float* ke = lds + 2112; LAS float* k2 = lds + 4224; LAS float* vs = lds + 6336; LAS float* att = lds + 10432;
    const int tid = TID;
    for (int item = bid; item < NB * 4 * 64; item += nblk) {
        const int n = item & 63, h = (item >> 6) & 3, b = item >> 8;
        const size_t m0 = (size_t)b * S + n * 64;
        __syncthreads();
        for (int idx = tid; idx < 2048; idx += NT) {
            const int tt = idx >> 5, d = idx & 31;
            const float bb = Bc[(m0 + tt) * 128 + 32 * h + d], bmid = Bc[(m0 + 32) * 128 + 32 * h + d], blast = Bc[(m0 + 63) * 128 + 32 * h + d];
            const float qv = (float)Z[(m0 + tt) * ZP + ZC_LQ + 32 * h + d] * 0.17677669529663687f, kv = (float)Z[(m0 + tt) * ZP + ZC_LK + 32 * h + d];
            qe[tt * 33 + d] = qv * expf(bb - bmid); ke[tt * 33 + d] = kv * expf(bmid - bb); k2[tt * 33 + d] = kv * expf(blast - bb);
            QE2[(m0 + tt) * 128 + 32 * h + d] = qv * expf(bb);
        }
        for (int idx = tid; idx < 4096; idx += NT) { const int tt = idx >> 6, v = idx & 63; vs[idx] = (float)Z[(m0 + tt) * ZP + ZC_LV + 64 * h + v]; }
        __syncthreads();
        for (int idx = tid; idx < 4096; idx += NT) {
            const int tt = idx >> 6, s = idx & 63; float a = 0.f;
            if (s <= tt) { for (int d = 0; d < 32; ++d) a += qe[tt * 33 + d] * ke[s * 33 + d]; }
            att[tt * 65 + s] = a;
        }
        __syncthreads();
        for (int idx = tid; idx < 4096; idx += NT) {
            const int tt = idx >> 6, v = idx & 63; float o = 0.f;
            for (int s = 0; s <= tt; ++s) o += att[tt * 65 + s] * vs[s * 64 + v];
            OI[(m0 + tt) * 256 + 64 * h + v] = o;
        }
        for (int idx = tid; idx < 2048; idx += NT) {
            const int d = idx >> 6, v = idx & 63; float a = 0.f;
            for (int s = 0; s < 64; ++s) a += k2[s * 33 + d] * vs[s * 64 + v];
            KV[(size_t)item * 2048 + idx] = a;
        }
    }
}
__device__ __forceinline__ void ph_gla4(const Ctx& C, int TID, int bid, int nblk) {
    const float* Bc = (const float*)(C.ws + WS_LA); const float* KV = (const float*)(C.ws + WS_KV); float* SP = (float*)(C.ws + WS_SPREV);
    for (int idx = bid * NT + TID; idx < NB * 4 * 2048; idx += nblk * NT) {
        const int dv = idx & 2047, bh = idx >> 11, d = dv >> 6, h = bh & 3, b = bh >> 2;
        float st = 0.f;
        for (int n0 = 0; n0 < 64; n0 += 16) {
            float kvv[16], bl[16];
#pragma unroll
            for (int i = 0; i < 16; ++i) { kvv[i] = KV[((size_t)bh * 64 + n0 + i) * 2048 + dv]; bl[i] = Bc[((size_t)b * S + (n0 + i) * 64 + 63) * 128 + 32 * h + d]; }
#pragma unroll
            for (int i = 0; i < 16; ++i) { SP[((size_t)bh * 64 + n0 + i) * 2048 + dv] = st; st = expf(bl[i]) * st + kvv[i]; }
        }
    }
}
__device__ __forceinline__ void ph_gla5(const Ctx& C, int l, int TID, int bid, int nblk) {
    const f16* Z = (const f16*)(C.ws + WS_Z); f16* MIX = (f16*)(C.ws + WS_MIX);
    const float* QE2 = (const float*)(C.ws + WS_QE2); const float* OI = (const float*)(C.ws + WS_OI); const float* SP = (const float*)(C.ws + WS_SPREV);
    const float* gain = C.in[12] + (size_t)l * D + 512;
    const int lane = TID & 63, gw = bid * NWAVE + (TID >> 6), ngw = nblk * NWAVE;
    for (int m = gw; m < M; m += ngw) {
        const int b = m / S, t = m % S, n = t >> 6;
        float og[4]; float ss = 0.f;
#pragma unroll
        for (int h = 0; h < 4; ++h) {
            float o = OI[(size_t)m * 256 + 64 * h + lane];
            const float* sp = SP + ((size_t)(b * 4 + h) * 64 + n) * 2048 + lane; const float* qe = QE2 + (size_t)m * 128 + 32 * h;
            float spv[32];
#pragma unroll
            for (int d = 0; d < 32; ++d) spv[d] = sp[d * 64];
#pragma unroll
            for (int d4 = 0; d4 < 8; ++d4) { const f32x4 q4 = *(const f32x4*)(qe + 4 * d4);
#pragma unroll
                for (int e = 0; e < 4; ++e) o += q4[e] * spv[4 * d4 + e]; }
            const float ms = wave_sum(o * o) * (1.f / 64);
            const float gv = (float)Z[(size_t)m * ZP + ZC_LG + 64 * h + lane];
            og[h] = siluf(gv) * (o * rsqrtf(ms + EPS)); ss += og[h] * og[h];
        }
        const float r = rsqrtf(wave_sum(ss) * (1.f / 256) + EPS);
#pragma unroll
        for (int h = 0; h < 4; ++h) MIX[(size_t)m * D + 512 + 64 * h + lane] = (f16)(og[h] * r * gain[64 * h + lane]);
    }
}
__device__ __forceinline__ void ph_gmlp(const Ctx& C, int l, int TID, int bid, int nblk, LAS unsigned char* lds) {
    const f16* Z = (const f16*)(C.ws + WS_Z); f16* MIX = (f16*)(C.ws + WS_MIX);
    const f16* W16 = (const f16*)(C.ws + WS_WS16) + (size_t)l * 4 * 128 * 128;
    const float* bs = C.in[11] + (size_t)l * 4 * 128; const float* gain = C.in[12] + (size_t)l * D + 768;
    const int tid = TID, lane = tid & 63, wid = tid >> 6, r32 = lane & 31, hi = lane >> 5;
    LAS unsigned char* OS = lds + 65536;
    for (int item = bid; item < M / 128; item += nblk) {
        const size_t m0 = (size_t)item * 128;
        __syncthreads();
#pragma unroll
        for (int it = 0; it < 8; ++it) {
            const int q = tid + NT * it, s = q >> 5, g = (q >> 3) & 3, ch = q & 7;
            const f16x8 v8 = *(const f16x8*)(Z + (m0 + s) * ZP + ZC_MV + 64 * g + 8 * ch);
            float v[8]; float sum = 0.f;
#pragma unroll
            for (int e = 0; e < 8; ++e) { v[e] = (float)v8[e]; sum += v[e]; }
            sum += __shfl_xor(sum, 1); sum += __shfl_xor(sum, 2); sum += __shfl_xor(sum, 4);
            const float mu = sum * (1.f / 64); float var = 0.f;
#pragma unroll
            for (int e = 0; e < 8; ++e) { v[e] -= mu; var += v[e] * v[e]; }
            var += __shfl_xor(var, 1); var += __shfl_xor(var, 2); var += __shfl_xor(var, 4);
            const float rs = rsqrtf(var * (1.f / 64) + EPS);
            f16x8 o8;
#pragma unroll
            for (int e = 0; e < 8; ++e) o8[e] = (f16)(v[e] * rs);
            *(LAS f16x8*)(lds + g * 16384 + (ch >> 2) * 8192 + s * 64 + (ch & 3) * 16) = o8;
        }
        __syncthreads();
        {
            const int g = wid >> 1, wh = wid & 1;
            const LAS unsigned char* vb = lds + g * 16384 + wh * 8192 + ((lane >> 4) & 1) * 32 + (lane & 3) * 8 + (4 * hi + ((lane & 15) >> 2)) * 64;
            for (int rt = 0; rt < 4; ++rt) {
                f32x16 acc;
#pragma unroll
                for (int r = 0; r < 16; ++r) acc[r] = 0.f;
                const f16* wrow = W16 + ((size_t)g * 128 + 32 * rt + r32) * 128 + 4 * hi;
                for (int ks = 0; ks < 2 * rt + 2; ++ks) {
                    const f16x4 a0 = *(const f16x4*)(wrow + 16 * ks), a1 = *(const f16x4*)(wrow + 16 * ks + 8);
                    const f16x8 af = {a0[0], a0[1], a0[2], a0[3], a1[0], a1[1], a1[2], a1[3]};
                    const s16x4 lo = vtr(vb + ks * 1024), hh = vtr(vb + ks * 1024 + 512);
                    typedef short s16x8 __attribute__((ext_vector_type(8)));
                    const s16x8 bv = {lo[0], lo[1], lo[2], lo[3], hh[0], hh[1], hh[2], hh[3]};
                    acc = __builtin_amdgcn_mfma_f32_32x32x16_f16(af, __builtin_bit_cast(f16x8, bv), acc, 0, 0, 0);
                }
#pragma unroll
                for (int r = 0; r < 16; ++r) {
                    const int t = 32 * rt + crow(r, hi), ch = 64 * g + 32 * wh + r32;
                    const float val = (float)Z[(m0 + t) * ZP + ZC_MU + ch] * (acc[r] + bs[g * 128 + t]);
                    *(LAS f16*)(OS + (t * 256 + ch) * 2) = (f16)val;
                }
            }
        }
        __syncthreads();
        for (int tt = 0; tt < 16; ++tt) {
            const int t = 16 * wid + tt;
            const f16x4 v4 = *(const LAS f16x4*)(OS + (t * 256 + 4 * lane) * 2);
            float v[4]; float ss = 0.f;
#pragma unroll
            for (int e = 0; e < 4; ++e) { v[e] = (float)v4[e]; ss += v[e] * v[e]; }
            const float r = rsqrtf(wave_sum(ss) * (1.f / 256) + EPS);
            const f32x4 gv = *(const f32x4*)(gain + 4 * lane);
            f16x4 o4;
#pragma unroll
            for (int e = 0; e < 4; ++e) o4[e] = (f16)(v[e] * r * gv[e]);
            *(f16x4*)(MIX + (m0 + t) * D + 768 + 4 * lane) = o4;
        }
    }
}

__device__ __forceinline__ void cvt_item(const float* W, int K, int N, f16* WT, bool remap, LAS float* scr, int item, int lane) {
    const int nb_ = (N + 31) / 32, kb = item / nb_, nb = item % nb_, k0 = 64 * kb, n0 = 32 * nb;
#pragma unroll 8
    for (int i = 0; i < 32; ++i) { const int kk = 2 * i + (lane >> 5), n = n0 + (lane & 31); scr[kk * 33 + (lane & 31)] = n < N ? W[(size_t)(k0 + kk) * N + n] : 0.f; }
    WAVE_LDS_SYNC();
    const int c = lane & 7;
#pragma unroll
    for (int j = 0; j < 4; ++j) {
        const int nn = (lane >> 3) + 8 * j, n = n0 + nn;
        if (n < N) {
            const int row = remap ? n + (n >= 1420 ? 4 : 0) : n; const LAS float* s = scr + (8 * c) * 33 + nn;
            f16x8 o;
#pragma unroll
            for (int e = 0; e < 8; ++e) o[e] = (f16)s[e * 33];
            *(f16x8*)(WT + (size_t)row * K + k0 + 8 * c) = o;
        }
    }
    WAVE_LDS_SYNC();
}
__device__ __forceinline__ void ph_wcvt(const Ctx& C, int TID, int bid, int nblk, LAS float* lds) {
    const int lane = TID & 63, wave = TID >> 6, gw = bid * NWAVE + wave, ngw = nblk * NWAVE;
    LAS float* scr = lds + wave * 4096;
    for (int it = gw; it < DEPTH * 2 * 2 * 64; it += ngw) {
        const int r = it & 63, half = (it >> 6) & 1, j = (it >> 7) & 1, l = it >> 8;
        cvt_item(C.in[6] + ((size_t)(l * 2 + j) * 2048 + half * 1024) * 128, 1024, 128, (f16*)(C.ws + WS_W1T) + ((size_t)(l * 2 + j) * 256 + half * 128) * 1024, false, scr, r, lane);
    }
    for (int it = gw; it < DEPTH * 4 * 128; it += ngw) {
        const float* w = C.in[10] + (size_t)it * 128; const int t = it & 127;
        f16* o = (f16*)(C.ws + WS_WS16) + (size_t)it * 128;
        o[lane] = (f16)(lane <= t ? w[lane] : 0.f); o[lane + 64] = (f16)(lane + 64 <= t ? w[lane + 64] : 0.f);
    }
    for (int it = gw; it < DEPTH * 2 * 32; it += ngw) {
        const int q = it & 31, lj = it >> 5;
        const float* pp = C.in[5] + (size_t)lj * 2048 + q * 64; const float* w = C.in[6] + ((size_t)lj * 2048 + q * 64) * 128;
        float a0 = 0.f, a1 = 0.f;
        for (int k = 0; k < 64; ++k) { const float pv = pp[k]; a0 += pv * w[k * 128 + lane]; a1 += pv * w[k * 128 + 64 + lane]; }
        float* o = (float*)(C.ws + WS_PCB) + (size_t)it * 128; o[lane] = a0; o[lane + 64] = a1;
    }
    constexpr int I_IN = (D / 64) * ((NIN + 31) / 32), I_O = (D / 64) * (D / 32), I_UP = (D / 64) * (DFF / 32), I_DN = (DFF / 64) * (D / 32), I_PAD = 100, I_L = I_IN + I_O + I_UP + I_DN + I_PAD;
    for (int it = gw; it < DEPTH * I_L; it += ngw) {
        const int l = it / I_L; int r = it % I_L;
        unsigned char* wl = C.ws + WS_W16 + (size_t)l * W16_LAYER;
        if (r < I_IN) { cvt_item(C.in[3] + (size_t)l * D * NIN, D, NIN, (f16*)(wl + W16_WIN), true, scr, r, lane); continue; } r -= I_IN;
        if (r < I_O) { cvt_item(C.in[13] + (size_t)l * D * D, D, D, (f16*)(wl + W16_WO), false, scr, r, lane); continue; } r -= I_O;
        if (r < I_UP) { cvt_item(C.in[17] + (size_t)l * D * DFF, D, DFF, (f16*)(wl + W16_WUP), false, scr, r, lane); continue; } r -= I_UP;
        if (r < I_DN) { cvt_item(C.in[18] + (size_t)l * DFF * D, DFF, D, (f16*)(wl + W16_WDN), false, scr, r, lane); continue; } r -= I_DN;
        const int row = r < 4 ? 1420 + r : 2720 + (r - 4);
        f16x8 z; for (int e = 0; e < 8; ++e) z[e] = (f16)0.f;
        f16* p = (f16*)(wl + W16_WIN) + (size_t)row * D;
        *(f16x8*)(p + 8 * lane) = z; *(f16x8*)(p + 512 + 8 * lane) = z;
    }
}

namespace pg8 {
#define PG8_LAS __attribute__((address_space(3)))
typedef _Float16 bf16_t;
typedef _Float16 bf16x8 __attribute__((ext_vector_type(8)));
typedef float f32x4 __attribute__((ext_vector_type(4)));
typedef unsigned u32x4 __attribute__((ext_vector_type(4)));
constexpr int BM = 256, BK = 64, HALF = 128, HTB = HALF * BK * 2  , STAGE_BYTES = 8 * HTB, NXCD = 8, WGM = 8;

__host__ __device__ __forceinline__ int lds_byte(int r, int c) { const int st = (r >> 4) * 2 + (c >> 5), rr = r & 15, cc = c & 31, ob = rr * 64 + cc * 2; return st * 1024 + (ob ^ (((ob >> 9) & 1) << 5)); }
__host__ __device__ __forceinline__ void stage_rc(int b, int& R, int& C) { const int st = b / 1024, sb = b % 1024, swz = sb ^ (((sb >> 9) & 1) << 5); R = (st >> 1) * 16 + swz / 64; C = (st & 1) * 32 + (swz % 64) / 2; }
__host__ __device__ __forceinline__ int perm32(int rho) { const int n = rho >> 4, i = rho & 15; return 8 * (i >> 2) + 4 * n + (i & 3); }

struct Unit { int pm, pn; };
struct Gemm { const bf16_t* A; const bf16_t* Bt; int M, N, K; };

struct StaticOrder {
    int nM, nN, nwg, G, c;
    __host__ __device__ void init(int M, int N, int G_, int c_) { nM = M / BM; nN = N / BM; nwg = nM * nN; G = G_; c = c_; }
    __host__ __device__ bool next(int i, Unit& u) const {
        const long L = (long)i * G + c; if (L >= nwg) return false;
        int wgid = (int)L; { const int q = nwg / NXCD, r = nwg % NXCD, xcd = wgid % NXCD, off = wgid / NXCD; wgid = (xcd < r ? xcd * (q + 1) : r * (q + 1) + (xcd - r) * q) + off; }
        const int nig = WGM * nN, gid = wgid / nig, fm = gid * WGM, gsz = (nM - fm) < WGM ? (nM - fm) : WGM;
        u.pm = fm + ((wgid % nig) % gsz); u.pn = (wgid % nig) / gsz; return true;
    }
    __device__ __forceinline__ void a_ready(const Unit&) const {}
    __device__ __forceinline__ void done(const Unit&) const {}
};


template <int ACT> struct EpiF16 {
    static constexpr bool PERM = true, AFTER_DRAIN = false;
    bf16_t* O; int ldc;
    __device__ __forceinline__ void operator()(const f32x4 (&acc)[2][2][4][2], const Unit& u, int wr, int wc, int fr, int fq) const {
        const int row0 = u.pm * BM + wr * 64 + fr, col0 = u.pn * BM + wc * 32 + 8 * fq;
#pragma unroll
        for (int ai = 0; ai < 2; ++ai)
#pragma unroll
            for (int m = 0; m < 4; ++m) { bf16_t* rowp = O + (size_t)(row0 + ai * HALF + m * 16) * ldc + col0;
#pragma unroll
                for (int bj = 0; bj < 2; ++bj) { f32x4 v0 = acc[ai][bj][m][0], v1 = acc[ai][bj][m][1];
                    if (ACT == 1) {
#pragma unroll
                        for (int e = 0; e < 4; ++e) { const float a = fmaxf(v0[e], 0.f), b = fmaxf(v1[e], 0.f); v0[e] = a * a; v1[e] = b * b; } }
                    bf16x8 w; w[0] = (bf16_t)v0[0]; w[1] = (bf16_t)v0[1]; w[2] = (bf16_t)v0[2]; w[3] = (bf16_t)v0[3]; w[4] = (bf16_t)v1[0]; w[5] = (bf16_t)v1[1]; w[6] = (bf16_t)v1[2]; w[7] = (bf16_t)v1[3];
                    *(bf16x8*)(rowp + bj * HALF) = w; } }
    }
};
template <class Epi, class Sched, bool ALIGN_EPI = false, bool SP2 = false>
__device__ __forceinline__ void gemm_phase(PG8_LAS unsigned char* lds, const Gemm g, const Sched& S, const Epi& E, const int tid) {
    const int  wid = __builtin_amdgcn_readfirstlane(tid >> 6), lane = tid & 63, wr = wid >> 2, wc = wid & 3, fr = lane & 15, fq = lane >> 4;
    const int K = g.K, nt = K / BK;
    unsigned voffA[2], voffB[2];
#pragma unroll
    for (int i = 0; i < 2; ++i) { int R, C; stage_rc(tid * 16 + i * 8192, R, C); const int Rb = Epi::PERM ? ((R & ~31) + perm32(R & 31)) : R;
        voffA[i] = (unsigned)(R * K + C) * 2u; voffB[i] = (unsigned)(Rb * K + C) * 2u; }
    const size_t kstep = (size_t)(BK * 2);
    const size_t hstep = (size_t)HALF * K * 2;
    const size_t tstep = 2 * hstep;
    const unsigned ldsw = (unsigned)wid * 1024u;
    const int aoff = lds_byte(wr * 64 + fr, fq * 8), boff = lds_byte(wc * 32 + fr, fq * 8);
#define PG8_SA(b, h) (((b) * 2 + (h)) * HTB)
#define PG8_SB(b, h) ((4 + (b) * 2 + (h)) * HTB)
#define PG8_STAGE(bufoff, gbase, voff) do { _Pragma("unroll") for (int _i = 0; _i < 2; ++_i) \
        __builtin_amdgcn_global_load_lds((const unsigned*)((const char*)(gbase) + (voff)[_i]), (PG8_LAS unsigned*)(lds + (bufoff) + ldsw + _i * 8192), 16, 0, 0); } while (0)
#define PG8_LDA(dst, b, h) do { _Pragma("unroll") for (int m = 0; m < 4; ++m) _Pragma("unroll") for (int k = 0; k < 2; ++k) dst[m][k] = *(const PG8_LAS bf16x8*)(lds + PG8_SA(b, h) + aoff + m * 2048 + k * 1024); } while (0)
#define PG8_LDB(dst, b, h) do { _Pragma("unroll") for (int n = 0; n < 2; ++n) _Pragma("unroll") for (int k = 0; k < 2; ++k) dst[n][k] = *(const PG8_LAS bf16x8*)(lds + PG8_SB(b, h) + boff + n * 2048 + k * 1024); } while (0)
#define PG8_MMA(ai, bj, At, Bt) do { __builtin_amdgcn_s_setprio(1); _Pragma("unroll") for (int m = 0; m < 4; ++m) _Pragma("unroll") for (int n = 0; n < 2; ++n) _Pragma("unroll") for (int k = 0; k < 2; ++k) \
        acc[ai][bj][m][n] = __builtin_amdgcn_mfma_f32_16x16x32_f16(Bt[n][k], At[m][k], acc[ai][bj][m][n], 0, 0, 0); __builtin_amdgcn_s_setprio(0); } while (0)
#define PG8_WAIT_V(n) asm volatile("s_waitcnt vmcnt(" #n ")" ::: "memory")
#define PG8_WAIT_L(n) asm volatile("s_waitcnt lgkmcnt(" #n ")" ::: "memory")
#define PG8_BAR __builtin_amdgcn_s_barrier()
#define PG8_SCHED __builtin_amdgcn_sched_barrier(0)
    Unit cur, nxt; int ui = 0;
    if (!S.next(0, cur)) return;
    f32x4 acc[2][2][4][2];
#pragma unroll
    for (int a = 0; a < 2; ++a)
#pragma unroll
        for (int b = 0; b < 2; ++b)
#pragma unroll
            for (int m = 0; m < 4; ++m)
#pragma unroll
                for (int n = 0; n < 2; ++n) acc[a][b][m][n] = (f32x4){0.f, 0.f, 0.f, 0.f};
    bf16x8 At[4][2], B0[2][2], B1[2][2];
    const char* cA = (const char*)g.A + (size_t)cur.pm * tstep; const char* cB = (const char*)g.Bt + (size_t)cur.pn * tstep;
    S.a_ready(cur);
    if constexpr (SP2) {
        PG8_STAGE(PG8_SB(0, 0), cB, voffB); PG8_STAGE(PG8_SB(0, 1), cB + hstep, voffB); PG8_STAGE(PG8_SA(0, 0), cA, voffA); PG8_STAGE(PG8_SA(0, 1), cA + hstep, voffA);
        if (wr == 1) PG8_BAR;
        PG8_WAIT_V(2); PG8_BAR;
        PG8_STAGE(PG8_SB(1, 0), cB + kstep, voffB); PG8_STAGE(PG8_SA(1, 0), cA + kstep, voffA); PG8_STAGE(PG8_SB(1, 1), cB + hstep + kstep, voffB);
        PG8_WAIT_V(6); PG8_BAR;
    } else {
        PG8_STAGE(PG8_SB(0, 0), cB, voffB); PG8_STAGE(PG8_SA(0, 0), cA, voffA); PG8_STAGE(PG8_SB(0, 1), cB + hstep, voffB); PG8_STAGE(PG8_SA(0, 1), cA + hstep, voffA);
        if (wr == 1) PG8_BAR;
        PG8_WAIT_V(4); PG8_BAR;
        PG8_STAGE(PG8_SB(1, 0), cB + kstep, voffB); PG8_STAGE(PG8_SA(1, 0), cA + kstep, voffA); PG8_STAGE(PG8_SB(1, 1), cB + hstep + kstep, voffB);
        PG8_WAIT_V(6); PG8_BAR;
    }
    for (;;) {
        const bool has_next = S.next(ui + 1, nxt);
        const char* nA = has_next ? (const char*)g.A + (size_t)nxt.pm * tstep : cA; const char* nB = has_next ? (const char*)g.Bt + (size_t)nxt.pn * tstep : cB;
        for (int t = 0; t < nt; t += 2) {
            const bool last = (t == nt - 2);
            const char* a1 = cA + (size_t)(t + 1) * kstep;
            const char* a2 = last ? nA : cA + (size_t)(t + 2) * kstep; const char* b2 = last ? nB : cB + (size_t)(t + 2) * kstep;
            const char* a3 = a2 + kstep; const char* b3 = b2 + kstep;
            if (last && has_next) S.a_ready(nxt);
            if constexpr (SP2) {
            PG8_LDB(B0, 0, 0); PG8_LDB(B1, 0, 1); PG8_SCHED; PG8_LDA(At, 0, 0); PG8_STAGE(PG8_SA(1, 1), a1 + hstep, voffA);
            PG8_WAIT_V(8); PG8_WAIT_L(0); PG8_BAR; PG8_MMA(0, 0, At, B0); PG8_MMA(0, 1, At, B1); PG8_BAR; PG8_SCHED;
            PG8_LDA(At, 0, 1); PG8_STAGE(PG8_SB(0, 0), b2, voffB); PG8_STAGE(PG8_SB(0, 1), b2 + hstep, voffB); PG8_STAGE(PG8_SA(0, 0), a2, voffA);
            PG8_WAIT_V(8); PG8_WAIT_L(0); PG8_BAR; PG8_MMA(1, 0, At, B0); PG8_MMA(1, 1, At, B1); PG8_BAR; PG8_SCHED;
            PG8_LDB(B0, 1, 0); PG8_LDB(B1, 1, 1); PG8_SCHED; PG8_LDA(At, 1, 0); PG8_STAGE(PG8_SA(0, 1), a2 + hstep, voffA);
            PG8_WAIT_V(8); PG8_WAIT_L(0); PG8_BAR; PG8_MMA(0, 0, At, B0); PG8_MMA(0, 1, At, B1); PG8_BAR; PG8_SCHED;
            PG8_LDA(At, 1, 1); PG8_STAGE(PG8_SB(1, 0), b3, voffB); PG8_STAGE(PG8_SB(1, 1), b3 + hstep, voffB); PG8_STAGE(PG8_SA(1, 0), a3, voffA);
            PG8_WAIT_V(8); PG8_WAIT_L(0); PG8_BAR; PG8_MMA(1, 0, At, B0); PG8_MMA(1, 1, At, B1); PG8_BAR; PG8_SCHED;
            } else {
            PG8_LDB(B0, 0, 0); PG8_SCHED; PG8_LDA(At, 0, 0); PG8_STAGE(PG8_SA(1, 1), a1 + hstep, voffA);
            PG8_WAIT_L(8); PG8_BAR; PG8_WAIT_L(0); PG8_MMA(0, 0, At, B0); PG8_BAR; PG8_SCHED;
            PG8_LDB(B1, 0, 1); PG8_STAGE(PG8_SB(0, 0), b2, voffB);
            PG8_BAR; PG8_WAIT_L(0); PG8_MMA(0, 1, At, B1); PG8_BAR;
            PG8_LDA(At, 0, 1); PG8_STAGE(PG8_SA(0, 0), a2, voffA);
            PG8_BAR; PG8_WAIT_L(0); PG8_MMA(1, 0, At, B0); PG8_BAR; PG8_SCHED;
            PG8_STAGE(PG8_SB(0, 1), b2 + hstep, voffB);
            PG8_WAIT_V(6); PG8_BAR; PG8_MMA(1, 1, At, B1); PG8_BAR;
            PG8_LDB(B0, 1, 0); PG8_SCHED; PG8_LDA(At, 1, 0); PG8_STAGE(PG8_SA(0, 1), a2 + hstep, voffA);
            PG8_WAIT_L(8); PG8_BAR; PG8_WAIT_L(0); PG8_MMA(0, 0, At, B0); PG8_BAR; PG8_SCHED;
            PG8_LDB(B1, 1, 1); PG8_STAGE(PG8_SB(1, 0), b3, voffB);
            PG8_BAR; PG8_WAIT_L(0); PG8_MMA(0, 1, At, B1); PG8_BAR;
            PG8_LDA(At, 1, 1); PG8_STAGE(PG8_SA(1, 0), a3, voffA);
            PG8_BAR; PG8_WAIT_L(0); PG8_MMA(1, 0, At, B0); PG8_BAR; PG8_SCHED;
            PG8_STAGE(PG8_SB(1, 1), b3 + hstep, voffB);
            PG8_WAIT_V(6); PG8_BAR; PG8_MMA(1, 1, At, B1); PG8_BAR;
            }
        }
        if constexpr (ALIGN_EPI) { if (wr == 0) PG8_BAR; }
        if constexpr (!Epi::AFTER_DRAIN) { E(acc, cur, wr, wc, fr, fq); S.done(cur); }
        if (!has_next) break;
#pragma unroll
        for (int a = 0; a < 2; ++a)
#pragma unroll
            for (int b = 0; b < 2; ++b)
#pragma unroll
                for (int m = 0; m < 4; ++m)
#pragma unroll
                    for (int n = 0; n < 2; ++n) acc[a][b][m][n] = (f32x4){0.f, 0.f, 0.f, 0.f};
        cur = nxt; cA = nA; cB = nB; ++ui;
        if constexpr (ALIGN_EPI) { if (wr == 1) PG8_BAR; }
    }
    PG8_WAIT_V(0);
    if constexpr (!ALIGN_EPI) { if (wr == 0) PG8_BAR; }
    PG8_BAR;
    if constexpr (Epi::AFTER_DRAIN) { E.fused(acc, cur, wr, wc, fr, fq, lds, wid, lane); S.done(cur); }
#undef PG8_SA
#undef PG8_SB
#undef PG8_STAGE
#undef PG8_LDA
#undef PG8_LDB
#undef PG8_MMA
#undef PG8_WAIT_V
#undef PG8_WAIT_L
#undef PG8_BAR
#undef PG8_SCHED
}
}

#define XB_TMO      128
#define XB_XCNT(j)  (256  + 64 * (j))
#define XB_XSUB(j)  (1280 + 64 * (j))
#define XB_XGEN(j)  (2304 + 64 * (j))
#define XB_TOP      3328
#define XB_TOPGEN   3392
#define XCD_BAR_WORDS 3456
#define XB_SPIN_CAP (1u << 18)

__device__ __forceinline__ unsigned xb_ld(unsigned* p)              { return __hip_atomic_load(p, __ATOMIC_RELAXED, __HIP_MEMORY_SCOPE_AGENT); }
__device__ __forceinline__ unsigned xb_add(unsigned* p, unsigned v) { return __hip_atomic_fetch_add(p, v, __ATOMIC_RELAXED, __HIP_MEMORY_SCOPE_AGENT); }
__device__ __forceinline__ unsigned xb_xcc_id() { return (unsigned)__builtin_amdgcn_s_getreg((3 << 11) | 20) & 0xFu; }
#define XB_SPIN(cond, bar) do { unsigned _sp = 0; while (cond) { __builtin_amdgcn_s_sleep(1); \
    if ((++_sp & 255u) == 0u) { if (xb_ld(&(bar)[XB_TMO])) break; if (_sp > XB_SPIN_CAP) { atomicAdd(&(bar)[XB_TMO], 1u); break; } } } } while (0)

struct XcdBarrier {
    unsigned* bar; unsigned x;
    volatile LAS unsigned* st;
};

__device__ __forceinline__ XcdBarrier xcd_barrier_post(unsigned* bar, volatile LAS unsigned* st) {
    XcdBarrier b; b.bar = bar; b.x = xb_xcc_id(); b.st = st;
    if (threadIdx.x == 0) (void)xb_add(&bar[XB_XCNT(b.x)], 1u);
    return b;
}
__device__ __forceinline__ void xcd_barrier_complete(unsigned* bar, unsigned x, unsigned& nloc, unsigned& nx) {
    const unsigned G = gridDim.x * gridDim.y * gridDim.z;
    unsigned sum, cnt, mine, sp = 0u;
    for (;;) {
        sum = 0u; cnt = 0u; mine = 0u;
#pragma unroll
        for (unsigned j = 0; j < 16; ++j) { const unsigned c = xb_ld(&bar[XB_XCNT(j)]); sum += c; cnt += (c > 0u) ? 1u : 0u; mine = (j == x) ? c : mine; }
        if (sum == G) break;
        __builtin_amdgcn_s_sleep(1);
        if ((++sp & 255u) == 0u) { if (xb_ld(&bar[XB_TMO])) break; if (sp > XB_SPIN_CAP) { atomicAdd(&bar[XB_TMO], 1u); break; } }
    }
    nloc = mine > 0u ? mine : 1u; nx = cnt > 0u ? cnt : 1u;
}

__device__ __forceinline__ void xcd_barrier(const XcdBarrier& b) {
    asm volatile("s_waitcnt vmcnt(0)" ::: "memory");
    __syncthreads();
    if (threadIdx.x == 0) {
        unsigned* bar = b.bar;
        __builtin_amdgcn_s_waitcnt(0);
        unsigned nloc = b.st[0], nx = b.st[1];
        if (nloc == 0u) { xcd_barrier_complete(bar, b.x, nloc, nx); b.st[0] = nloc; b.st[1] = nx; }
        const unsigned old = xb_add(&bar[XB_XSUB(b.x)], 1u);
        const unsigned gen = old / nloc;
        if (old + 1u == (gen + 1u) * nloc) {
            __builtin_amdgcn_fence(__ATOMIC_RELEASE, "agent");
            asm volatile("s_waitcnt vmcnt(0)" ::: "memory");
            const unsigned og = xb_add(&bar[XB_TOP], 1u);
            const unsigned tg = og / nx;
            if (og + 1u == (tg + 1u) * nx) xb_add(&bar[XB_TOPGEN], 1u);
            else XB_SPIN(xb_ld(&bar[XB_TOPGEN]) == tg, bar);
            __builtin_amdgcn_fence(__ATOMIC_ACQUIRE, "agent");
            xb_add(&bar[XB_XGEN(b.x)], 1u);
            asm volatile("s_waitcnt vmcnt(0)" ::: "memory");
        } else {
            XB_SPIN(xb_ld(&bar[XB_XGEN(b.x)]) == gen, bar);
            __builtin_amdgcn_fence(__ATOMIC_ACQUIRE, "agent");
            asm volatile("s_waitcnt vmcnt(0)" ::: "memory");
        }
    }
    __syncthreads();
}

constexpr int CW_BAR = 4096;
constexpr int LDS_MISC = LDS_BYTES - 256;
#define LAUNDER(v) asm volatile("" : "+s"(v))
__global__ void __launch_bounds__(NT, 2) k_mega(Ctx Carg) {
    extern __shared__ __attribute__((aligned(16))) unsigned char lds_raw[];
    LAS float* lds = (LAS float*)lds_raw;
    const int bid = blockIdx.x, nblk = gridDim.x;
    for (int u = threadIdx.x; u < 64; u += NT) ((LAS unsigned*)((LAS unsigned char*)lds_raw + LDS_MISC))[u] = 0u;
    __syncthreads();
    const Ctx* Cp = (const Ctx*)__builtin_amdgcn_kernarg_segment_ptr();
    XcdBarrier bar = xcd_barrier_post((unsigned*)(Cp->ws + WS_CTL) + CW_BAR, (volatile LAS unsigned*)((LAS unsigned char*)lds_raw + LDS_MISC + 32));
#ifndef PMASK
#define PMASK 0xFFFFF
#endif
#define SITE(k, ...) do { if (!((PMASK >> (k)) & 1)) break; const Ctx* cp_ = Cp; LAUNDER(cp_); const Ctx C = *cp_; int ll = l; LAUNDER(ll); int tid_ = threadIdx.x; asm volatile("" : "+v"(tid_)); int bid_ = bid; LAUNDER(bid_); int nblk_ = nblk; LAUNDER(nblk_); \
        f16* H = (f16*)(C.ws + WS_H); f16* Zb = (f16*)(C.ws + WS_Z); f16* MIX = (f16*)(C.ws + WS_MIX); f16* Y = (f16*)(C.ws + WS_Y); f16* U = (f16*)(C.ws + WS_BIG); \
        (void)H; (void)Zb; (void)MIX; (void)Y; (void)U; __VA_ARGS__; } while (0); { XcdBarrier b_ = bar; LAUNDER(b_.x); LAUNDER(b_.bar); xcd_barrier(b_); }
    int l = 0;
    SITE(0, ph_mod(C, tid_, bid_, nblk_, lds); __syncthreads(); ph_rope(C, tid_, bid_, nblk_); ph_wcvt(C, tid_, bid_, nblk_, lds));
    SITE(1, ph_norm0(C, tid_, bid_, nblk_));
    for (l = 0; l < DEPTH; ++l) {
        SITE(2, { pg8::Gemm g{H, (const f16*)(C.ws + WS_W16 + (size_t)ll * W16_LAYER + W16_WIN), M, ZP, D}; pg8::StaticOrder S; S.init(M, ZP, nblk_, bid_); pg8::EpiF16<0> E{Zb, ZP}; pg8::gemm_phase<pg8::EpiF16<0>, pg8::StaticOrder, true, true>((LAS unsigned char*)lds, g, S, E, tid_); });
        SITE(3, ph_conv(C, ll, tid_, bid_, nblk_); ph_rotk(C, tid_, bid_, nblk_); ph_cmp1(C, ll, tid_, bid_, nblk_); ph_gla1(C, ll, tid_, bid_, nblk_); ph_gmlp(C, ll, tid_, bid_, nblk_, (LAS unsigned char*)lds));
        SITE(4, ph_cmp2(C, ll, tid_, bid_, nblk_, lds); ph_gla2(C, tid_, bid_, nblk_));
        SITE(5, ph_nsa(C, ll, tid_, bid_, nblk_, lds); __syncthreads(); ph_gla3(C, tid_, bid_, nblk_, lds));
        SITE(6, ph_gla4(C, tid_, bid_, nblk_));
        SITE(7, ph_gla5(C, ll, tid_, bid_, nblk_));
        SITE(8, { pg8::Gemm g{MIX, (const f16*)(C.ws + WS_W16 + (size_t)ll * W16_LAYER + W16_WO), M, D, D}; pg8::StaticOrder S; S.init(M, D, nblk_, bid_); pg8::EpiF16<0> E{Y, D}; pg8::gemm_phase<pg8::EpiF16<0>, pg8::StaticOrder, true, true>((LAS unsigned char*)lds, g, S, E, tid_); });
        SITE(9, ph_resnorm(C, ll, 0, tid_, bid_, nblk_));
        SITE(10, { pg8::Gemm g{H, (const f16*)(C.ws + WS_W16 + (size_t)ll * W16_LAYER + W16_WUP), M, DFF, D}; pg8::StaticOrder S; S.init(M, DFF, nblk_, bid_); pg8::EpiF16<1> E{U, DFF}; pg8::gemm_phase<pg8::EpiF16<1>, pg8::StaticOrder, true, true>((LAS unsigned char*)lds, g, S, E, tid_); });
        SITE(11, { pg8::Gemm g{U, (const f16*)(C.ws + WS_W16 + (size_t)ll * W16_LAYER + W16_WDN), M, D, DFF}; pg8::StaticOrder S; S.init(M, D, nblk_, bid_); pg8::EpiF16<0> E{Y, D}; pg8::gemm_phase<pg8::EpiF16<0>, pg8::StaticOrder, true, true>((LAS unsigned char*)lds, g, S, E, tid_); });
        SITE(12, ph_resnorm(C, ll, 1, tid_, bid_, nblk_));
    }
#undef SITE
}

extern "C" void kernel_launch(void* const* d_in, const int* in_sizes, int n_in, void* d_out, int out_size, void* d_ws, size_t ws_size, hipStream_t stream) {
    static int grid = 0;
    if (grid == 0) {
        if (n_in != 19 || ws_size < WS_END) { fprintf(stderr, "kernel_launch: unexpected n_in %d / ws_size %zu\n", n_in, ws_size); grid = -1; return; }
        int dev = 0, cus = 0, per_cu = 0;
        if (hipGetDevice(&dev) != hipSuccess || hipDeviceGetAttribute(&cus, hipDeviceAttributeMultiprocessorCount, dev) != hipSuccess) { grid = -1; return; }
        if (hipFuncSetAttribute((const void*)k_mega, hipFuncAttributeMaxDynamicSharedMemorySize, LDS_BYTES) != hipSuccess) { fprintf(stderr, "hipFuncSetAttribute failed\n"); grid = -1; return; }
        if (hipOccupancyMaxActiveBlocksPerMultiprocessor(&per_cu, (const void*)k_mega, NT, LDS_BYTES) != hipSuccess || per_cu < 1) { fprintf(stderr, "occupancy query: %d\n", per_cu); }
        (void)hipGetLastError();
        grid = cus;
    }
    if (grid < 0) return;
    if (hipMemsetAsync((char*)d_ws + WS_CTL, 0, 1 * MiB, stream) != hipSuccess) return;
    Ctx c{};
    for (int i = 0; i < 19; ++i) c.in[i] = (const float*)d_in[i];
    c.out = (float*)d_out; c.ws = (unsigned char*)d_ws;
    hipLaunchKernelGGL(k_mega, dim3(grid), dim3(NT), LDS_BYTES, stream, c);
}
```

```cpp
#include <hip/hip_runtime.h>
#include <cstdint>
#include <cstdio>

#define LAS __attribute__((address_space(3)))
typedef _Float16 f16;
typedef f16 f16x4 __attribute__((ext_vector_type(4)));
typedef f16 f16x8 __attribute__((ext_vector_type(8)));
typedef float f32x4 __attribute__((ext_vector_type(4)));

constexpr int D = 1024, NB = 8, S = 4096, DEPTH = 4, M = NB * S, DFF = 4096;
constexpr int NIN = 2716, ZP = 2816;
constexpr int ZC_AH = 0, ZC_AB = 256, ZC_AC = 512, ZC_NQ = 768, ZC_KCMP = 1024, ZC_VCMP = 1088, ZC_KSLC = 1152, ZC_VSLC = 1216,
              ZC_KWIN = 1280, ZC_VWIN = 1344, ZC_NG = 1408, ZC_LQ = 1424, ZC_LK = 1552, ZC_LV = 1680, ZC_LG = 1936, ZC_LR = 2192,
              ZC_MU = 2208, ZC_MV = 2464;
constexpr int NCMP = 255;
constexpr float EPS = 1e-6f;
constexpr int NT = 512, NWAVE = 8;

constexpr size_t MiB = 1u << 20;
constexpr size_t WS_CTL = 0;
constexpr size_t WS_MOD = 1 * MiB;
constexpr size_t WS_ROPE = 2 * MiB;
constexpr size_t WS_W16 = 4 * MiB;
constexpr size_t WS_H = 98 * MiB;
constexpr size_t WS_Y = 162 * MiB;
constexpr size_t WS_BIG = 226 * MiB;
constexpr size_t WS_Z = WS_BIG;
constexpr size_t WS_MIX = WS_BIG + 176 * MiB;
constexpr size_t WS_KSR = WS_BIG + 240 * MiB;
constexpr size_t WS_KWR = WS_BIG + 244 * MiB;
constexpr size_t WS_HID = WS_BIG + 248 * MiB;
constexpr size_t WS_KC = WS_BIG + 251 * MiB;
constexpr size_t WS_VC = WS_BIG + 252 * MiB;
constexpr size_t WS_KC16 = WS_KC + 768 * 1024, WS_VC16 = WS_VC + 768 * 1024;
constexpr size_t WS_W1T = 498 * MiB;
constexpr size_t WS_WS16 = 502 * MiB;
constexpr size_t WS_PCB = 502 * MiB + 512 * 1024;
constexpr size_t WS_G = 503 * MiB;
constexpr size_t WS_END = 507 * MiB;
constexpr size_t WS_LA = WS_H;
constexpr size_t WS_QE2 = WS_H + 16 * MiB;
constexpr size_t WS_OI = WS_H + 32 * MiB;
constexpr size_t WS_KV = WS_Y;
constexpr size_t WS_SPREV = WS_Y + 16 * MiB;
constexpr size_t WS_VN = WS_Y + 32 * MiB;

constexpr size_t W16_WIN = 0, W16_WO = (size_t)ZP * D * 2, W16_WUP = W16_WO + (size_t)D * D * 2, W16_WDN = W16_WUP + (size_t)DFF * D * 2, W16_LAYER = W16_WDN + (size_t)D * DFF * 2;
static_assert(WS_W16 + DEPTH * W16_LAYER <= WS_H, "weight copies fit below H");

constexpr int LDS_BYTES = 147456;

struct Ctx {
    const float* in[19];
    float* out;
    unsigned char* ws;
    int lo, hi;
};

__device__ __forceinline__ float wave_sum(float v) {
#pragma unroll
    for (int o = 32; o > 0; o >>= 1) v += __shfl_xor(v, o);
    return v;
}
__device__ __forceinline__ float wave_max(float v) {
#pragma unroll
    for (int o = 32; o > 0; o >>= 1) v = fmaxf(v, __shfl_xor(v, o));
    return v;
}
#define WAVE_LDS_SYNC() asm volatile("s_waitcnt lgkmcnt(0)" ::: "memory")
__device__ __forceinline__ float siluf(float v) { return v / (1.f + expf(-v)); }
__device__ __forceinline__ float sigmoidf_(float v) { return 1.f / (1.f + expf(-v)); }

typedef float f32x16 __attribute__((ext_vector_type(16)));
typedef short s16x4 __attribute__((ext_vector_type(4)));
typedef unsigned u32x4 __attribute__((ext_vector_type(4)));
__device__ __forceinline__ int crow(int r, int hi) { return (r & 3) + 8 * (r >> 2) + 4 * hi; }
__device__ __forceinline__ float pl32_max(float v) { auto rr = __builtin_amdgcn_permlane32_swap(__float_as_uint(v), __float_as_uint(v), false, false); return fmaxf(__uint_as_float(rr[0]), __uint_as_float(rr[1])); }
__device__ __forceinline__ float pl32_sum(float v) { auto rr = __builtin_amdgcn_permlane32_swap(__float_as_uint(v), __float_as_uint(v), false, false); return __uint_as_float(rr[0]) + __uint_as_float(rr[1]); }
__device__ __forceinline__ unsigned pl32_other(unsigned v, int hi) { auto rr = __builtin_amdgcn_permlane32_swap(v, v, false, false); return hi ? rr[0] : rr[1]; }
__device__ __forceinline__ s16x4 vtr(const LAS unsigned char* p) { return __builtin_bit_cast(s16x4, __builtin_amdgcn_ds_read_tr16_b64_v4i16((LAS s16x4*)p)); }
__device__ __forceinline__ void sincos_d(double a, double& s, double& c) {
    const double two_over_pi = 0.63661977236758134308, pio2_hi = 1.57079632679489655800e+00, pio2_lo = 6.12323399573676603587e-17;
    const double kq = rint(a * two_over_pi);
    double r = (a - kq * pio2_hi) - kq * pio2_lo;
    const double r2 = r * r;
    double sp = r * (1.0 + r2 * (-1.0 / 6 + r2 * (1.0 / 120 + r2 * (-1.0 / 5040 + r2 * (1.0 / 362880 + r2 * (-1.0 / 39916800 + r2 * (1.0 / 6227020800.0 + r2 * (-1.0 / 1307674368000.0))))))));
    double cp = 1.0 + r2 * (-0.5 + r2 * (1.0 / 24 + r2 * (-1.0 / 720 + r2 * (1.0 / 40320 + r2 * (-1.0 / 3628800 + r2 * (1.0 / 479001600.0 + r2 * (-1.0 / 87178291200.0 + r2 * (1.0 / 20922789888000.0))))))));
    const int q = ((int)kq) & 3;
    if (q == 0) { s = sp; c = cp; } else if (q == 1) { s = cp; c = -sp; } else if (q == 2) { s = -sp; c = -cp; } else { s = -cp; c = sp; }
}

__device__ __forceinline__ void ph_mod(const Ctx& C, int TID, int bid, int nblk, LAS float* lds) {
    const float* c = C.in[1]; const float* w_mod = C.in[15]; const float* b_mod = C.in[16];
    float* MOD = (float*)(C.ws + WS_MOD);
    LAS float* cs = lds;
    LAS float* red = lds + 8192;
    const int tid = TID, nn = tid & 63, kg = tid >> 6;
    __syncthreads();
    for (int idx = tid; idx < NB * D; idx += NT) cs[idx] = siluf(c[idx]);
    __syncthreads();
    for (int item = bid; item < DEPTH * (6 * D / 64); item += nblk) {
        const int l = item / (6 * D / 64), n = (item % (6 * D / 64)) * 64 + nn;
        const float* w = w_mod + (size_t)l * D * 6 * D + n;
        float acc[8];
#pragma unroll
        for (int b = 0; b < 8; ++b) acc[b] = 0.f;
        for (int k0 = kg * 128; k0 < kg * 128 + 128; k0 += 16) {
            float wv[16];
#pragma unroll
            for (int i = 0; i < 16; ++i) wv[i] = w[(size_t)(k0 + i) * 6 * D];
#pragma unroll
            for (int i = 0; i < 16; ++i)
#pragma unroll
                for (int b = 0; b < 8; ++b) acc[b] += cs[b * D + k0 + i] * wv[i];
        }
#pragma unroll
        for (int b = 0; b < 8; ++b) red[(kg * 8 + b) * 64 + nn] = acc[b];
        __syncthreads();
        { const int b = tid >> 6; float s = b_mod[l * 6 * D + n];
#pragma unroll
          for (int g = 0; g < 8; ++g) s += red[(g * 8 + b) * 64 + nn];
          MOD[(size_t)(l * NB + b) * 6 * D + n] = s; }
        __syncthreads();
    }
}
__device__ __forceinline__ void ph_rope(const Ctx& C, int TID, int bid, int nblk) {
    const int* pos = (const int*)C.in[2];
    float* RC = (float*)(C.ws + WS_ROPE); float* RS = RC + (size_t)M * 8;
    const double invf[8] = {1.0, 0.19392274474868576, 0.03760603093086393, 0.007292664737217109, 0.001414213562373095, 0.0002742481756762073, 5.318295896944988e-05, 1.031338537721246e-05};
    for (int idx = bid * NT + TID; idx < M * 8; idx += nblk * NT) {
        const int i = idx & 7, m = idx >> 3;
        double f = invf[0];
#pragma unroll
        for (int j = 1; j < 8; ++j) f = (i == j) ? invf[j] : f;
        double s, c; sincos_d((double)pos[m] * f, s, c);
        RC[idx] = (float)c; RS[idx] = (float)s;
    }
}
__device__ __forceinline__ void adaln_row(const float (&xv)[16], const float* g, const float* sc, const float* sh, f16* hrow, int lane) {
    float ss = 0.f;
#pragma unroll
    for (int j = 0; j < 16; ++j) ss += xv[j] * xv[j];
    const float r = rsqrtf(wave_sum(ss) * (1.f / D) + EPS);
#pragma unroll
    for (int j = 0; j < 4; ++j) {
        const int c0 = 256 * j + 4 * lane;
        const f32x4 gv = *(const f32x4*)(g + c0), scv = *(const f32x4*)(sc + c0), shv = *(const f32x4*)(sh + c0);
        f16x4 o;
#pragma unroll
        for (int e = 0; e < 4; ++e) o[e] = (f16)(xv[4 * j + e] * r * gv[e] * (1.f + scv[e]) + shv[e]);
        *(f16x4*)(hrow + c0) = o;
    }
}
__device__ __forceinline__ void ph_norm0(const Ctx& C, int TID, int bid, int nblk) {
    const float* x = C.in[0]; const float* norm_g = C.in[14]; const float* MOD = (const float*)(C.ws + WS_MOD);
    f16* H = (f16*)(C.ws + WS_H);
    const int lane = TID & 63, gw = bid * NWAVE + (TID >> 6), ngw = nblk * NWAVE;
    for (int m = gw; m < M; m += ngw) {
        const int b = m / S;
        float xv[16];
#pragma unroll
        for (int j = 0; j < 4; ++j) { const f32x4 v = *(const f32x4*)(x + (size_t)m * D + 256 * j + 4 * lane); xv[4 * j] = v[0]; xv[4 * j + 1] = v[1]; xv[4 * j + 2] = v[2]; xv[4 * j + 3] = v[3]; }
        const float* mod = MOD + (size_t)(0 * NB + b) * 6 * D;
        adaln_row(xv, norm_g + 0, mod + D, mod + 0, H + (size_t)m * D, lane);
    }
}
__device__ __forceinline__ void ph_resnorm(const Ctx& C, int l, int sub, int TID, int bid, int nblk) {
    const float* norm_g = C.in[14]; const float* MOD = (const float*)(C.ws + WS_MOD);
    const f16* Y = (const f16*)(C.ws + WS_Y); f16* H = (f16*)(C.ws + WS_H);
    const float* xsrc = (l == 0 && sub == 0) ? C.in[0] : C.out;
    const float* ga = norm_g + (size_t)(l * 4 + (sub == 0 ? 1 : 3)) * D;
    const bool has_next = !(l == DEPTH - 1 && sub == 1);
    const int ln = sub == 0 ? l : l + 1;
    const float* gb = norm_g + (size_t)((has_next ? ln : 0) * 4 + (sub == 0 ? 2 : 0)) * D;
    const int lane = TID & 63, gw = bid * NWAVE + (TID >> 6), ngw = nblk * NWAVE;
    for (int m = gw; m < M; m += ngw) {
        const int b = m / S;
        const float* mod = MOD + (size_t)(l * NB + b) * 6 * D;
        const float* gt = mod + (sub == 0 ? 2 : 5) * D;
        float yv[16], xv[16]; float ss = 0.f;
#pragma unroll
        for (int j = 0; j < 4; ++j) {
            const f16x4 v = *(const f16x4*)(Y + (size_t)m * D + 256 * j + 4 * lane);
#pragma unroll
            for (int e = 0; e < 4; ++e) { yv[4 * j + e] = (float)v[e]; ss += yv[4 * j + e] * yv[4 * j + e]; }
        }
        const float r = rsqrtf(wave_sum(ss) * (1.f / D) + EPS);
#pragma unroll
        for (int j = 0; j < 4; ++j) {
            const int c0 = 256 * j + 4 * lane;
            const f32x4 xo = *(const f32x4*)(xsrc + (size_t)m * D + c0), gav = *(const f32x4*)(ga + c0), gtv = *(const f32x4*)(gt + c0);
            f32x4 xn;
#pragma unroll
            for (int e = 0; e < 4; ++e) { xn[e] = xo[e] + gtv[e] * (yv[4 * j + e] * r * gav[e]); xv[4 * j + e] = xn[e]; }
            *(f32x4*)(C.out + (size_t)m * D + c0) = xn;
        }
        if (has_next) {
            const float* modn = MOD + (size_t)(ln * NB + b) * 6 * D;
            adaln_row(xv, gb, modn + (sub == 0 ? 4 : 1) * D, modn + (sub == 0 ? 3 : 0) * D, H + (size_t)m * D, lane);
        }
    }
}

__device__ __forceinline__ void ph_conv(const Ctx& C, int l, int TID, int bid, int nblk) {
    const f16* Z = (const f16*)(C.ws + WS_Z); f16* MIX = (f16*)(C.ws + WS_MIX);
    const float* cw = C.in[4] + (size_t)l * 3 * 256; const float* gain = C.in[12] + (size_t)l * D;
    const int lane = TID & 63, gw = bid * NWAVE + (TID >> 6), ngw = nblk * NWAVE;
    for (int m = gw; m < M; m += ngw) {
        const int t = m % S;
        float o[4]; float ss = 0.f;
#pragma unroll
        for (int j = 0; j < 4; ++j) {
            const int ch = lane + 64 * j; float y = 0.f;
#pragma unroll
            for (int k = 0; k < 3; ++k) {
                const int tt = t - 2 + k;
                if (tt >= 0) { const f16* zr = Z + (size_t)(m - 2 + k) * ZP; y += (float)zr[ZC_AC + ch] * (float)zr[ZC_AH + ch] * cw[k * 256 + ch]; }
            }
            o[j] = (float)Z[(size_t)m * ZP + ZC_AB + ch] * y; ss += o[j] * o[j];
        }
        const float r = rsqrtf(wave_sum(ss) * (1.f / 256) + EPS);
#pragma unroll
        for (int j = 0; j < 4; ++j) { const int ch = lane + 64 * j; MIX[(size_t)m * D + ch] = (f16)(o[j] * r * gain[ch]); }
    }
}
__device__ __forceinline__ void ph_rotk(const Ctx& C, int TID, int bid, int nblk) {
    const f16* Z = (const f16*)(C.ws + WS_Z); f16* KSR = (f16*)(C.ws + WS_KSR); f16* KWR = (f16*)(C.ws + WS_KWR);
    const float* RC = (const float*)(C.ws + WS_ROPE); const float* RS = RC + (size_t)M * 8;
    for (int idx = bid * NT + TID; idx < M * 128; idx += nblk * NT) {
        const int d = idx & 63, which = (idx >> 6) & 1, m = idx >> 7;
        const f16* zr = Z + (size_t)m * ZP + (which ? ZC_KWIN : ZC_KSLC);
        float v = (float)zr[d];
        if (d < 16) { const int i = d & 7; const float cs = RC[m * 8 + i], sn = RS[m * 8 + i];
            if (d < 8) v = v * cs - (float)zr[d + 8] * sn; else v = v * cs + (float)zr[d - 8] * sn; }
        (which ? KWR : KSR)[(size_t)m * 64 + d] = (f16)v;
    }
}
__device__ __forceinline__ void ph_cmp1(const Ctx& C, int l, int TID, int bid, int nblk) {
    const f16* Z = (const f16*)(C.ws + WS_Z); float* G = (float*)(C.ws + WS_G);
    const f16* W1T = (const f16*)(C.ws + WS_W1T) + (size_t)l * 2 * 256 * 1024;
    const int lane = TID & 63, r32 = lane & 31, hi = lane >> 5, gw = bid * NWAVE + (TID >> 6), ngw = nblk * NWAVE;
    for (int it = gw; it < 2 * 64 * 8; it += ngw) {
        const int ct = it & 7, rt = (it >> 3) & 63, j = it >> 9;
        const int row = rt * 32 + r32;
        const f16* ap = Z + ((size_t)(row >> 8) * S + 16 * (row & 255)) * ZP + (j ? ZC_VCMP : ZC_KCMP) + 8 * hi;
        const f16* bp = W1T + ((size_t)j * 256 + ct * 32 + r32) * 1024 + 8 * hi;
        f32x16 acc;
#pragma unroll
        for (int r = 0; r < 16; ++r) acc[r] = 0.f;
        for (int k8 = 0; k8 < 64; k8 += 8) {
            f16x8 av[8], bv[8];
#pragma unroll
            for (int i = 0; i < 8; ++i) { const int ks = k8 + i; av[i] = *(const f16x8*)(ap + (size_t)(ks >> 2) * ZP + (ks & 3) * 16); bv[i] = *(const f16x8*)(bp + ks * 16); }
#pragma unroll
            for (int i = 0; i < 8; ++i) acc = __builtin_amdgcn_mfma_f32_32x32x16_f16(av[i], bv[i], acc, 0, 0, 0);
        }
        float* gp = G + ((size_t)j * 2048 + rt * 32) * 256 + ct * 32 + r32;
#pragma unroll
        for (int r = 0; r < 16; ++r) gp[(size_t)crow(r, hi) * 256] = acc[r];
    }
}
__device__ __forceinline__ void ph_cmp2(const Ctx& C, int l, int TID, int bid, int nblk, LAS float* lds) {
    const float* G = (const float*)(C.ws + WS_G); const float* PCB = (const float*)(C.ws + WS_PCB) + (size_t)l * 2 * 32 * 128;
    float* KC = (float*)(C.ws + WS_KC); float* VC = (float*)(C.ws + WS_VC);
    const float* w2 = C.in[7] + (size_t)l * 2 * 128 * 64;
    LAS float* w2s = lds;
    LAS float* cbs = lds + 16384;
    LAS float* hs = lds + 16640 + (TID >> 6) * 128;
    const int tid = TID, lane = tid & 63, gw = bid * NWAVE + (tid >> 6), ngw = nblk * NWAVE;
    __syncthreads();
    for (int idx = tid; idx < 2 * 128 * 64; idx += NT) w2s[idx] = w2[idx];
    if (tid < 256) { float s = 0.f; for (int q = 0; q < 32; ++q) s += PCB[((tid >> 7) * 32 + q) * 128 + (tid & 127)]; cbs[tid] = s; }
    __syncthreads();
    for (int it = gw; it < 2 * NB * NCMP; it += ngw) {
        const int j = it / (NB * NCMP), bi = it % (NB * NCMP), b = bi / NCMP, i = bi % NCMP;
        const float* g0 = G + ((size_t)j * 2048 + b * 256 + i) * 256;
#pragma unroll
        for (int q = 0; q < 2; ++q) { const int o = lane + 64 * q; hs[o] = siluf(g0[o] + g0[256 + 128 + o] + cbs[j * 128 + o]); }
        WAVE_LDS_SYNC();
        float acc = 0.f;
#pragma unroll 16
        for (int o = 0; o < 128; ++o) acc += hs[o] * w2s[(j * 128 + o) * 64 + lane];
        (j ? VC : KC)[(size_t)bi * 64 + lane] = acc;
        ((f16*)(C.ws + (j ? WS_VC16 : WS_KC16)))[((size_t)b * 256 + i) * 64 + lane] = (f16)acc;
        WAVE_LDS_SYNC();
    }
    for (int it = gw; it < 2 * NB; it += ngw) ((f16*)(C.ws + ((it & 1) ? WS_VC16 : WS_KC16)))[((size_t)(it >> 1) * 256 + 255) * 64 + lane] = (f16)0.f;
}
constexpr float NSA_C2 = 0.125f * 1.4426950408889634f;

#define NSA_ISSUE(Kg, Vg, vpitch, jt, koff, voff) do { \
        int ln_ = lane; asm volatile("" : "+v"(ln_)); \
        const f16* ksrc_ = (Kg) + (size_t)(64 * (jt) + ln_) * 64 + wid * 8; \
        const f16* vsrc_ = (Vg) + (size_t)(64 * (jt) + 16 * (wid & 3) + (ln_ >> 2)) * (vpitch) + (wid >> 2) * 32 + (ln_ & 3) * 8; \
        __builtin_amdgcn_global_load_lds((const unsigned*)ksrc_, (LAS unsigned*)(lds + (koff) + wid * 1024), 16, 0, 0); \
        __builtin_amdgcn_global_load_lds((const unsigned*)vsrc_, (LAS unsigned*)(lds + (voff) + wid * 1024), 16, 0, 0); } while (0)
#define NSA_QKT(p0, p1, kb, qf) do { \
        _Pragma("unroll") for (int r_ = 0; r_ < 16; ++r_) { p0[r_] = 0.f; p1[r_] = 0.f; } \
        _Pragma("unroll") for (int d0_ = 0; d0_ < 4; ++d0_) { \
            const f16x8 k0_ = *(const LAS f16x8*)((kb) + d0_ * 2048), k1_ = *(const LAS f16x8*)((kb) + d0_ * 2048 + 512); \
            p0 = __builtin_amdgcn_mfma_f32_32x32x16_f16(k0_, qf[d0_], p0, 0, 0, 0); \
            p1 = __builtin_amdgcn_mfma_f32_32x32x16_f16(k1_, qf[d0_], p1, 0, 0, 0); } } while (0)
#define NSA_PV(o, p0, p1, vs) do { \
        f16x8 pa_[4]; \
        _Pragma("unroll") for (int e_ = 0; e_ < 8; ++e_) { pa_[0][e_] = (f16)p0[e_]; pa_[1][e_] = (f16)p0[8 + e_]; pa_[2][e_] = (f16)p1[e_]; pa_[3][e_] = (f16)p1[8 + e_]; } \
        _Pragma("unroll") for (int d0_ = 0; d0_ < 2; ++d0_) \
            _Pragma("unroll") for (int ks_ = 0; ks_ < 4; ++ks_) { \
                const s16x4 lo_ = vtr((vs) + d0_ * 4096 + ks_ * 1024), hh_ = vtr((vs) + d0_ * 4096 + ks_ * 1024 + 512); \
                const s16x8 bv_ = {lo_[0], lo_[1], lo_[2], lo_[3], hh_[0], hh_[1], hh_[2], hh_[3]}; \
                o[d0_] = __builtin_amdgcn_mfma_f32_32x32x16_f16(pa_[ks_], __builtin_bit_cast(f16x8, bv_), o[d0_], 0, 0, 0); } } while (0)
typedef short s16x8 __attribute__((ext_vector_type(8)));

template <int MODE>
__device__ __forceinline__ void nsa_branch(const f16* Kg, const f16* Vg, int c, unsigned long long sel, int tokw, const f16x8 (&qf)[4], f32x16 (&o)[2], float& lsum,
                                           LAS unsigned char* lds, LAS float* wsf, int wid, int lane, int r32, int hi) {
    const float NEG = -__builtin_inff();
    float m = NEG; lsum = 0.f;
#pragma unroll
    for (int r = 0; r < 16; ++r) { o[0][r] = 0.f; o[1][r] = 0.f; }
    const int ntiles = MODE == 0 ? c + 1 : (c < 8 ? c + 1 : 9);
    const LAS unsigned char* vlane = lds + 16384 + ((lane >> 4) & 1) * 32 + (lane & 3) * 8 + (4 * hi + ((lane & 15) >> 2)) * 64;
    NSA_ISSUE(Kg, Vg, ZP, (MODE == 0 ? 0 : c), 0, 16384);
    for (int i = 0; i < ntiles; ++i) {
        const int j = MODE == 0 ? i : c - i, slot = i & 1;
        asm volatile("s_waitcnt vmcnt(0)" ::: "memory");
        __syncthreads();
        if (i + 1 < ntiles) { const int jn = MODE == 0 ? i + 1 : c - i - 1; NSA_ISSUE(Kg, Vg, ZP, jn, (slot ^ 1) * 8192, 16384 + (slot ^ 1) * 8192); }
        f32x16 p0, p1;
        const LAS unsigned char* kb = lds + slot * 8192 + hi * 1024 + r32 * 16;
        NSA_QKT(p0, p1, kb, qf);
        if (j == c) {
#pragma unroll
            for (int r = 0; r < 16; ++r) { const int kk = crow(r, hi); if (kk > tokw) p0[r] = NEG; if (kk + 32 > tokw) p1[r] = NEG; }
        }
        if (MODE == 1 && j == c - 8) {
#pragma unroll
            for (int r = 0; r < 16; ++r) { const int kk = crow(r, hi); if (kk <= tokw) p0[r] = NEG; if (kk + 32 <= tokw) p1[r] = NEG; }
        }
        const bool rowsel = MODE == 0 ? ((sel >> j) & 1ull) != 0ull : true;
        float rm = fmaxf(p0[0], p1[0]);
#pragma unroll
        for (int r = 1; r < 16; ++r) rm = fmaxf(rm, fmaxf(p0[r], p1[r]));
        rm = pl32_max(rm);
        rm = rowsel ? rm : NEG;
        const float mnew = fmaxf(m, rm);
        const float corr = __builtin_amdgcn_exp2f(m - mnew);
        const float msub = rowsel ? mnew : __builtin_inff();
        float ps = 0.f;
#pragma unroll
        for (int r = 0; r < 16; ++r) { p0[r] = __builtin_amdgcn_exp2f(p0[r] - msub); p1[r] = __builtin_amdgcn_exp2f(p1[r] - msub); ps += p0[r] + p1[r]; }
        lsum = lsum * corr + ps; m = mnew;
        if (__any(corr != 1.0f)) {
            if (hi == 0) wsf[r32] = corr;
            WAVE_LDS_SYNC();
#pragma unroll
            for (int r = 0; r < 16; ++r) { const float f = wsf[crow(r, hi)]; o[0][r] *= f; o[1][r] *= f; }
            WAVE_LDS_SYNC();
        }
        const LAS unsigned char* vs = vlane + slot * 8192;
        NSA_PV(o, p0, p1, vs);
    }
    __syncthreads();
}

constexpr int NSA_WS_OFF = 65536;
__device__ __forceinline__ void nsa_unit(const Ctx& C, int l, int b, int c, int TID, LAS unsigned char* lds) {
    const f16* Z = (const f16*)(C.ws + WS_Z); f16* MIX = (f16*)(C.ws + WS_MIX);
    const f16* KSR = (const f16*)(C.ws + WS_KSR); const f16* KWR = (const f16*)(C.ws + WS_KWR);
    const f16* KC16 = (const f16*)(C.ws + WS_KC16) + (size_t)b * 256 * 64; const f16* VC16 = (const f16*)(C.ws + WS_VC16) + (size_t)b * 256 * 64;
    const float* RC = (const float*)(C.ws + WS_ROPE); const float* RS = RC + (size_t)M * 8;
    const float* gain = C.in[12] + (size_t)l * D + 256;
    const int tid = TID, lane = tid & 63, wid = __builtin_amdgcn_readfirstlane(tid >> 6), r32 = lane & 31, hi = lane >> 5;
    const size_t m0 = (size_t)b * S + 64 * c;
    const int tokw = 8 * wid + (r32 >> 2), head = r32 & 3;
    const size_t mrow = m0 + tokw;
#define ZROW() ({ size_t mr_ = mrow; asm volatile("" : "+v"(mr_)); Z + mr_ * ZP; })
    const float NEG = -__builtin_inff();
    LAS float* wsb = (LAS float*)(lds + NSA_WS_OFF) + wid * 1280;
    LAS float* wsf = wsb; LAS float* Aa = wsb + 64; LAS float* Bb = wsb + 576; LAS float* Ssc = wsb + 1100; LAS unsigned long long* SELW = (LAS unsigned long long*)(wsb + 1168);
    f32x16 tot[2], o[2];
    unsigned long long sel;
    {
        f16x8 qc[4];
#pragma unroll
        for (int d0 = 0; d0 < 4; ++d0) { const f16x8 qv = *(const f16x8*)(ZROW() + ZC_NQ + 64 * head + 16 * d0 + 8 * hi);
#pragma unroll
            for (int i = 0; i < 8; ++i) qc[d0][i] = (f16)((float)qv[i] * NSA_C2); }
        const int nct = (4 * c + 3 + 63) >> 6;
        for (int T = 0; T < nct; ++T) NSA_ISSUE(KC16, VC16, 64, T, T * 8192, 32768 + T * 8192);
        for (int i = lane; i < 1036; i += 64) Aa[i] = 0.f;
        asm volatile("s_waitcnt vmcnt(0)" ::: "memory");
        __syncthreads();
        const int t = 64 * c + tokw, imax = t >= 31 ? (t - 31) >> 4 : -1;
        const LAS unsigned char* kb0 = lds + hi * 1024 + r32 * 16;
        const LAS unsigned char* vl0 = lds + 32768 + ((lane >> 4) & 1) * 32 + (lane & 3) * 8 + (4 * hi + ((lane & 15) >> 2)) * 64;
        float m = NEG, lsum = 0.f;
        for (int T = 0; T < nct; ++T) {
            f32x16 p0, p1;
            NSA_QKT(p0, p1, kb0 + T * 8192, qc);
            float rm = NEG;
#pragma unroll
            for (int r = 0; r < 16; ++r) { const int i0 = 64 * T + crow(r, hi); p0[r] = i0 <= imax ? p0[r] : NEG; p1[r] = i0 + 32 <= imax ? p1[r] : NEG; rm = fmaxf(rm, fmaxf(p0[r], p1[r])); }
            rm = pl32_max(rm);
            const float mnew = fmaxf(m, rm), msafe = mnew == NEG ? 0.f : mnew;
            float ps = 0.f;
#pragma unroll
            for (int r = 0; r < 16; ++r) ps += __builtin_amdgcn_exp2f(p0[r] - msafe) + __builtin_amdgcn_exp2f(p1[r] - msafe);
            lsum = lsum * __builtin_amdgcn_exp2f(m - msafe) + ps; m = mnew;
        }
        const float ltot = pl32_sum(lsum), inv = ltot > 0.f ? 1.f / ltot : 0.f, msafe = m == NEG ? 0.f : m;
#pragma unroll
        for (int r = 0; r < 16; ++r) { o[0][r] = 0.f; o[1][r] = 0.f; }
        for (int T = 0; T < nct; ++T) {
            f32x16 p0, p1;
            NSA_QKT(p0, p1, kb0 + T * 8192, qc);
#pragma unroll
            for (int r = 0; r < 16; ++r) { const int i0 = 64 * T + crow(r, hi);
                p0[r] = i0 <= imax ? __builtin_amdgcn_exp2f(p0[r] - msafe) * inv : 0.f; p1[r] = i0 + 32 <= imax ? __builtin_amdgcn_exp2f(p1[r] - msafe) * inv : 0.f; }
#pragma unroll
            for (int k = 0; k < 4; ++k) {
                float a0 = 2.f * (p0[4 * k] + p0[4 * k + 1] + p0[4 * k + 2]) + p0[4 * k + 3], b0 = p0[4 * k + 3];
                float a1 = 2.f * (p1[4 * k] + p1[4 * k + 1] + p1[4 * k + 2]) + p1[4 * k + 3], b1 = p1[4 * k + 3];
                a0 += __shfl_xor(a0, 1); a0 += __shfl_xor(a0, 2); b0 += __shfl_xor(b0, 1); b0 += __shfl_xor(b0, 2);
                a1 += __shfl_xor(a1, 1); a1 += __shfl_xor(a1, 2); b1 += __shfl_xor(b1, 1); b1 += __shfl_xor(b1, 2);
                if (head == 0) { const int g = 16 * T + 2 * k + hi, tl = r32 >> 2;
                    Aa[tl * 64 + g] = a0; Bb[tl * 65 + g + 1] = b0; Aa[tl * 64 + g + 8] = a1; Bb[tl * 65 + g + 9] = b1; }
            }
            NSA_PV(o, p0, p1, vl0 + T * 8192);
        }
        {
            const float f = sigmoidf_((float)ZROW()[ZC_NG + 3 * head + 0]);
            if (hi == 0) wsf[r32] = f;
            WAVE_LDS_SYNC();
#pragma unroll
            for (int r = 0; r < 16; ++r) { const float fr = wsf[crow(r, hi)]; tot[0][r] = o[0][r] * fr; tot[1][r] = o[1][r] * fr; }
            WAVE_LDS_SYNC();
        }
        if (c >= 16) {
            for (int tk = 0; tk < 8; ++tk) {
                const bool forced = (lane < 1) || (c - lane >= 0 && c - lane < 2);
                const float sc = (lane <= c) ? Aa[tk * 64 + lane] + Bb[tk * 65 + lane] + (forced ? 1e4f : 0.f) : -1e30f;
                Ssc[lane] = sc;
                WAVE_LDS_SYNC();
                int rank = 0;
#pragma unroll 4
                for (int q = 0; q < 16; ++q) { const f32x4 v = *(const LAS f32x4*)(Ssc + 4 * q);
#pragma unroll
                    for (int e = 0; e < 4; ++e) rank += (v[e] > sc || (v[e] == sc && 4 * q + e < lane)) ? 1 : 0; }
                const unsigned long long mk = __ballot(rank < 16);
                if (lane == 0) SELW[tk] = mk;
                WAVE_LDS_SYNC();
            }
            sel = SELW[r32 >> 2];
        } else sel = (2ull << c) - 1ull;
        __syncthreads();
    }
    f16x8 qf[4];
#pragma unroll
    for (int d0 = 0; d0 < 4; ++d0) qf[d0] = *(const f16x8*)(ZROW() + ZC_NQ + 64 * head + 16 * d0 + 8 * hi);
    {
        const u32x4 w = __builtin_bit_cast(u32x4, qf[0]); u32x4 ow;
#pragma unroll
        for (int k = 0; k < 4; ++k) ow[k] = pl32_other(w[k], hi);
        const f16x8 of = __builtin_bit_cast(f16x8, ow);
        size_t mr2 = mrow; asm volatile("" : "+v"(mr2));
        const f32x4 c0 = *(const f32x4*)(RC + mr2 * 8), c1 = *(const f32x4*)(RC + mr2 * 8 + 4), s0 = *(const f32x4*)(RS + mr2 * 8), s1 = *(const f32x4*)(RS + mr2 * 8 + 4);
#pragma unroll
        for (int i = 0; i < 8; ++i) {
            const float cs = i < 4 ? c0[i & 3] : c1[i & 3], sn = i < 4 ? s0[i & 3] : s1[i & 3];
            const float a = (float)qf[0][i], bq = (float)of[i];
            const float r = hi ? a * cs + bq * sn : a * cs - bq * sn;
            qf[0][i] = (f16)(r * NSA_C2);
        }
#pragma unroll
        for (int d0 = 1; d0 < 4; ++d0)
#pragma unroll
            for (int i = 0; i < 8; ++i) qf[d0][i] = (f16)((float)qf[d0][i] * NSA_C2);
    }
    float lsum;
    nsa_branch<0>(KSR + (size_t)b * S * 64, Z + (size_t)b * S * ZP + ZC_VSLC, c, sel, tokw, qf, o, lsum, lds, wsf, wid, lane, r32, hi);
    {
        const float f = sigmoidf_((float)ZROW()[ZC_NG + 3 * head + 1]) / pl32_sum(lsum);
        if (hi == 0) wsf[r32] = f;
        WAVE_LDS_SYNC();
#pragma unroll
        for (int r = 0; r < 16; ++r) { const float fr = wsf[crow(r, hi)]; tot[0][r] += o[0][r] * fr; tot[1][r] += o[1][r] * fr; }
        WAVE_LDS_SYNC();
    }
    nsa_branch<1>(KWR + (size_t)b * S * 64, Z + (size_t)b * S * ZP + ZC_VWIN, c, sel, tokw, qf, o, lsum, lds, wsf, wid, lane, r32, hi);
    {
        const float f = sigmoidf_((float)ZROW()[ZC_NG + 3 * head + 2]) / pl32_sum(lsum);
        if (hi == 0) wsf[r32] = f;
        WAVE_LDS_SYNC();
#pragma unroll
        for (int r = 0; r < 16; ++r) { const float fr = wsf[crow(r, hi)]; tot[0][r] += o[0][r] * fr; tot[1][r] += o[1][r] * fr; }
        WAVE_LDS_SYNC();
    }
    int r32s = r32; asm volatile("" : "+v"(r32s));
#pragma unroll
    for (int k = 0; k < 4; ++k) {
        const size_t mm = m0 + 8 * wid + 2 * k + hi;
        float ss = 0.f;
#pragma unroll
        for (int hd = 0; hd < 4; ++hd)
#pragma unroll
            for (int d0 = 0; d0 < 2; ++d0) { const float v = tot[d0][4 * k + hd]; ss += v * v; }
#pragma unroll
        for (int off = 1; off < 32; off <<= 1) ss += __shfl_xor(ss, off);
        const float rinv = rsqrtf(ss * (1.f / 256) + EPS);
#pragma unroll
        for (int hd = 0; hd < 4; ++hd)
#pragma unroll
            for (int d0 = 0; d0 < 2; ++d0) MIX[mm * D + 256 + 64 * hd + 32 * d0 + r32s] = (f16)(tot[d0][4 * k + hd] * rinv * gain[64 * hd + 32 * d0 + r32s]);
    }
}
#undef ZROW
__device__ __forceinline__ void ph_nsa(const Ctx& C, int l, int TID, int bid, int nblk, LAS float* lds) {
    for (int item = bid; item < 256; item += nblk) {
        const int b = item >> 5, s = item & 31;
        for (int u = 0; u < 2; ++u) {
            const int c = u == 0 ? s : 63 - s;
            __syncthreads();
            nsa_unit(C, l, b, c, TID, (LAS unsigned char*)lds);
        }
    }
}
__device__ __forceinline__ void ph_gla1(const Ctx& C, int l, int TID, int bid, int nblk) {
    const f16* Z = (const f16*)(C.ws + WS_Z); float* LA = (float*)(C.ws + WS_LA);
    const float* w2 = C.in[8] + (size_t)l * 16 * 128; const float* gb = C.in[9] + (size_t)l * 128;
    for (int idx = bid * NT + TID; idx < M * 128; idx += nblk * NT) {
        const int dim = idx & 127, m = idx >> 7;
        const f16* lr = Z + (size_t)m * ZP + ZC_LR;
        float a = gb[dim];
#pragma unroll
        for (int r = 0; r < 16; ++r) a += (float)lr[r] * w2[r * 128 + dim];
        const float ls = fminf(a, 0.f) - log1pf(expf(-fabsf(a)));
        LA[idx] = ls * (1.f / 16.f);
    }
}
__device__ __forceinline__ void ph_gla2(const Ctx& C, int TID, int bid, int nblk) {
    float* LA = (float*)(C.ws + WS_LA);
    const int total = (M / 64) * 128;
    for (int idx = bid * NT + TID; idx < total; idx += nblk * NT) {
        const int dim = idx & 127, ch = idx >> 7;
        float run = 0.f;
        for (int t0 = 0; t0 < 64; t0 += 16) {
            float v[16];
#pragma unroll
            for (int i = 0; i < 16; ++i) v[i] = LA[((size_t)ch * 64 + t0 + i) * 128 + dim];
#pragma unroll
            for (int i = 0; i < 16; ++i) { run += v[i]; LA[((size_t)ch * 64 + t0 + i) * 128 + dim] = run; }
        }
    }
}
__device__ __forceinline__ void ph_gla3(const Ctx& C, int TID, int bid, int nblk, LAS float* lds) {
    const f16* Z = (const f16*)(C.ws + WS_Z); const float* Bc = (const float*)(C.ws + WS_LA);
    float* QE2 = (float*)(C.ws + WS_QE2); float* OI = (float*)(C.ws + WS_OI); float* KV = (float*)(C.ws + WS_KV);
    LAS float* qe = lds; LAS float* ke = lds + 2112; LAS float* k2 = lds + 4224; LAS float* vs = lds + 6336; LAS float* att = lds + 10432;
    const int tid = TID;
    for (int item = bid; item < NB * 4 * 64; item += nblk) {
        const int n = item & 63, h = (item >> 6) & 3, b = item >> 8;
        const size_t m0 = (size_t)b * S + n * 64;
        __syncthreads();
        for (int idx = tid; idx < 2048; idx += NT) {
            const int tt = idx >> 5, d = idx & 31;
            const float bb = Bc[(m0 + tt) * 128 + 32 * h + d], bmid = Bc[(m0 + 32) * 128 + 32 * h + d], blast = Bc[(m0 + 63) * 128 + 32 * h + d];
            const float qv = (float)Z[(m0 + tt) * ZP + ZC_LQ + 32 * h + d] * 0.17677669529663687f, kv = (float)Z[(m0 + tt) * ZP + ZC_LK + 32 * h + d];
            qe[tt * 33 + d] = qv * expf(bb - bmid); ke[tt * 33 + d] = kv * expf(bmid - bb); k2[tt * 33 + d] = kv * expf(blast - bb);
            QE2[(m0 + tt) * 128 + 32 * h + d] = qv * expf(bb);
        }
        for (int idx = tid; idx < 4096; idx += NT) { const int tt = idx >> 6, v = idx & 63; vs[idx] = (float)Z[(m0 + tt) * ZP + ZC_LV + 64 * h + v]; }
        __syncthreads();
        for (int idx = tid; idx < 4096; idx += NT) {
            const int tt = idx >> 6, s = idx & 63; float a = 0.f;
            if (s <= tt) { for (int d = 0; d < 32; ++d) a += qe[tt * 33 + d] * ke[s * 33 + d]; }
            att[tt * 65 + s] = a;
        }
        __syncthreads();
        for (int idx = tid; idx < 4096; idx += NT) {
            const int tt = idx >> 6, v = idx & 63; float o = 0.f;
            for (int s = 0; s <= tt; ++s) o += att[tt * 65 + s] * vs[s * 64 + v];
            OI[(m0 + tt) * 256 + 64 * h + v] = o;
        }
        for (int idx = tid; idx < 2048; idx += NT) {
            const int d = idx >> 6, v = idx & 63; float a = 0.f;
            for (int s = 0; s < 64; ++s) a += k2[s * 33 + d] * vs[s * 64 + v];
            KV[(size_t)item * 2048 + idx] = a;
        }
    }
}
__device__ __forceinline__ void ph_gla4(const Ctx& C, int TID, int bid, int nblk) {
    const float* Bc = (const float*)(C.ws + WS_LA); const float* KV = (const float*)(C.ws + WS_KV); float* SP = (float*)(C.ws + WS_SPREV);
    for (int idx = bid * NT + TID; idx < NB * 4 * 2048; idx += nblk * NT) {
        const int dv = idx & 2047, bh = idx >> 11, d = dv >> 6, h = bh & 3, b = bh >> 2;
        float st = 0.f;
        for (int n0 = 0; n0 < 64; n0 += 16) {
            float kvv[16], bl[16];
#pragma unroll
            for (int i = 0; i < 16; ++i) { kvv[i] = KV[((size_t)bh * 64 + n0 + i) * 2048 + dv]; bl[i] = Bc[((size_t)b * S + (n0 + i) * 64 + 63) * 128 + 32 * h + d]; }
#pragma unroll
            for (int i = 0; i < 16; ++i) { SP[((size_t)bh * 64 + n0 + i) * 2048 + dv] = st; st = expf(bl[i]) * st + kvv[i]; }
        }
    }
}
__device__ __forceinline__ void ph_gla5(const Ctx& C, int l, int TID, int bid, int nblk) {
    const f16* Z = (const f16*)(C.ws + WS_Z); f16* MIX = (f16*)(C.ws + WS_MIX);
    const float* QE2 = (const float*)(C.ws + WS_QE2); const float* OI = (const float*)(C.ws + WS_OI); const float* SP = (const float*)(C.ws + WS_SPREV);
    const float* gain = C.in[12] + (size_t)l * D + 512;
    const int lane = TID & 63, gw = bid * NWAVE + (TID >> 6), ngw = nblk * NWAVE;
    for (int m = gw; m < M; m += ngw) {
        const int b = m / S, t = m % S, n = t >> 6;
        float og[4]; float ss = 0.f;
#pragma unroll
        for (int h = 0; h < 4; ++h) {
            float o = OI[(size_t)m * 256 + 64 * h + lane];
            const float* sp = SP + ((size_t)(b * 4 + h) * 64 + n) * 2048 + lane; const float* qe = QE2 + (size_t)m * 128 + 32 * h;
            float spv[32];
#pragma unroll
            for (int d = 0; d < 32; ++d) spv[d] = sp[d * 64];
#pragma unroll
            for (int d4 = 0; d4 < 8; ++d4) { const f32x4 q4 = *(const f32x4*)(qe + 4 * d4);
#pragma unroll
                for (int e = 0; e < 4; ++e) o += q4[e] * spv[4 * d4 + e]; }
            const float ms = wave_sum(o * o) * (1.f / 64);
            const float gv = (float)Z[(size_t)m * ZP + ZC_LG + 64 * h + lane];
            og[h] = siluf(gv) * (o * rsqrtf(ms + EPS)); ss += og[h] * og[h];
        }
        const float r = rsqrtf(wave_sum(ss) * (1.f / 256) + EPS);
#pragma unroll
        for (int h = 0; h < 4; ++h) MIX[(size_t)m * D + 512 + 64 * h + lane] = (f16)(og[h] * r * gain[64 * h + lane]);
    }
}
__device__ __forceinline__ void ph_gmlp(const Ctx& C, int l, int TID, int bid, int nblk, LAS unsigned char* lds) {
    const f16* Z = (const f16*)(C.ws + WS_Z); f16* MIX = (f16*)(C.ws + WS_MIX);
    const f16* W16 = (const f16*)(C.ws + WS_WS16) + (size_t)l * 4 * 128 * 128;
    const float* bs = C.in[11] + (size_t)l * 4 * 128; const float* gain = C.in[12] + (size_t)l * D + 768;
    const int tid = TID, lane = tid & 63, wid = tid >> 6, r32 = lane & 31, hi = lane >> 5;
    LAS unsigned char* OS = lds + 65536;
    for (int item = bid; item < M / 128; item += nblk) {
        const size_t m0 = (size_t)item * 128;
        __syncthreads();
#pragma unroll
        for (int it = 0; it < 8; ++it) {
            const int q = tid + NT * it, s = q >> 5, g = (q >> 3) & 3, ch = q & 7;
            const f16x8 v8 = *(const f16x8*)(Z + (m0 + s) * ZP + ZC_MV + 64 * g + 8 * ch);
            float v[8]; float sum = 0.f;
#pragma unroll
            for (int e = 0; e < 8; ++e) { v[e] = (float)v8[e]; sum += v[e]; }
            sum += __shfl_xor(sum, 1); sum += __shfl_xor(sum, 2); sum += __shfl_xor(sum, 4);
            const float mu = sum * (1.f / 64); float var = 0.f;
#pragma unroll
            for (int e = 0; e < 8; ++e) { v[e] -= mu; var += v[e] * v[e]; }
            var += __shfl_xor(var, 1); var += __shfl_xor(var, 2); var += __shfl_xor(var, 4);
            const float rs = rsqrtf(var * (1.f / 64) + EPS);
            f16x8 o8;
#pragma unroll
            for (int e = 0; e < 8; ++e) o8[e] = (f16)(v[e] * rs);
            *(LAS f16x8*)(lds + g * 16384 + (ch >> 2) * 8192 + s * 64 + (ch & 3) * 16) = o8;
        }
        __syncthreads();
        {
            const int g = wid >> 1, wh = wid & 1;
            const LAS unsigned char* vb = lds + g * 16384 + wh * 8192 + ((lane >> 4) & 1) * 32 + (lane & 3) * 8 + (4 * hi + ((lane & 15) >> 2)) * 64;
            for (int rt = 0; rt < 4; ++rt) {
                f32x16 acc;
#pragma unroll
                for (int r = 0; r < 16; ++r) acc[r] = 0.f;
                const f16* wrow = W16 + ((size_t)g * 128 + 32 * rt + r32) * 128 + 4 * hi;
                for (int ks = 0; ks < 2 * rt + 2; ++ks) {
                    const f16x4 a0 = *(const f16x4*)(wrow + 16 * ks), a1 = *(const f16x4*)(wrow + 16 * ks + 8);
                    const f16x8 af = {a0[0], a0[1], a0[2], a0[3], a1[0], a1[1], a1[2], a1[3]};
                    const s16x4 lo = vtr(vb + ks * 1024), hh = vtr(vb + ks * 1024 + 512);
                    typedef short s16x8 __attribute__((ext_vector_type(8)));
                    const s16x8 bv = {lo[0], lo[1], lo[2], lo[3], hh[0], hh[1], hh[2], hh[3]};
                    acc = __builtin_amdgcn_mfma_f32_32x32x16_f16(af, __builtin_bit_cast(f16x8, bv), acc, 0, 0, 0);
                }
#pragma unroll
                for (int r = 0; r < 16; ++r) {
                    const int t = 32 * rt + crow(r, hi), ch = 64 * g + 32 * wh + r32;
                    const float val = (float)Z[(m0 + t) * ZP + ZC_MU + ch] * (acc[r] + bs[g * 128 + t]);
                    *(LAS f16*)(OS + (t * 256 + ch) * 2) = (f16)val;
                }
            }
        }
        __syncthreads();
        for (int tt = 0; tt < 16; ++tt) {
            const int t = 16 * wid + tt;
            const f16x4 v4 = *(const LAS f16x4*)(OS + (t * 256 + 4 * lane) * 2);
            float v[4]; float ss = 0.f;
#pragma unroll
            for (int e = 0; e < 4; ++e) { v[e] = (float)v4[e]; ss += v[e] * v[e]; }
            const float r = rsqrtf(wave_sum(ss) * (1.f / 256) + EPS);
            const f32x4 gv = *(const f32x4*)(gain + 4 * lane);
            f16x4 o4;
#pragma unroll
            for (int e = 0; e < 4; ++e) o4[e] = (f16)(v[e] * r * gv[e]);
            *(f16x4*)(MIX + (m0 + t) * D + 768 + 4 * lane) = o4;
        }
    }
}

__device__ __forceinline__ void cvt_item(const float* W, int K, int N, f16* WT, bool remap, LAS float* scr, int item, int lane) {
    const int nb_ = (N + 31) / 32, kb = item / nb_, nb = item % nb_, k0 = 64 * kb, n0 = 32 * nb;
#pragma unroll 8
    for (int i = 0; i < 32; ++i) { const int kk = 2 * i + (lane >> 5), n = n0 + (lane & 31); scr[kk * 33 + (lane & 31)] = n < N ? W[(size_t)(k0 + kk) * N + n] : 0.f; }
    WAVE_LDS_SYNC();
    const int c = lane & 7;
#pragma unroll
    for (int j = 0; j < 4; ++j) {
        const int nn = (lane >> 3) + 8 * j, n = n0 + nn;
        if (n < N) {
            const int row = remap ? n + (n >= 1420 ? 4 : 0) : n; const LAS float* s = scr + (8 * c) * 33 + nn;
            f16x8 o;
#pragma unroll
            for (int e = 0; e < 8; ++e) o[e] = (f16)s[e * 33];
            *(f16x8*)(WT + (size_t)row * K + k0 + 8 * c) = o;
        }
    }
    WAVE_LDS_SYNC();
}
__device__ __forceinline__ void ph_wcvt(const Ctx& C, int TID, int bid, int nblk, LAS float* lds) {
    const int lane = TID & 63, wave = TID >> 6, gw = bid * NWAVE + wave, ngw = nblk * NWAVE;
    LAS float* scr = lds + wave * 4096;
    for (int it = gw; it < DEPTH * 2 * 2 * 64; it += ngw) {
        const int r = it & 63, half = (it >> 6) & 1, j = (it >> 7) & 1, l = it >> 8;
        cvt_item(C.in[6] + ((size_t)(l * 2 + j) * 2048 + half * 1024) * 128, 1024, 128, (f16*)(C.ws + WS_W1T) + ((size_t)(l * 2 + j) * 256 + half * 128) * 1024, false, scr, r, lane);
    }
    for (int it = gw; it < DEPTH * 4 * 128; it += ngw) {
        const float* w = C.in[10] + (size_t)it * 128; const int t = it & 127;
        f16* o = (f16*)(C.ws + WS_WS16) + (size_t)it * 128;
        o[lane] = (f16)(lane <= t ? w[lane] : 0.f); o[lane + 64] = (f16)(lane + 64 <= t ? w[lane + 64] : 0.f);
    }
    for (int it = gw; it < DEPTH * 2 * 32; it += ngw) {
        const int q = it & 31, lj = it >> 5;
        const float* pp = C.in[5] + (size_t)lj * 2048 + q * 64; const float* w = C.in[6] + ((size_t)lj * 2048 + q * 64) * 128;
        float a0 = 0.f, a1 = 0.f;
        for (int k = 0; k < 64; ++k) { const float pv = pp[k]; a0 += pv * w[k * 128 + lane]; a1 += pv * w[k * 128 + 64 + lane]; }
        float* o = (float*)(C.ws + WS_PCB) + (size_t)it * 128; o[lane] = a0; o[lane + 64] = a1;
    }
    constexpr int I_IN = (D / 64) * ((NIN + 31) / 32), I_O = (D / 64) * (D / 32), I_UP = (D / 64) * (DFF / 32), I_DN = (DFF / 64) * (D / 32), I_PAD = 100, I_L = I_IN + I_O + I_UP + I_DN + I_PAD;
    for (int it = gw; it < DEPTH * I_L; it += ngw) {
        const int l = it / I_L; int r = it % I_L;
        unsigned char* wl = C.ws + WS_W16 + (size_t)l * W16_LAYER;
        if (r < I_IN) { cvt_item(C.in[3] + (size_t)l * D * NIN, D, NIN, (f16*)(wl + W16_WIN), true, scr, r, lane); continue; } r -= I_IN;
        if (r < I_O) { cvt_item(C.in[13] + (size_t)l * D * D, D, D, (f16*)(wl + W16_WO), false, scr, r, lane); continue; } r -= I_O;
        if (r < I_UP) { cvt_item(C.in[17] + (size_t)l * D * DFF, D, DFF, (f16*)(wl + W16_WUP), false, scr, r, lane); continue; } r -= I_UP;
        if (r < I_DN) { cvt_item(C.in[18] + (size_t)l * DFF * D, DFF, D, (f16*)(wl + W16_WDN), false, scr, r, lane); continue; } r -= I_DN;
        const int row = r < 4 ? 1420 + r : 2720 + (r - 4);
        f16x8 z; for (int e = 0; e < 8; ++e) z[e] = (f16)0.f;
        f16* p = (f16*)(wl + W16_WIN) + (size_t)row * D;
        *(f16x8*)(p + 8 * lane) = z; *(f16x8*)(p + 512 + 8 * lane) = z;
    }
}

namespace pg8 {
#define PG8_LAS __attribute__((address_space(3)))
typedef _Float16 bf16_t;
typedef _Float16 bf16x8 __attribute__((ext_vector_type(8)));
typedef float f32x4 __attribute__((ext_vector_type(4)));
typedef unsigned u32x4 __attribute__((ext_vector_type(4)));
constexpr int BM = 256, BK = 64, HALF = 128, HTB = HALF * BK * 2  , STAGE_BYTES = 8 * HTB, NXCD = 8, WGM = 8;

__host__ __device__ __forceinline__ int lds_byte(int r, int c) { const int st = (r >> 4) * 2 + (c >> 5), rr = r & 15, cc = c & 31, ob = rr * 64 + cc * 2; return st * 1024 + (ob ^ (((ob >> 9) & 1) << 5)); }
__host__ __device__ __forceinline__ void stage_rc(int b, int& R, int& C) { const int st = b / 1024, sb = b % 1024, swz = sb ^ (((sb >> 9) & 1) << 5); R = (st >> 1) * 16 + swz / 64; C = (st & 1) * 32 + (swz % 64) / 2; }
__host__ __device__ __forceinline__ int perm32(int rho) { const int n = rho >> 4, i = rho & 15; return 8 * (i >> 2) + 4 * n + (i & 3); }

struct Unit { int pm, pn; };
struct Gemm { const bf16_t* A; const bf16_t* Bt; int M, N, K; };

struct StaticOrder {
    int nM, nN, nwg, G, c;
    __host__ __device__ void init(int M, int N, int G_, int c_) { nM = M / BM; nN = N / BM; nwg = nM * nN; G = G_; c = c_; }
    __host__ __device__ bool next(int i, Unit& u) const {
        const long L = (long)i * G + c; if (L >= nwg) return false;
        int wgid = (int)L; { const int q = nwg / NXCD, r = nwg % NXCD, xcd = wgid % NXCD, off = wgid / NXCD; wgid = (xcd < r ? xcd * (q + 1) : r * (q + 1) + (xcd - r) * q) + off; }
        const int nig = WGM * nN, gid = wgid / nig, fm = gid * WGM, gsz = (nM - fm) < WGM ? (nM - fm) : WGM;
        u.pm = fm + ((wgid % nig) % gsz); u.pn = (wgid % nig) / gsz; return true;
    }
    __device__ __forceinline__ void a_ready(const Unit&) const {}
    __device__ __forceinline__ void done(const Unit&) const {}
};


template <int ACT> struct EpiF16 {
    static constexpr bool PERM = true, AFTER_DRAIN = false;
    bf16_t* O; int ldc;
    __device__ __forceinline__ void operator()(const f32x4 (&acc)[2][2][4][2], const Unit& u, int wr, int wc, int fr, int fq) const {
        const int row0 = u.pm * BM + wr * 64 + fr, col0 = u.pn * BM + wc * 32 + 8 * fq;
#pragma unroll
        for (int ai = 0; ai < 2; ++ai)
#pragma unroll
            for (int m = 0; m < 4; ++m) { bf16_t* rowp = O + (size_t)(row0 + ai * HALF + m * 16) * ldc + col0;
#pragma unroll
                for (int bj = 0; bj < 2; ++bj) { f32x4 v0 = acc[ai][bj][m][0], v1 = acc[ai][bj][m][1];
                    if (ACT == 1) {
#pragma unroll
                        for (int e = 0; e < 4; ++e) { const float a = fmaxf(v0[e], 0.f), b = fmaxf(v1[e], 0.f); v0[e] = a * a; v1[e] = b * b; } }
                    bf16x8 w; w[0] = (bf16_t)v0[0]; w[1] = (bf16_t)v0[1]; w[2] = (bf16_t)v0[2]; w[3] = (bf16_t)v0[3]; w[4] = (bf16_t)v1[0]; w[5] = (bf16_t)v1[1]; w[6] = (bf16_t)v1[2]; w[7] = (bf16_t)v1[3];
                    *(bf16x8*)(rowp + bj * HALF) = w; } }
    }
};
template <class Epi, class Sched, bool ALIGN_EPI = false, bool SP2 = false>
__device__ __forceinline__ void gemm_phase(PG8_LAS unsigned char* lds, const Gemm g, const Sched& S, const Epi& E, const int tid) {
    const int  wid = __builtin_amdgcn_readfirstlane(tid >> 6), lane = tid & 63, wr = wid >> 2, wc = wid & 3, fr = lane & 15, fq = lane >> 4;
    const int K = g.K, nt = K / BK;
    unsigned voffA[2], voffB[2];
#pragma unroll
    for (int i = 0; i < 2; ++i) { int R, C; stage_rc(tid * 16 + i * 8192, R, C); const int Rb = Epi::PERM ? ((R & ~31) + perm32(R & 31)) : R;
        voffA[i] = (unsigned)(R * K + C) * 2u; voffB[i] = (unsigned)(Rb * K + C) * 2u; }
    const size_t kstep = (size_t)(BK * 2);
    const size_t hstep = (size_t)HALF * K * 2;
    const size_t tstep = 2 * hstep;
    const unsigned ldsw = (unsigned)wid * 1024u;
    const int aoff = lds_byte(wr * 64 + fr, fq * 8), boff = lds_byte(wc * 32 + fr, fq * 8);
#define PG8_SA(b, h) (((b) * 2 + (h)) * HTB)
#define PG8_SB(b, h) ((4 + (b) * 2 + (h)) * HTB)
#define PG8_STAGE(bufoff, gbase, voff) do { _Pragma("unroll") for (int _i = 0; _i < 2; ++_i) \
        __builtin_amdgcn_global_load_lds((const unsigned*)((const char*)(gbase) + (voff)[_i]), (PG8_LAS unsigned*)(lds + (bufoff) + ldsw + _i * 8192), 16, 0, 0); } while (0)
#define PG8_LDA(dst, b, h) do { _Pragma("unroll") for (int m = 0; m < 4; ++m) _Pragma("unroll") for (int k = 0; k < 2; ++k) dst[m][k] = *(const PG8_LAS bf16x8*)(lds + PG8_SA(b, h) + aoff + m * 2048 + k * 1024); } while (0)
#define PG8_LDB(dst, b, h) do { _Pragma("unroll") for (int n = 0; n < 2; ++n) _Pragma("unroll") for (int k = 0; k < 2; ++k) dst[n][k] = *(const PG8_LAS bf16x8*)(lds + PG8_SB(b, h) + boff + n * 2048 + k * 1024); } while (0)
#define PG8_MMA(ai, bj, At, Bt) do { __builtin_amdgcn_s_setprio(1); _Pragma("unroll") for (int m = 0; m < 4; ++m) _Pragma("unroll") for (int n = 0; n < 2; ++n) _Pragma("unroll") for (int k = 0; k < 2; ++k) \
        acc[ai][bj][m][n] = __builtin_amdgcn_mfma_f32_16x16x32_f16(Bt[n][k], At[m][k], acc[ai][bj][m][n], 0, 0, 0); __builtin_amdgcn_s_setprio(0); } while (0)
#define PG8_WAIT_V(n) asm volatile("s_waitcnt vmcnt(" #n ")" ::: "memory")
#define PG8_WAIT_L(n) asm volatile("s_waitcnt lgkmcnt(" #n ")" ::: "memory")
#define PG8_BAR __builtin_amdgcn_s_barrier()
#define PG8_SCHED __builtin_amdgcn_sched_barrier(0)
    Unit cur, nxt; int ui = 0;
    if (!S.next(0, cur)) return;
    f32x4 acc[2][2][4][2];
#pragma unroll
    for (int a = 0; a < 2; ++a)
#pragma unroll
        for (int b = 0; b < 2; ++b)
#pragma unroll
            for (int m = 0; m < 4; ++m)
#pragma unroll
                for (int n = 0; n < 2; ++n) acc[a][b][m][n] = (f32x4){0.f, 0.f, 0.f, 0.f};
    bf16x8 At[4][2], B0[2][2], B1[2][2];
    const char* cA = (const char*)g.A + (size_t)cur.pm * tstep; const char* cB = (const char*)g.Bt + (size_t)cur.pn * tstep;
    S.a_ready(cur);
    if constexpr (SP2) {
        PG8_STAGE(PG8_SB(0, 0), cB, voffB); PG8_STAGE(PG8_SB(0, 1), cB + hstep, voffB); PG8_STAGE(PG8_SA(0, 0), cA, voffA); PG8_STAGE(PG8_SA(0, 1), cA + hstep, voffA);
        if (wr == 1) PG8_BAR;
        PG8_WAIT_V(2); PG8_BAR;
        PG8_STAGE(PG8_SB(1, 0), cB + kstep, voffB); PG8_STAGE(PG8_SA(1, 0), cA + kstep, voffA); PG8_STAGE(PG8_SB(1, 1), cB + hstep + kstep, voffB);
        PG8_WAIT_V(6); PG8_BAR;
    } else {
        PG8_STAGE(PG8_SB(0, 0), cB, voffB); PG8_STAGE(PG8_SA(0, 0), cA, voffA); PG8_STAGE(PG8_SB(0, 1), cB + hstep, voffB); PG8_STAGE(PG8_SA(0, 1), cA + hstep, voffA);
        if (wr == 1) PG8_BAR;
        PG8_WAIT_V(4); PG8_BAR;
        PG8_STAGE(PG8_SB(1, 0), cB + kstep, voffB); PG8_STAGE(PG8_SA(1, 0), cA + kstep, voffA); PG8_STAGE(PG8_SB(1, 1), cB + hstep + kstep, voffB);
        PG8_WAIT_V(6); PG8_BAR;
    }
    for (;;) {
        const bool has_next = S.next(ui + 1, nxt);
        const char* nA = has_next ? (const char*)g.A + (size_t)nxt.pm * tstep : cA; const char* nB = has_next ? (const char*)g.Bt + (size_t)nxt.pn * tstep : cB;
        for (int t = 0; t < nt; t += 2) {
            const bool last = (t == nt - 2);
            const char* a1 = cA + (size_t)(t + 1) * kstep;
            const char* a2 = last ? nA : cA + (size_t)(t + 2) * kstep; const char* b2 = last ? nB : cB + (size_t)(t + 2) * kstep;
            const char* a3 = a2 + kstep; const char* b3 = b2 + kstep;
            if (last && has_next) S.a_ready(nxt);
            if constexpr (SP2) {
            PG8_LDB(B0, 0, 0); PG8_LDB(B1, 0, 1); PG8_SCHED; PG8_LDA(At, 0, 0); PG8_STAGE(PG8_SA(1, 1), a1 + hstep, voffA);
            PG8_WAIT_V(8); PG8_WAIT_L(0); PG8_BAR; PG8_MMA(0, 0, At, B0); PG8_MMA(0, 1, At, B1); PG8_BAR; PG8_SCHED;
            PG8_LDA(At, 0, 1); PG8_STAGE(PG8_SB(0, 0), b2, voffB); PG8_STAGE(PG8_SB(0, 1), b2 + hstep, voffB); PG8_STAGE(PG8_SA(0, 0), a2, voffA);
            PG8_WAIT_V(8); PG8_WAIT_L(0); PG8_BAR; PG8_MMA(1, 0, At, B0); PG8_MMA(1, 1, At, B1); PG8_BAR; PG8_SCHED;
            PG8_LDB(B0, 1, 0); PG8_LDB(B1, 1, 1); PG8_SCHED; PG8_LDA(At, 1, 0); PG8_STAGE(PG8_SA(0, 1), a2 + hstep, voffA);
            PG8_WAIT_V(8); PG8_WAIT_L(0); PG8_BAR; PG8_MMA(0, 0, At, B0); PG8_MMA(0, 1, At, B1); PG8_BAR; PG8_SCHED;
            PG8_LDA(At, 1, 1); PG8_STAGE(PG8_SB(1, 0), b3, voffB); PG8_STAGE(PG8_SB(1, 1), b3 + hstep, voffB); PG8_STAGE(PG8_SA(1, 0), a3, voffA);
            PG8_WAIT_V(8); PG8_WAIT_L(0); PG8_BAR; PG8_MMA(1, 0, At, B0); PG8_MMA(1, 1, At, B1); PG8_BAR; PG8_SCHED;
            } else {
            PG8_LDB(B0, 0, 0); PG8_SCHED; PG8_LDA(At, 0, 0); PG8_STAGE(PG8_SA(1, 1), a1 + hstep, voffA);
            PG8_WAIT_L(8); PG8_BAR; PG8_WAIT_L(0); PG8_MMA(0, 0, At, B0); PG8_BAR; PG8_SCHED;
            PG8_LDB(B1, 0, 1); PG8_STAGE(PG8_SB(0, 0), b2, voffB);
            PG8_BAR; PG8_WAIT_L(0); PG8_MMA(0, 1, At, B1); PG8_BAR;
            PG8_LDA(At, 0, 1); PG8_STAGE(PG8_SA(0, 0), a2, voffA);
            PG8_BAR; PG8_WAIT_L(0); PG8_MMA(1, 0, At, B0); PG8_BAR; PG8_SCHED;
            PG8_STAGE(PG8_SB(0, 1), b2 + hstep, voffB);
            PG8_WAIT_V(6); PG8_BAR; PG8_MMA(1, 1, At, B1); PG8_BAR;
            PG8_LDB(B0, 1, 0); PG8_SCHED; PG8_LDA(At, 1, 0); PG8_STAGE(PG8_SA(0, 1), a2 + hstep, voffA);
            PG8_WAIT_L(8); PG8_BAR; PG8_WAIT_L(0); PG8_MMA(0, 0, At, B0); PG8_BAR; PG8_SCHED;
            PG8_LDB(B1, 1, 1); PG8_STAGE(PG8_SB(1, 0), b3, voffB);
            PG8_BAR; PG8_WAIT_L(0); PG8_MMA(0, 1, At, B1); PG8_BAR;
            PG8_LDA(At, 1, 1); PG8_STAGE(PG8_SA(1, 0), a3, voffA);
            PG8_BAR; PG8_WAIT_L(0); PG8_MMA(1, 0, At, B0); PG8_BAR; PG8_SCHED;
            PG8_STAGE(PG8_SB(1, 1), b3 + hstep, voffB);
            PG8_WAIT_V(6); PG8_BAR; PG8_MMA(1, 1, At, B1); PG8_BAR;
            }
        }
        if constexpr (ALIGN_EPI) { if (wr == 0) PG8_BAR; }
        if constexpr (!Epi::AFTER_DRAIN) { E(acc, cur, wr, wc, fr, fq); S.done(cur); }
        if (!has_next) break;
#pragma unroll
        for (int a = 0; a < 2; ++a)
#pragma unroll
            for (int b = 0; b < 2; ++b)
#pragma unroll
                for (int m = 0; m < 4; ++m)
#pragma unroll
                    for (int n = 0; n < 2; ++n) acc[a][b][m][n] = (f32x4){0.f, 0.f, 0.f, 0.f};
        cur = nxt; cA = nA; cB = nB; ++ui;
        if constexpr (ALIGN_EPI) { if (wr == 1) PG8_BAR; }
    }
    PG8_WAIT_V(0);
    if constexpr (!ALIGN_EPI) { if (wr == 0) PG8_BAR; }
    PG8_BAR;
    if constexpr (Epi::AFTER_DRAIN) { E.fused(acc, cur, wr, wc, fr, fq, lds, wid, lane); S.done(cur); }
#undef PG8_SA
#undef PG8_SB
#undef PG8_STAGE
#undef PG8_LDA
#undef PG8_LDB
#undef PG8_MMA
#undef PG8_WAIT_V
#undef PG8_WAIT_L
#undef PG8_BAR
#undef PG8_SCHED
}
}

#define XB_TMO      128
#define XB_XCNT(j)  (256  + 64 * (j))
#define XB_XSUB(j)  (1280 + 64 * (j))
#define XB_XGEN(j)  (2304 + 64 * (j))
#define XB_TOP      3328
#define XB_TOPGEN   3392
#define XCD_BAR_WORDS 3456
#define XB_SPIN_CAP (1u << 18)

__device__ __forceinline__ unsigned xb_ld(unsigned* p)              { return __hip_atomic_load(p, __ATOMIC_RELAXED, __HIP_MEMORY_SCOPE_AGENT); }
__device__ __forceinline__ unsigned xb_add(unsigned* p, unsigned v) { return __hip_atomic_fetch_add(p, v, __ATOMIC_RELAXED, __HIP_MEMORY_SCOPE_AGENT); }
__device__ __forceinline__ unsigned xb_xcc_id() { return (unsigned)__builtin_amdgcn_s_getreg((3 << 11) | 20) & 0xFu; }
#define XB_SPIN(cond, bar) do { unsigned _sp = 0; while (cond) { __builtin_amdgcn_s_sleep(1); \
    if ((++_sp & 255u) == 0u) { if (xb_ld(&(bar)[XB_TMO])) break; if (_sp > XB_SPIN_CAP) { atomicAdd(&(bar)[XB_TMO], 1u); break; } } } } while (0)

struct XcdBarrier {
    unsigned* bar; unsigned x;
    volatile LAS unsigned* st;
};

__device__ __forceinline__ XcdBarrier xcd_barrier_post(unsigned* bar, volatile LAS unsigned* st) {
    XcdBarrier b; b.bar = bar; b.x = xb_xcc_id(); b.st = st;
    if (threadIdx.x == 0) (void)xb_add(&bar[XB_XCNT(b.x)], 1u);
    return b;
}
__device__ __forceinline__ void xcd_barrier_complete(unsigned* bar, unsigned x, unsigned& nloc, unsigned& nx) {
    const unsigned G = gridDim.x * gridDim.y * gridDim.z;
    unsigned sum, cnt, mine, sp = 0u;
    for (;;) {
        sum = 0u; cnt = 0u; mine = 0u;
#pragma unroll
        for (unsigned j = 0; j < 16; ++j) { const unsigned c = xb_ld(&bar[XB_XCNT(j)]); sum += c; cnt += (c > 0u) ? 1u : 0u; mine = (j == x) ? c : mine; }
        if (sum == G) break;
        __builtin_amdgcn_s_sleep(1);
        if ((++sp & 255u) == 0u) { if (xb_ld(&bar[XB_TMO])) break; if (sp > XB_SPIN_CAP) { atomicAdd(&bar[XB_TMO], 1u); break; } }
    }
    nloc = mine > 0u ? mine : 1u; nx = cnt > 0u ? cnt : 1u;
}

__device__ __forceinline__ void xcd_barrier(const XcdBarrier& b) {
    asm volatile("s_waitcnt vmcnt(0)" ::: "memory");
    __syncthreads();
    if (threadIdx.x == 0) {
        unsigned* bar = b.bar;
        __builtin_amdgcn_s_waitcnt(0);
        unsigned nloc = b.st[0], nx = b.st[1];
        if (nloc == 0u) { xcd_barrier_complete(bar, b.x, nloc, nx); b.st[0] = nloc; b.st[1] = nx; }
        const unsigned old = xb_add(&bar[XB_XSUB(b.x)], 1u);
        const unsigned gen = old / nloc;
        if (old + 1u == (gen + 1u) * nloc) {
            __builtin_amdgcn_fence(__ATOMIC_RELEASE, "agent");
            asm volatile("s_waitcnt vmcnt(0)" ::: "memory");
            const unsigned og = xb_add(&bar[XB_TOP], 1u);
            const unsigned tg = og / nx;
            if (og + 1u == (tg + 1u) * nx) xb_add(&bar[XB_TOPGEN], 1u);
            else XB_SPIN(xb_ld(&bar[XB_TOPGEN]) == tg, bar);
            __builtin_amdgcn_fence(__ATOMIC_ACQUIRE, "agent");
            xb_add(&bar[XB_XGEN(b.x)], 1u);
            asm volatile("s_waitcnt vmcnt(0)" ::: "memory");
        } else {
            XB_SPIN(xb_ld(&bar[XB_XGEN(b.x)]) == gen, bar);
            __builtin_amdgcn_fence(__ATOMIC_ACQUIRE, "agent");
            asm volatile("s_waitcnt vmcnt(0)" ::: "memory");
        }
    }
    __syncthreads();
}

constexpr int CW_BAR = 4096;
constexpr int LDS_MISC = LDS_BYTES - 256;
#define LAUNDER(v) asm volatile("" : "+s"(v))
__global__ void __launch_bounds__(NT, 2) k_mega(Ctx Carg) {
#if defined(__HIP_DEVICE_COMPILE__)
    extern __shared__ __attribute__((aligned(16))) unsigned char lds_raw[];
    LAS float* lds = (LAS float*)lds_raw;
    const int bid = blockIdx.x, nblk = gridDim.x;
    for (int u = threadIdx.x; u < 64; u += NT) ((LAS unsigned*)((LAS unsigned char*)lds_raw + LDS_MISC))[u] = 0u;
    __syncthreads();
    typedef const __attribute__((address_space(4))) Ctx* CtxCP;
    CtxCP Cp = (CtxCP)__builtin_amdgcn_kernarg_segment_ptr();
    const int wave_s = __builtin_amdgcn_readfirstlane(threadIdx.x >> 6);
    XcdBarrier bar = xcd_barrier_post((unsigned*)(Cp->ws + WS_CTL) + CW_BAR, (volatile LAS unsigned*)((LAS unsigned char*)lds_raw + LDS_MISC + 32));
#ifndef DUPMASK
#define DUPMASK 0
#endif
#ifndef PMASK
#define PMASK 0xFFFFF
#endif
#define SITE(k, ...) for (int rep_ = 0; rep_ < 1 + ((DUPMASK >> (k)) & 1); ++rep_) do { if (!((PMASK >> (k)) & 1)) break; CtxCP cp_ = Cp; LAUNDER(cp_); const Ctx C = *cp_; int ll = l; LAUNDER(ll); int wv_ = wave_s; LAUNDER(wv_); int tid_ = (wv_ << 6) | (int)__builtin_amdgcn_mbcnt_hi(~0u, __builtin_amdgcn_mbcnt_lo(~0u, 0u)); asm volatile("" : "+v"(tid_)); int bid_ = bid; LAUNDER(bid_); int nblk_ = nblk; LAUNDER(nblk_); \
        f16* H = (f16*)(C.ws + WS_H); f16* Zb = (f16*)(C.ws + WS_Z); f16* MIX = (f16*)(C.ws + WS_MIX); f16* Y = (f16*)(C.ws + WS_Y); f16* U = (f16*)(C.ws + WS_BIG); \
        (void)H; (void)Zb; (void)MIX; (void)Y; (void)U; __VA_ARGS__; } while (0); { XcdBarrier b_ = bar; LAUNDER(b_.x); LAUNDER(b_.bar); xcd_barrier(b_); }
    int l = 0;
    SITE(0, ph_mod(C, tid_, bid_, nblk_, lds); __syncthreads(); ph_rope(C, tid_, bid_, nblk_); ph_wcvt(C, tid_, bid_, nblk_, lds));
    SITE(1, ph_norm0(C, tid_, bid_, nblk_));
    for (l = 0; l < DEPTH; ++l) {
        SITE(2, { pg8::Gemm g{H, (const f16*)(C.ws + WS_W16 + (size_t)ll * W16_LAYER + W16_WIN), M, ZP, D}; pg8::StaticOrder S; S.init(M, ZP, nblk_, bid_); pg8::EpiF16<0> E{Zb, ZP}; pg8::gemm_phase<pg8::EpiF16<0>, pg8::StaticOrder, true, true>((LAS unsigned char*)lds, g, S, E, tid_); });
        SITE(3, ph_conv(C, ll, tid_, bid_, nblk_); ph_rotk(C, tid_, bid_, nblk_); ph_cmp1(C, ll, tid_, bid_, nblk_); ph_gla1(C, ll, tid_, bid_, nblk_); ph_gmlp(C, ll, tid_, bid_, nblk_, (LAS unsigned char*)lds));
        SITE(4, ph_cmp2(C, ll, tid_, bid_, nblk_, lds); ph_gla2(C, tid_, bid_, nblk_));
        SITE(5, ph_nsa(C, ll, tid_, bid_, nblk_, lds); __syncthreads(); ph_gla3(C, tid_, bid_, nblk_, lds));
        SITE(6, ph_gla4(C, tid_, bid_, nblk_));
        SITE(7, ph_gla5(C, ll, tid_, bid_, nblk_));
        SITE(8, { pg8::Gemm g{MIX, (const f16*)(C.ws + WS_W16 + (size_t)ll * W16_LAYER + W16_WO), M, D, D}; pg8::StaticOrder S; S.init(M, D, nblk_, bid_); pg8::EpiF16<0> E{Y, D}; pg8::gemm_phase<pg8::EpiF16<0>, pg8::StaticOrder, true, true>((LAS unsigned char*)lds, g, S, E, tid_); });
        SITE(9, ph_resnorm(C, ll, 0, tid_, bid_, nblk_));
        SITE(10, { pg8::Gemm g{H, (const f16*)(C.ws + WS_W16 + (size_t)ll * W16_LAYER + W16_WUP), M, DFF, D}; pg8::StaticOrder S; S.init(M, DFF, nblk_, bid_); pg8::EpiF16<1> E{U, DFF}; pg8::gemm_phase<pg8::EpiF16<1>, pg8::StaticOrder, true, true>((LAS unsigned char*)lds, g, S, E, tid_); });
        SITE(11, { pg8::Gemm g{U, (const f16*)(C.ws + WS_W16 + (size_t)ll * W16_LAYER + W16_WDN), M, D, DFF}; pg8::StaticOrder S; S.init(M, D, nblk_, bid_); pg8::EpiF16<0> E{Y, D}; pg8::gemm_phase<pg8::EpiF16<0>, pg8::StaticOrder, true, true>((LAS unsigned char*)lds, g, S, E, tid_); });
        SITE(12, ph_resnorm(C, ll, 1, tid_, bid_, nblk_));
    }
#undef SITE
#endif
}

extern "C" void kernel_launch(void* const* d_in, const int* in_sizes, int n_in, void* d_out, int out_size, void* d_ws, size_t ws_size, hipStream_t stream) {
    static int grid = 0;
    if (grid == 0) {
        if (n_in != 19 || ws_size < WS_END) { fprintf(stderr, "kernel_launch: unexpected n_in %d / ws_size %zu\n", n_in, ws_size); grid = -1; return; }
        int dev = 0, cus = 0, per_cu = 0;
        if (hipGetDevice(&dev) != hipSuccess || hipDeviceGetAttribute(&cus, hipDeviceAttributeMultiprocessorCount, dev) != hipSuccess) { grid = -1; return; }
        if (hipFuncSetAttribute((const void*)k_mega, hipFuncAttributeMaxDynamicSharedMemorySize, LDS_BYTES) != hipSuccess) { fprintf(stderr, "hipFuncSetAttribute failed\n"); grid = -1; return; }
        if (hipOccupancyMaxActiveBlocksPerMultiprocessor(&per_cu, (const void*)k_mega, NT, LDS_BYTES) != hipSuccess || per_cu < 1) { fprintf(stderr, "occupancy query: %d\n", per_cu); }
        (void)hipGetLastError();
        grid = cus;
    }
    if (grid < 0) return;
    if (hipMemsetAsync((char*)d_ws + WS_CTL, 0, 1 * MiB, stream) != hipSuccess) return;
    Ctx c{};
    for (int i = 0; i < 19; ++i) c.in[i] = (const float*)d_in[i];
    c.out = (float*)d_out; c.ws = (unsigned char*)d_ws;
    hipLaunchKernelGGL(k_mega, dim3(grid), dim3(NT), LDS_BYTES, stream, c);
}
```

```cpp
#include <hip/hip_runtime.h>
#include <cstdint>
#include <cstdio>

#define LAS __attribute__((address_space(3)))
typedef _Float16 f16;
typedef f16 f16x4 __attribute__((ext_vector_type(4)));
typedef f16 f16x8 __attribute__((ext_vector_type(8)));
typedef float f32x4 __attribute__((ext_vector_type(4)));

constexpr int D = 1024, NB = 8, S = 4096, DEPTH = 4, M = NB * S, DFF = 4096;
constexpr int NIN = 2716, ZP = 2816;
constexpr int ZC_AH = 0, ZC_AB = 256, ZC_AC = 512, ZC_NQ = 768, ZC_KCMP = 1024, ZC_VCMP = 1088, ZC_KSLC = 1152, ZC_VSLC = 1216,
              ZC_KWIN = 1280, ZC_VWIN = 1344, ZC_NG = 1408, ZC_LQ = 1424, ZC_LK = 1552, ZC_LV = 1680, ZC_LG = 1936, ZC_LR = 2192,
              ZC_MU = 2208, ZC_MV = 2464;
constexpr int NCMP = 255;
constexpr float EPS = 1e-6f;
constexpr int NT = 512, NWAVE = 8;

constexpr size_t MiB = 1u << 20;
constexpr size_t WS_CTL = 0;
constexpr size_t WS_MOD = 1 * MiB;
constexpr size_t WS_ROPE = 2 * MiB;
constexpr size_t WS_W16 = 4 * MiB;
constexpr size_t WS_H = 98 * MiB;
constexpr size_t WS_Y = 162 * MiB;
constexpr size_t WS_BIG = 226 * MiB;
constexpr size_t WS_Z = WS_BIG;
constexpr size_t WS_MIX = WS_BIG + 176 * MiB;
constexpr size_t WS_KSR = WS_BIG + 240 * MiB;
constexpr size_t WS_KWR = WS_BIG + 244 * MiB;
constexpr size_t WS_HID = WS_BIG + 248 * MiB;
constexpr size_t WS_KC = WS_BIG + 251 * MiB;
constexpr size_t WS_VC = WS_BIG + 252 * MiB;
constexpr size_t WS_KC16 = WS_KC + 768 * 1024, WS_VC16 = WS_VC + 768 * 1024;
constexpr size_t WS_W1T = 498 * MiB;
constexpr size_t WS_WS16 = 502 * MiB;
constexpr size_t WS_PCB = 502 * MiB + 512 * 1024;
constexpr size_t WS_G = 503 * MiB;
constexpr size_t WS_END = 507 * MiB;
constexpr size_t WS_LA = WS_H;
constexpr size_t WS_QE2 = WS_H + 16 * MiB;
constexpr size_t WS_OI = WS_H + 32 * MiB;
constexpr size_t WS_KV = WS_Y;
constexpr size_t WS_SPREV = WS_Y + 16 * MiB;
constexpr size_t WS_VN = WS_Y + 32 * MiB;

constexpr size_t W16_WIN = 0, W16_WO = (size_t)ZP * D * 2, W16_WUP = W16_WO + (size_t)D * D * 2, W16_WDN = W16_WUP + (size_t)DFF * D * 2, W16_LAYER = W16_WDN + (size_t)D * DFF * 2;
static_assert(WS_W16 + DEPTH * W16_LAYER <= WS_H, "weight copies fit below H");

constexpr int LDS_BYTES = 147456;

struct Ctx {
    const float* in[19];
    float* out;
    unsigned char* ws;
    int lo, hi;
};

__device__ __forceinline__ float wave_sum(float v) {
#pragma unroll
    for (int o = 32; o > 0; o >>= 1) v += __shfl_xor(v, o);
    return v;
}
__device__ __forceinline__ float wave_max(float v) {
#pragma unroll
    for (int o = 32; o > 0; o >>= 1) v = fmaxf(v, __shfl_xor(v, o));
    return v;
}
#define WAVE_LDS_SYNC() asm volatile("s_waitcnt lgkmcnt(0)" ::: "memory")
__device__ __forceinline__ float siluf(float v) { return v / (1.f + expf(-v)); }
__device__ __forceinline__ float sigmoidf_(float v) { return 1.f / (1.f + expf(-v)); }

typedef float f32x16 __attribute__((ext_vector_type(16)));
typedef short s16x4 __attribute__((ext_vector_type(4)));
typedef unsigned u32x4 __attribute__((ext_vector_type(4)));
__device__ __forceinline__ int crow(int r, int hi) { return (r & 3) + 8 * (r >> 2) + 4 * hi; }
__device__ __forceinline__ float pl32_max(float v) { auto rr = __builtin_amdgcn_permlane32_swap(__float_as_uint(v), __float_as_uint(v), false, false); return fmaxf(__uint_as_float(rr[0]), __uint_as_float(rr[1])); }
__device__ __forceinline__ float pl32_sum(float v) { auto rr = __builtin_amdgcn_permlane32_swap(__float_as_uint(v), __float_as_uint(v), false, false); return __uint_as_float(rr[0]) + __uint_as_float(rr[1]); }
__device__ __forceinline__ unsigned pl32_other(unsigned v, int hi) { auto rr = __builtin_amdgcn_permlane32_swap(v, v, false, false); return hi ? rr[0] : rr[1]; }
__device__ __forceinline__ s16x4 vtr(const LAS unsigned char* p) { return __builtin_bit_cast(s16x4, __builtin_amdgcn_ds_read_tr16_b64_v4i16((LAS s16x4*)p)); }
__device__ __forceinline__ void sincos_d(double a, double& s, double& c) {
    const double two_over_pi = 0.63661977236758134308, pio2_hi = 1.57079632679489655800e+00, pio2_lo = 6.12323399573676603587e-17;
    const double kq = rint(a * two_over_pi);
    double r = (a - kq * pio2_hi) - kq * pio2_lo;
    const double r2 = r * r;
    double sp = r * (1.0 + r2 * (-1.0 / 6 + r2 * (1.0 / 120 + r2 * (-1.0 / 5040 + r2 * (1.0 / 362880 + r2 * (-1.0 / 39916800 + r2 * (1.0 / 6227020800.0 + r2 * (-1.0 / 1307674368000.0))))))));
    double cp = 1.0 + r2 * (-0.5 + r2 * (1.0 / 24 + r2 * (-1.0 / 720 + r2 * (1.0 / 40320 + r2 * (-1.0 / 3628800 + r2 * (1.0 / 479001600.0 + r2 * (-1.0 / 87178291200.0 + r2 * (1.0 / 20922789888000.0))))))));
    const int q = ((int)kq) & 3;
    if (q == 0) { s = sp; c = cp; } else if (q == 1) { s = cp; c = -sp; } else if (q == 2) { s = -sp; c = -cp; } else { s = -cp; c = sp; }
}

__device__ __forceinline__ void ph_mod(const Ctx& C, int TID, int bid, int nblk, LAS float* lds) {
    const float* c = C.in[1]; const float* w_mod = C.in[15]; const float* b_mod = C.in[16];
    float* MOD = (float*)(C.ws + WS_MOD);
    LAS float* cs = lds;
    LAS float* red = lds + 8192;
    const int tid = TID, nn = tid & 63, kg = tid >> 6;
    __syncthreads();
    for (int idx = tid; idx < NB * D; idx += NT) cs[idx] = siluf(c[idx]);
    __syncthreads();
    for (int item = bid; item < DEPTH * (6 * D / 64); item += nblk) {
        const int l = item / (6 * D / 64), n = (item % (6 * D / 64)) * 64 + nn;
        const float* w = w_mod + (size_t)l * D * 6 * D + n;
        float acc[8];
#pragma unroll
        for (int b = 0; b < 8; ++b) acc[b] = 0.f;
        for (int k0 = kg * 128; k0 < kg * 128 + 128; k0 += 16) {
            float wv[16];
#pragma unroll
            for (int i = 0; i < 16; ++i) wv[i] = w[(size_t)(k0 + i) * 6 * D];
#pragma unroll
            for (int i = 0; i < 16; ++i)
#pragma unroll
                for (int b = 0; b < 8; ++b) acc[b] += cs[b * D + k0 + i] * wv[i];
        }
#pragma unroll
        for (int b = 0; b < 8; ++b) red[(kg * 8 + b) * 64 + nn] = acc[b];
        __syncthreads();
        { const int b = tid >> 6; float s = b_mod[l * 6 * D + n];
#pragma unroll
          for (int g = 0; g < 8; ++g) s += red[(g * 8 + b) * 64 + nn];
          MOD[(size_t)(l * NB + b) * 6 * D + n] = s; }
        __syncthreads();
    }
}
__device__ __forceinline__ void ph_rope(const Ctx& C, int TID, int bid, int nblk) {
    const int* pos = (const int*)C.in[2];
    float* RC = (float*)(C.ws + WS_ROPE); float* RS = RC + (size_t)M * 8;
    const double invf[8] = {1.0, 0.19392274474868576, 0.03760603093086393, 0.007292664737217109, 0.001414213562373095, 0.0002742481756762073, 5.318295896944988e-05, 1.031338537721246e-05};
    for (int idx = bid * NT + TID; idx < M * 8; idx += nblk * NT) {
        const int i = idx & 7, m = idx >> 3;
        double f = invf[0];
#pragma unroll
        for (int j = 1; j < 8; ++j) f = (i == j) ? invf[j] : f;
        double s, c; sincos_d((double)pos[m] * f, s, c);
        RC[idx] = (float)c; RS[idx] = (float)s;
    }
}
__device__ __forceinline__ void adaln_row(const float (&xv)[16], const float* g, const float* sc, const float* sh, f16* hrow, int lane) {
    float ss = 0.f;
#pragma unroll
    for (int j = 0; j < 16; ++j) ss += xv[j] * xv[j];
    const float r = rsqrtf(wave_sum(ss) * (1.f / D) + EPS);
#pragma unroll
    for (int j = 0; j < 4; ++j) {
        const int c0 = 256 * j + 4 * lane;
        const f32x4 gv = *(const f32x4*)(g + c0), scv = *(const f32x4*)(sc + c0), shv = *(const f32x4*)(sh + c0);
        f16x4 o;
#pragma unroll
        for (int e = 0; e < 4; ++e) o[e] = (f16)(xv[4 * j + e] * r * gv[e] * (1.f + scv[e]) + shv[e]);
        *(f16x4*)(hrow + c0) = o;
    }
}
__device__ __forceinline__ void ph_norm0(const Ctx& C, int TID, int bid, int nblk) {
    const float* x = C.in[0]; const float* norm_g = C.in[14]; const float* MOD = (const float*)(C.ws + WS_MOD);
    f16* H = (f16*)(C.ws + WS_H);
    const int lane = TID & 63, gw = bid * NWAVE + (TID >> 6), ngw = nblk * NWAVE;
    for (int m = gw; m < M; m += ngw) {
        const int b = m / S;
        float xv[16];
#pragma unroll
        for (int j = 0; j < 4; ++j) { const f32x4 v = *(const f32x4*)(x + (size_t)m * D + 256 * j + 4 * lane); xv[4 * j] = v[0]; xv[4 * j + 1] = v[1]; xv[4 * j + 2] = v[2]; xv[4 * j + 3] = v[3]; }
        const float* mod = MOD + (size_t)(0 * NB + b) * 6 * D;
        adaln_row(xv, norm_g + 0, mod + D, mod + 0, H + (size_t)m * D, lane);
    }
}
__device__ __forceinline__ void ph_resnorm(const Ctx& C, int l, int sub, int TID, int bid, int nblk) {
    const float* norm_g = C.in[14]; const float* MOD = (const float*)(C.ws + WS_MOD);
    const f16* Y = (const f16*)(C.ws + WS_Y); f16* H = (f16*)(C.ws + WS_H);
    const float* xsrc = (l == 0 && sub == 0) ? C.in[0] : C.out;
    const float* ga = norm_g + (size_t)(l * 4 + (sub == 0 ? 1 : 3)) * D;
    const bool has_next = !(l == DEPTH - 1 && sub == 1);
    const int ln = sub == 0 ? l : l + 1;
    const float* gb = norm_g + (size_t)((has_next ? ln : 0) * 4 + (sub == 0 ? 2 : 0)) * D;
    const int lane = TID & 63, gw = bid * NWAVE + (TID >> 6), ngw = nblk * NWAVE;
    for (int m = gw; m < M; m += ngw) {
        const int b = m / S;
        const float* mod = MOD + (size_t)(l * NB + b) * 6 * D;
        const float* gt = mod + (sub == 0 ? 2 : 5) * D;
        float yv[16], xv[16]; float ss = 0.f;
#pragma unroll
        for (int j = 0; j < 4; ++j) {
            const f16x4 v = *(const f16x4*)(Y + (size_t)m * D + 256 * j + 4 * lane);
#pragma unroll
            for (int e = 0; e < 4; ++e) { yv[4 * j + e] = (float)v[e]; ss += yv[4 * j + e] * yv[4 * j + e]; }
        }
        const float r = rsqrtf(wave_sum(ss) * (1.f / D) + EPS);
#pragma unroll
        for (int j = 0; j < 4; ++j) {
            const int c0 = 256 * j + 4 * lane;
            const f32x4 xo = *(const f32x4*)(xsrc + (size_t)m * D + c0), gav = *(const f32x4*)(ga + c0), gtv = *(const f32x4*)(gt + c0);
            f32x4 xn;
#pragma unroll
            for (int e = 0; e < 4; ++e) { xn[e] = xo[e] + gtv[e] * (yv[4 * j + e] * r * gav[e]); xv[4 * j + e] = xn[e]; }
            *(f32x4*)(C.out + (size_t)m * D + c0) = xn;
        }
        if (has_next) {
            const float* modn = MOD + (size_t)(ln * NB + b) * 6 * D;
            adaln_row(xv, gb, modn + (sub == 0 ? 4 : 1) * D, modn + (sub == 0 ? 3 : 0) * D, H + (size_t)m * D, lane);
        }
    }
}

__device__ __forceinline__ void ph_conv(const Ctx& C, int l, int TID, int bid, int nblk) {
    const f16* Z = (const f16*)(C.ws + WS_Z); f16* MIX = (f16*)(C.ws + WS_MIX);
    const float* cw = C.in[4] + (size_t)l * 3 * 256; const float* gain = C.in[12] + (size_t)l * D;
    const int lane = TID & 63, gw = bid * NWAVE + (TID >> 6), ngw = nblk * NWAVE;
    for (int m = gw; m < M; m += ngw) {
        const int t = m % S;
        float o[4]; float ss = 0.f;
#pragma unroll
        for (int j = 0; j < 4; ++j) {
            const int ch = lane + 64 * j; float y = 0.f;
#pragma unroll
            for (int k = 0; k < 3; ++k) {
                const int tt = t - 2 + k;
                if (tt >= 0) { const f16* zr = Z + (size_t)(m - 2 + k) * ZP; y += (float)zr[ZC_AC + ch] * (float)zr[ZC_AH + ch] * cw[k * 256 + ch]; }
            }
            o[j] = (float)Z[(size_t)m * ZP + ZC_AB + ch] * y; ss += o[j] * o[j];
        }
        const float r = rsqrtf(wave_sum(ss) * (1.f / 256) + EPS);
#pragma unroll
        for (int j = 0; j < 4; ++j) { const int ch = lane + 64 * j; MIX[(size_t)m * D + ch] = (f16)(o[j] * r * gain[ch]); }
    }
}
__device__ __forceinline__ void ph_rotk(const Ctx& C, int TID, int bid, int nblk) {
    const f16* Z = (const f16*)(C.ws + WS_Z); f16* KSR = (f16*)(C.ws + WS_KSR); f16* KWR = (f16*)(C.ws + WS_KWR);
    const float* RC = (const float*)(C.ws + WS_ROPE); const float* RS = RC + (size_t)M * 8;
    for (int idx = bid * NT + TID; idx < M * 128; idx += nblk * NT) {
        const int d = idx & 63, which = (idx >> 6) & 1, m = idx >> 7;
        const f16* zr = Z + (size_t)m * ZP + (which ? ZC_KWIN : ZC_KSLC);
        float v = (float)zr[d];
        if (d < 16) { const int i = d & 7; const float cs = RC[m * 8 + i], sn = RS[m * 8 + i];
            if (d < 8) v = v * cs - (float)zr[d + 8] * sn; else v = v * cs + (float)zr[d - 8] * sn; }
        (which ? KWR : KSR)[(size_t)m * 64 + d] = (f16)v;
    }
}
__device__ __forceinline__ void ph_cmp1(const Ctx& C, int l, int TID, int bid, int nblk) {
    const f16* Z = (const f16*)(C.ws + WS_Z); float* G = (float*)(C.ws + WS_G);
    const f16* W1T = (const f16*)(C.ws + WS_W1T) + (size_t)l * 2 * 256 * 1024;
    const int lane = TID & 63, r32 = lane & 31, hi = lane >> 5, gw = bid * NWAVE + (TID >> 6), ngw = nblk * NWAVE;
    for (int it = gw; it < 2 * 64 * 8; it += ngw) {
        const int ct = it & 7, rt = (it >> 3) & 63, j = it >> 9;
        const int row = rt * 32 + r32;
        const f16* ap = Z + ((size_t)(row >> 8) * S + 16 * (row & 255)) * ZP + (j ? ZC_VCMP : ZC_KCMP) + 8 * hi;
        const f16* bp = W1T + ((size_t)j * 256 + ct * 32 + r32) * 1024 + 8 * hi;
        f32x16 acc;
#pragma unroll
        for (int r = 0; r < 16; ++r) acc[r] = 0.f;
        for (int k8 = 0; k8 < 64; k8 += 8) {
            f16x8 av[8], bv[8];
#pragma unroll
            for (int i = 0; i < 8; ++i) { const int ks = k8 + i; av[i] = *(const f16x8*)(ap + (size_t)(ks >> 2) * ZP + (ks & 3) * 16); bv[i] = *(const f16x8*)(bp + ks * 16); }
#pragma unroll
            for (int i = 0; i < 8; ++i) acc = __builtin_amdgcn_mfma_f32_32x32x16_f16(av[i], bv[i], acc, 0, 0, 0);
        }
        float* gp = G + ((size_t)j * 2048 + rt * 32) * 256 + ct * 32 + r32;
#pragma unroll
        for (int r = 0; r < 16; ++r) gp[(size_t)crow(r, hi) * 256] = acc[r];
    }
}
__device__ __forceinline__ void ph_cmp2(const Ctx& C, int l, int TID, int bid, int nblk, LAS float* lds) {
    const float* G = (const float*)(C.ws + WS_G); const float* PCB = (const float*)(C.ws + WS_PCB) + (size_t)l * 2 * 32 * 128;
    float* KC = (float*)(C.ws + WS_KC); float* VC = (float*)(C.ws + WS_VC);
    const float* w2 = C.in[7] + (size_t)l * 2 * 128 * 64;
    LAS float* w2s = lds;
    LAS float* cbs = lds + 16384;
    LAS float* hs = lds + 16640 + (TID >> 6) * 128;
    const int tid = TID, lane = tid & 63, gw = bid * NWAVE + (tid >> 6), ngw = nblk * NWAVE;
    __syncthreads();
    for (int idx = tid; idx < 2 * 128 * 64; idx += NT) w2s[idx] = w2[idx];
    if (tid < 256) { float s = 0.f; for (int q = 0; q < 32; ++q) s += PCB[((tid >> 7) * 32 + q) * 128 + (tid & 127)]; cbs[tid] = s; }
    __syncthreads();
    for (int it = gw; it < 2 * NB * NCMP; it += ngw) {
        const int j = it / (NB * NCMP), bi = it % (NB * NCMP), b = bi / NCMP, i = bi % NCMP;
        const float* g0 = G + ((size_t)j * 2048 + b * 256 + i) * 256;
#pragma unroll
        for (int q = 0; q < 2; ++q) { const int o = lane + 64 * q; hs[o] = siluf(g0[o] + g0[256 + 128 + o] + cbs[j * 128 + o]); }
        WAVE_LDS_SYNC();
        float acc = 0.f;
#pragma unroll 16
        for (int o = 0; o < 128; ++o) acc += hs[o] * w2s[(j * 128 + o) * 64 + lane];
        (j ? VC : KC)[(size_t)bi * 64 + lane] = acc;
        ((f16*)(C.ws + (j ? WS_VC16 : WS_KC16)))[((size_t)b * 256 + i) * 64 + lane] = (f16)acc;
        WAVE_LDS_SYNC();
    }
    for (int it = gw; it < 2 * NB; it += ngw) ((f16*)(C.ws + ((it & 1) ? WS_VC16 : WS_KC16)))[((size_t)(it >> 1) * 256 + 255) * 64 + lane] = (f16)0.f;
}
constexpr float NSA_C2 = 0.125f * 1.4426950408889634f;

#define NSA_ISSUE(Kg, Vg, vpitch, jt, koff, voff) do { \
        int ln_ = lane; asm volatile("" : "+v"(ln_)); \
        const f16* ksrc_ = (Kg) + (size_t)(64 * (jt) + ln_) * 64 + wid * 8; \
        const f16* vsrc_ = (Vg) + (size_t)(64 * (jt) + 16 * (wid & 3) + (ln_ >> 2)) * (vpitch) + (wid >> 2) * 32 + (ln_ & 3) * 8; \
        __builtin_amdgcn_global_load_lds((const unsigned*)ksrc_, (LAS unsigned*)(lds + (koff) + wid * 1024), 16, 0, 0); \
        __builtin_amdgcn_global_load_lds((const unsigned*)vsrc_, (LAS unsigned*)(lds + (voff) + wid * 1024), 16, 0, 0); } while (0)
#define NSA_QKT(p0, p1, kb, qf) do { \
        _Pragma("unroll") for (int r_ = 0; r_ < 16; ++r_) { p0[r_] = 0.f; p1[r_] = 0.f; } \
        _Pragma("unroll") for (int d0_ = 0; d0_ < 4; ++d0_) { \
            const f16x8 k0_ = *(const LAS f16x8*)((kb) + d0_ * 2048), k1_ = *(const LAS f16x8*)((kb) + d0_ * 2048 + 512); \
            p0 = __builtin_amdgcn_mfma_f32_32x32x16_f16(k0_, qf[d0_], p0, 0, 0, 0); \
            p1 = __builtin_amdgcn_mfma_f32_32x32x16_f16(k1_, qf[d0_], p1, 0, 0, 0); } } while (0)
#define NSA_PV(o, p0, p1, vs) do { \
        f16x8 pa_[4]; \
        _Pragma("unroll") for (int e_ = 0; e_ < 8; ++e_) { pa_[0][e_] = (f16)p0[e_]; pa_[1][e_] = (f16)p0[8 + e_]; pa_[2][e_] = (f16)p1[e_]; pa_[3][e_] = (f16)p1[8 + e_]; } \
        _Pragma("unroll") for (int d0_ = 0; d0_ < 2; ++d0_) \
            _Pragma("unroll") for (int ks_ = 0; ks_ < 4; ++ks_) { \
                const s16x4 lo_ = vtr((vs) + d0_ * 4096 + ks_ * 1024), hh_ = vtr((vs) + d0_ * 4096 + ks_ * 1024 + 512); \
                const s16x8 bv_ = {lo_[0], lo_[1], lo_[2], lo_[3], hh_[0], hh_[1], hh_[2], hh_[3]}; \
                o[d0_] = __builtin_amdgcn_mfma_f32_32x32x16_f16(pa_[ks_], __builtin_bit_cast(f16x8, bv_), o[d0_], 0, 0, 0); } } while (0)
typedef short s16x8 __attribute__((ext_vector_type(8)));

template <int MODE>
__device__ __forceinline__ void nsa_branch(const f16* Kg, const f16* Vg, int c, unsigned long long sel, int tokw, const f16x8 (&qf)[4], f32x16 (&o)[2], float& lsum,
                                           LAS unsigned char* lds, LAS float* wsf, int wid, int lane, int r32, int hi) {
    const float NEG = -__builtin_inff();
    float m = NEG; lsum = 0.f;
#pragma unroll
    for (int r = 0; r < 16; ++r) { o[0][r] = 0.f; o[1][r] = 0.f; }
    const int ntiles = MODE == 0 ? c + 1 : (c < 8 ? c + 1 : 9);
    const LAS unsigned char* vlane = lds + 16384 + ((lane >> 4) & 1) * 32 + (lane & 3) * 8 + (4 * hi + ((lane & 15) >> 2)) * 64;
    NSA_ISSUE(Kg, Vg, ZP, (MODE == 0 ? 0 : c), 0, 16384);
    for (int i = 0; i < ntiles; ++i) {
        const int j = MODE == 0 ? i : c - i, slot = i & 1;
        asm volatile("s_waitcnt vmcnt(0)" ::: "memory");
        __syncthreads();
        if (i + 1 < ntiles) { const int jn = MODE == 0 ? i + 1 : c - i - 1; NSA_ISSUE(Kg, Vg, ZP, jn, (slot ^ 1) * 8192, 16384 + (slot ^ 1) * 8192); }
        f32x16 p0, p1;
        const LAS unsigned char* kb = lds + slot * 8192 + hi * 1024 + r32 * 16;
        NSA_QKT(p0, p1, kb, qf);
        if (j == c) {
#pragma unroll
            for (int r = 0; r < 16; ++r) { const int kk = crow(r, hi); if (kk > tokw) p0[r] = NEG; if (kk + 32 > tokw) p1[r] = NEG; }
        }
        if (MODE == 1 && j == c - 8) {
#pragma unroll
            for (int r = 0; r < 16; ++r) { const int kk = crow(r, hi); if (kk <= tokw) p0[r] = NEG; if (kk + 32 <= tokw) p1[r] = NEG; }
        }
        const bool rowsel = MODE == 0 ? ((sel >> j) & 1ull) != 0ull : true;
        float rm = fmaxf(p0[0], p1[0]);
#pragma unroll
        for (int r = 1; r < 16; ++r) rm = fmaxf(rm, fmaxf(p0[r], p1[r]));
        rm = pl32_max(rm);
        rm = rowsel ? rm : NEG;
        const float mnew = fmaxf(m, rm);
        const float corr = __builtin_amdgcn_exp2f(m - mnew);
        const float msub = rowsel ? mnew : __builtin_inff();
        float ps = 0.f;
#pragma unroll
        for (int r = 0; r < 16; ++r) { p0[r] = __builtin_amdgcn_exp2f(p0[r] - msub); p1[r] = __builtin_amdgcn_exp2f(p1[r] - msub); ps += p0[r] + p1[r]; }
        lsum = lsum * corr + ps; m = mnew;
        if (__any(corr != 1.0f)) {
            if (hi == 0) wsf[r32] = corr;
            WAVE_LDS_SYNC();
#pragma unroll
            for (int r = 0; r < 16; ++r) { const float f = wsf[crow(r, hi)]; o[0][r] *= f; o[1][r] *= f; }
            WAVE_LDS_SYNC();
        }
        const LAS unsigned char* vs = vlane + slot * 8192;
        NSA_PV(o, p0, p1, vs);
    }
    __syncthreads();
}

constexpr int NSA_WS_OFF = 65536;
__device__ __forceinline__ void nsa_unit(const Ctx& C, int l, int b, int c, int TID, LAS unsigned char* lds) {
    const f16* Z = (const f16*)(C.ws + WS_Z); f16* MIX = (f16*)(C.ws + WS_MIX);
    const f16* KSR = (const f16*)(C.ws + WS_KSR); const f16* KWR = (const f16*)(C.ws + WS_KWR);
    const f16* KC16 = (const f16*)(C.ws + WS_KC16) + (size_t)b * 256 * 64; const f16* VC16 = (const f16*)(C.ws + WS_VC16) + (size_t)b * 256 * 64;
    const float* RC = (const float*)(C.ws + WS_ROPE); const float* RS = RC + (size_t)M * 8;
    const float* gain = C.in[12] + (size_t)l * D + 256;
    const int tid = TID, lane = tid & 63, wid = __builtin_amdgcn_readfirstlane(tid >> 6), r32 = lane & 31, hi = lane >> 5;
    const size_t m0 = (size_t)b * S + 64 * c;
    const int tokw = 8 * wid + (r32 >> 2), head = r32 & 3;
    const size_t mrow = m0 + tokw;
#define ZROW() ({ size_t mr_ = mrow; asm volatile("" : "+v"(mr_)); Z + mr_ * ZP; })
    const float NEG = -__builtin_inff();
    LAS float* wsb = (LAS float*)(lds + NSA_WS_OFF) + wid * 1280;
    LAS float* wsf = wsb; LAS float* Aa = wsb + 64; LAS float* Bb = wsb + 576; LAS float* Ssc = wsb + 1100; LAS unsigned long long* SELW = (LAS unsigned long long*)(wsb + 1168);
    f32x16 tot[2], o[2];
    unsigned long long sel;
    {
        f16x8 qc[4];
#pragma unroll
        for (int d0 = 0; d0 < 4; ++d0) { const f16x8 qv = *(const f16x8*)(ZROW() + ZC_NQ + 64 * head + 16 * d0 + 8 * hi);
#pragma unroll
            for (int i = 0; i < 8; ++i) qc[d0][i] = (f16)((float)qv[i] * NSA_C2); }
        const int nct = (4 * c + 3 + 63) >> 6;
        for (int T = 0; T < nct; ++T) NSA_ISSUE(KC16, VC16, 64, T, T * 8192, 32768 + T * 8192);
        for (int i = lane; i < 1036; i += 64) Aa[i] = 0.f;
        asm volatile("s_waitcnt vmcnt(0)" ::: "memory");
        __syncthreads();
        const int t = 64 * c + tokw, imax = t >= 31 ? (t - 31) >> 4 : -1;
        const LAS unsigned char* kb0 = lds + hi * 1024 + r32 * 16;
        const LAS unsigned char* vl0 = lds + 32768 + ((lane >> 4) & 1) * 32 + (lane & 3) * 8 + (4 * hi + ((lane & 15) >> 2)) * 64;
        float m = NEG, lsum = 0.f;
        for (int T = 0; T < nct; ++T) {
            f32x16 p0, p1;
            NSA_QKT(p0, p1, kb0 + T * 8192, qc);
            float rm = NEG;
#pragma unroll
            for (int r = 0; r < 16; ++r) { const int i0 = 64 * T + crow(r, hi); p0[r] = i0 <= imax ? p0[r] : NEG; p1[r] = i0 + 32 <= imax ? p1[r] : NEG; rm = fmaxf(rm, fmaxf(p0[r], p1[r])); }
            rm = pl32_max(rm);
            const float mnew = fmaxf(m, rm), msafe = mnew == NEG ? 0.f : mnew;
            float ps = 0.f;
#pragma unroll
            for (int r = 0; r < 16; ++r) ps += __builtin_amdgcn_exp2f(p0[r] - msafe) + __builtin_amdgcn_exp2f(p1[r] - msafe);
            lsum = lsum * __builtin_amdgcn_exp2f(m - msafe) + ps; m = mnew;
        }
        const float ltot = pl32_sum(lsum), inv = ltot > 0.f ? 1.f / ltot : 0.f, msafe = m == NEG ? 0.f : m;
#pragma unroll
        for (int r = 0; r < 16; ++r) { o[0][r] = 0.f; o[1][r] = 0.f; }
        for (int T = 0; T < nct; ++T) {
            f32x16 p0, p1;
            NSA_QKT(p0, p1, kb0 + T * 8192, qc);
#pragma unroll
            for (int r = 0; r < 16; ++r) { const int i0 = 64 * T + crow(r, hi);
                p0[r] = i0 <= imax ? __builtin_amdgcn_exp2f(p0[r] - msafe) * inv : 0.f; p1[r] = i0 + 32 <= imax ? __builtin_amdgcn_exp2f(p1[r] - msafe) * inv : 0.f; }
#pragma unroll
            for (int k = 0; k < 4; ++k) {
                float a0 = 2.f * (p0[4 * k] + p0[4 * k + 1] + p0[4 * k + 2]) + p0[4 * k + 3], b0 = p0[4 * k + 3];
                float a1 = 2.f * (p1[4 * k] + p1[4 * k + 1] + p1[4 * k + 2]) + p1[4 * k + 3], b1 = p1[4 * k + 3];
                a0 += __shfl_xor(a0, 1); a0 += __shfl_xor(a0, 2); b0 += __shfl_xor(b0, 1); b0 += __shfl_xor(b0, 2);
                a1 += __shfl_xor(a1, 1); a1 += __shfl_xor(a1, 2); b1 += __shfl_xor(b1, 1); b1 += __shfl_xor(b1, 2);
                if (head == 0) { const int g = 16 * T + 2 * k + hi, tl = r32 >> 2;
                    Aa[tl * 64 + g] = a0; Bb[tl * 65 + g + 1] = b0; Aa[tl * 64 + g + 8] = a1; Bb[tl * 65 + g + 9] = b1; }
            }
            NSA_PV(o, p0, p1, vl0 + T * 8192);
        }
        {
            const float f = sigmoidf_((float)ZROW()[ZC_NG + 3 * head + 0]);
            if (hi == 0) wsf[r32] = f;
            WAVE_LDS_SYNC();
#pragma unroll
            for (int r = 0; r < 16; ++r) { const float fr = wsf[crow(r, hi)]; tot[0][r] = o[0][r] * fr; tot[1][r] = o[1][r] * fr; }
            WAVE_LDS_SYNC();
        }
        if (c >= 16) {
            for (int tk = 0; tk < 8; ++tk) {
                const bool forced = (lane < 1) || (c - lane >= 0 && c - lane < 2);
                const float sc = (lane <= c) ? Aa[tk * 64 + lane] + Bb[tk * 65 + lane] + (forced ? 1e4f : 0.f) : -1e30f;
                Ssc[lane] = sc;
                WAVE_LDS_SYNC();
                int rank = 0;
#pragma unroll 4
                for (int q = 0; q < 16; ++q) { const f32x4 v = *(const LAS f32x4*)(Ssc + 4 * q);
#pragma unroll
                    for (int e = 0; e < 4; ++e) rank += (v[e] > sc || (v[e] == sc && 4 * q + e < lane)) ? 1 : 0; }
                const unsigned long long mk = __ballot(rank < 16);
                if (lane == 0) SELW[tk] = mk;
                WAVE_LDS_SYNC();
            }
            sel = SELW[r32 >> 2];
        } else sel = (2ull << c) - 1ull;
        __syncthreads();
    }
    f16x8 qf[4];
#pragma unroll
    for (int d0 = 0; d0 < 4; ++d0) qf[d0] = *(const f16x8*)(ZROW() + ZC_NQ + 64 * head + 16 * d0 + 8 * hi);
    {
        const u32x4 w = __builtin_bit_cast(u32x4, qf[0]); u32x4 ow;
#pragma unroll
        for (int k = 0; k < 4; ++k) ow[k] = pl32_other(w[k], hi);
        const f16x8 of = __builtin_bit_cast(f16x8, ow);
        size_t mr2 = mrow; asm volatile("" : "+v"(mr2));
        const f32x4 c0 = *(const f32x4*)(RC + mr2 * 8), c1 = *(const f32x4*)(RC + mr2 * 8 + 4), s0 = *(const f32x4*)(RS + mr2 * 8), s1 = *(const f32x4*)(RS + mr2 * 8 + 4);
#pragma unroll
        for (int i = 0; i < 8; ++i) {
            const float cs = i < 4 ? c0[i & 3] : c1[i & 3], sn = i < 4 ? s0[i & 3] : s1[i & 3];
            const float a = (float)qf[0][i], bq = (float)of[i];
            const float r = hi ? a * cs + bq * sn : a * cs - bq * sn;
            qf[0][i] = (f16)(r * NSA_C2);
        }
#pragma unroll
        for (int d0 = 1; d0 < 4; ++d0)
#pragma unroll
            for (int i = 0; i < 8; ++i) qf[d0][i] = (f16)((float)qf[d0][i] * NSA_C2);
    }
    float lsum;
    nsa_branch<0>(KSR + (size_t)b * S * 64, Z + (size_t)b * S * ZP + ZC_VSLC, c, sel, tokw, qf, o, lsum, lds, wsf, wid, lane, r32, hi);
    {
        const float f = sigmoidf_((float)ZROW()[ZC_NG + 3 * head + 1]) / pl32_sum(lsum);
        if (hi == 0) wsf[r32] = f;
        WAVE_LDS_SYNC();
#pragma unroll
        for (int r = 0; r < 16; ++r) { const float fr = wsf[crow(r, hi)]; tot[0][r] += o[0][r] * fr; tot[1][r] += o[1][r] * fr; }
        WAVE_LDS_SYNC();
    }
    nsa_branch<1>(KWR + (size_t)b * S * 64, Z + (size_t)b * S * ZP + ZC_VWIN, c, sel, tokw, qf, o, lsum, lds, wsf, wid, lane, r32, hi);
    {
        const float f = sigmoidf_((float)ZROW()[ZC_NG + 3 * head + 2]) / pl32_sum(lsum);
        if (hi == 0) wsf[r32] = f;
        WAVE_LDS_SYNC();
#pragma unroll
        for (int r = 0; r < 16; ++r) { const float fr = wsf[crow(r, hi)]; tot[0][r] += o[0][r] * fr; tot[1][r] += o[1][r] * fr; }
        WAVE_LDS_SYNC();
    }
    int r32s = r32; asm volatile("" : "+v"(r32s));
#pragma unroll
    for (int k = 0; k < 4; ++k) {
        const size_t mm = m0 + 8 * wid + 2 * k + hi;
        float ss = 0.f;
#pragma unroll
        for (int hd = 0; hd < 4; ++hd)
#pragma unroll
            for (int d0 = 0; d0 < 2; ++d0) { const float v = tot[d0][4 * k + hd]; ss += v * v; }
#pragma unroll
        for (int off = 1; off < 32; off <<= 1) ss += __shfl_xor(ss, off);
        const float rinv = rsqrtf(ss * (1.f / 256) + EPS);
#pragma unroll
        for (int hd = 0; hd < 4; ++hd)
#pragma unroll
            for (int d0 = 0; d0 < 2; ++d0) MIX[mm * D + 256 + 64 * hd + 32 * d0 + r32s] = (f16)(tot[d0][4 * k + hd] * rinv * gain[64 * hd + 32 * d0 + r32s]);
    }
}
#undef ZROW
__device__ __forceinline__ void ph_nsa(const Ctx& C, int l, int TID, int bid, int nblk, LAS float* lds) {
    for (int item = bid; item < 256; item += nblk) {
        const int b = item >> 5, s = item & 31;
        for (int u = 0; u < 2; ++u) {
            const int c = u == 0 ? s : 63 - s;
            __syncthreads();
            nsa_unit(C, l, b, c, TID, (LAS unsigned char*)lds);
        }
    }
}
constexpr size_t WS_QE2H = WS_H;
constexpr size_t WS_OI16 = WS_H + 8 * MiB;
constexpr size_t WS_SPT = WS_Y + 16 * MiB;
constexpr size_t WS_DEC = WS_Y + 24 * MiB;
__device__ __forceinline__ void ph_gla_local(const Ctx& C, int l, int TID, int bid, int nblk, LAS unsigned char* lds) {
    const f16* Z = (const f16*)(C.ws + WS_Z);
    f16* QE2H = (f16*)(C.ws + WS_QE2H); f16* OI16 = (f16*)(C.ws + WS_OI16); float* KV = (float*)(C.ws + WS_KV); float* DEC = (float*)(C.ws + WS_DEC);
    const float* w2 = C.in[8] + (size_t)l * 16 * 128; const float* gb = C.in[9] + (size_t)l * 128;
    const int tid = TID, lane = tid & 63, wid = __builtin_amdgcn_readfirstlane(tid >> 6), r32 = lane & 31, hi = lane >> 5;
    const int dim = tid & 127, tq = tid >> 7, hh = dim >> 5, dd = dim & 31;
    LAS float* LR = (LAS float*)lds; LAS float* TOT = (LAS float*)(lds + 4096); LAS float* BM = (LAS float*)(lds + 6144); LAS float* BL = (LAS float*)(lds + 6656);
    constexpr int QE_OFF = 8192, KE_OFF = 24576, K2_OFF = 40960, V_OFF = 57344;
    float w2c[16];
#pragma unroll
    for (int r = 0; r < 16; ++r) w2c[r] = w2[r * 128 + dim];
    const float bias = gb[dim];
    for (int item = bid; item < M / 64; item += nblk) {
        const size_t m0 = (size_t)item * 64; const int b = item >> 6, n = item & 63;
        __syncthreads();
#pragma unroll
        for (int it = 0; it < 2; ++it) { const int q = tid + NT * it; LR[q] = (float)Z[(m0 + (q >> 4)) * ZP + ZC_LR + (q & 15)]; }
#pragma unroll
        for (int it = 0; it < 4; ++it) { const int q = tid + NT * it, s = q >> 5, h4 = (q >> 3) & 3, ch = q & 7;
            *(LAS f16x8*)(lds + V_OFF + h4 * 8192 + (ch >> 2) * 4096 + s * 64 + (ch & 3) * 16) = *(const f16x8*)(Z + (m0 + s) * ZP + ZC_LV + 64 * h4 + 8 * ch); }
        __syncthreads();
        float bl[16]; float run = 0.f;
#pragma unroll
        for (int i = 0; i < 16; ++i) {
            float a = bias;
#pragma unroll
            for (int r = 0; r < 16; ++r) a += LR[(16 * tq + i) * 16 + r] * w2c[r];
            const float ls = fminf(a, 0.f) - log1pf(expf(-fabsf(a)));
            run += ls * (1.f / 16.f); bl[i] = run;
        }
        TOT[tq * 128 + dim] = run;
        __syncthreads();
        float pre = 0.f;
#pragma unroll
        for (int q = 0; q < 3; ++q) pre += q < tq ? TOT[q * 128 + dim] : 0.f;
#pragma unroll
        for (int i = 0; i < 16; ++i) bl[i] += pre;
        if (tq == 2) BM[dim] = bl[0];
        if (tq == 3) BL[dim] = bl[15];
        __syncthreads();
        const float bmid = BM[dim], blast = BL[dim];
        if (tq == 3) DEC[((size_t)(b * 4 + hh) * 64 + n) * 32 + dd] = expf(blast);
#pragma unroll
        for (int i = 0; i < 16; ++i) {
            const int t = 16 * tq + i;
            const float qv = (float)Z[(m0 + t) * ZP + ZC_LQ + dim] * 0.17677669529663687f, kv = (float)Z[(m0 + t) * ZP + ZC_LK + dim];
            *(LAS f16*)(lds + QE_OFF + hh * 4096 + t * 64 + dd * 2) = (f16)(qv * expf(bl[i] - bmid));
            *(LAS f16*)(lds + KE_OFF + hh * 4096 + (dd >> 3) * 1024 + t * 16 + (dd & 7) * 2) = (f16)(kv * expf(bmid - bl[i]));
            *(LAS f16*)(lds + K2_OFF + hh * 4096 + t * 64 + dd * 2) = (f16)(kv * expf(blast - bl[i]));
            QE2H[(m0 + t) * 128 + dim] = (f16)(qv * expf(bl[i]));
        }
        __syncthreads();
        {
            const int h = wid >> 1, th = wid & 1;
            f16x8 qb[2];
#pragma unroll
            for (int d0 = 0; d0 < 2; ++d0) qb[d0] = *(const LAS f16x8*)(lds + QE_OFF + h * 4096 + (32 * th + r32) * 64 + (16 * d0 + 8 * hi) * 2);
            f32x16 p0, p1;
#pragma unroll
            for (int r = 0; r < 16; ++r) { p0[r] = 0.f; p1[r] = 0.f; }
            const LAS unsigned char* kb = lds + KE_OFF + h * 4096 + hi * 1024 + r32 * 16;
#pragma unroll
            for (int d0 = 0; d0 < 2; ++d0) {
                const f16x8 k0 = *(const LAS f16x8*)(kb + d0 * 2048), k1 = *(const LAS f16x8*)(kb + d0 * 2048 + 512);
                p0 = __builtin_amdgcn_mfma_f32_32x32x16_f16(k0, qb[d0], p0, 0, 0, 0);
                p1 = __builtin_amdgcn_mfma_f32_32x32x16_f16(k1, qb[d0], p1, 0, 0, 0);
            }
            const int trow = 32 * th + r32;
#pragma unroll
            for (int r = 0; r < 16; ++r) { const int s = crow(r, hi); p0[r] = s <= trow ? p0[r] : 0.f; p1[r] = s + 32 <= trow ? p1[r] : 0.f; }
            f32x16 o[2];
#pragma unroll
            for (int r = 0; r < 16; ++r) { o[0][r] = 0.f; o[1][r] = 0.f; }
            const LAS unsigned char* vs = lds + V_OFF + h * 8192 + ((lane >> 4) & 1) * 32 + (lane & 3) * 8 + (4 * hi + ((lane & 15) >> 2)) * 64;
            NSA_PV(o, p0, p1, vs);
#pragma unroll
            for (int d0 = 0; d0 < 2; ++d0)
#pragma unroll
                for (int r = 0; r < 16; ++r) OI16[(m0 + 32 * th + crow(r, hi)) * 256 + 64 * h + 32 * d0 + r32] = (f16)o[d0][r];
            f32x16 kvacc;
#pragma unroll
            for (int r = 0; r < 16; ++r) kvacc[r] = 0.f;
            const LAS unsigned char* ka = lds + K2_OFF + h * 4096 + ((lane >> 4) & 1) * 32 + (lane & 3) * 8 + (4 * hi + ((lane & 15) >> 2)) * 64;
#pragma unroll
            for (int ks = 0; ks < 4; ++ks) {
                const s16x4 alo = vtr(ka + ks * 1024), ahi = vtr(ka + ks * 1024 + 512), blo = vtr(vs + th * 4096 + ks * 1024), bhi = vtr(vs + th * 4096 + ks * 1024 + 512);
                const s16x8 av = {alo[0], alo[1], alo[2], alo[3], ahi[0], ahi[1], ahi[2], ahi[3]}, bv = {blo[0], blo[1], blo[2], blo[3], bhi[0], bhi[1], bhi[2], bhi[3]};
                kvacc = __builtin_amdgcn_mfma_f32_32x32x16_f16(__builtin_bit_cast(f16x8, av), __builtin_bit_cast(f16x8, bv), kvacc, 0, 0, 0);
            }
#pragma unroll
            for (int r = 0; r < 16; ++r) KV[((size_t)(b * 4 + h) * 64 + n) * 2048 + crow(r, hi) * 64 + 32 * th + r32] = kvacc[r];
        }
    }
}
__device__ __forceinline__ void ph_gla_scan(const Ctx& C, int TID, int bid, int nblk) {
    const float* DEC = (const float*)(C.ws + WS_DEC); const float* KV = (const float*)(C.ws + WS_KV); f16* SPT = (f16*)(C.ws + WS_SPT);
    for (int idx = bid * NT + TID; idx < NB * 4 * 2048; idx += nblk * NT) {
        const int dv = idx & 2047, bh = idx >> 11, d = dv >> 6, v = dv & 63;
        float st = 0.f;
        for (int n0 = 0; n0 < 64; n0 += 16) {
            float kvv[16], dc[16];
#pragma unroll
            for (int i = 0; i < 16; ++i) { kvv[i] = KV[((size_t)bh * 64 + n0 + i) * 2048 + dv]; dc[i] = DEC[((size_t)bh * 64 + n0 + i) * 32 + d]; }
#pragma unroll
            for (int i = 0; i < 16; ++i) { SPT[(((size_t)bh * 64 + n0 + i) * 64 + v) * 32 + d] = (f16)st; st = dc[i] * st + kvv[i]; }
        }
    }
}
__device__ __forceinline__ void ph_gla_final(const Ctx& C, int l, int TID, int bid, int nblk, LAS unsigned char* lds) {
    const f16* Z = (const f16*)(C.ws + WS_Z); f16* MIX = (f16*)(C.ws + WS_MIX);
    const f16* QE2H = (const f16*)(C.ws + WS_QE2H); const f16* OI16 = (const f16*)(C.ws + WS_OI16); const f16* SPT = (const f16*)(C.ws + WS_SPT);
    const float* gain = C.in[12] + (size_t)l * D + 512;
    const int tid = TID, lane = tid & 63, wid = __builtin_amdgcn_readfirstlane(tid >> 6), r32 = lane & 31, hi = lane >> 5;
    LAS float* SS = (LAS float*)lds;
    for (int item = bid; item < M / 64; item += nblk) {
        const size_t m0 = (size_t)item * 64; const int b = item >> 6, n = item & 63;
        const int h = wid >> 1, th = wid & 1;
        const f16* qa_p = QE2H + (m0 + 32 * th + r32) * 128 + 32 * h + 8 * hi;
        const f16x8 qa0 = *(const f16x8*)(qa_p), qa1 = *(const f16x8*)(qa_p + 16);
        f32x16 o[2];
#pragma unroll
        for (int vh = 0; vh < 2; ++vh) {
            const f16* sp = SPT + (((size_t)(b * 4 + h) * 64 + n) * 64 + 32 * vh + r32) * 32 + 8 * hi;
            const f16x8 s0 = *(const f16x8*)(sp), s1 = *(const f16x8*)(sp + 16);
#pragma unroll
            for (int r = 0; r < 16; ++r) o[vh][r] = (float)OI16[(m0 + 32 * th + crow(r, hi)) * 256 + 64 * h + 32 * vh + r32];
            o[vh] = __builtin_amdgcn_mfma_f32_32x32x16_f16(qa0, s0, o[vh], 0, 0, 0);
            o[vh] = __builtin_amdgcn_mfma_f32_32x32x16_f16(qa1, s1, o[vh], 0, 0, 0);
        }
        float ssum[16];
#pragma unroll
        for (int r = 0; r < 16; ++r) {
            float s = o[0][r] * o[0][r] + o[1][r] * o[1][r];
#pragma unroll
            for (int off = 1; off < 32; off <<= 1) s += __shfl_xor(s, off);
            const float rn = rsqrtf(s * (1.f / 64) + EPS);
            const size_t mt = m0 + 32 * th + crow(r, hi);
            float s2 = 0.f;
#pragma unroll
            for (int vh = 0; vh < 2; ++vh) { const float gv = (float)Z[mt * ZP + ZC_LG + 64 * h + 32 * vh + r32]; const float og = siluf(gv) * (o[vh][r] * rn); o[vh][r] = og; s2 += og * og; }
#pragma unroll
            for (int off = 1; off < 32; off <<= 1) s2 += __shfl_xor(s2, off);
            ssum[r] = s2;
        }
        __syncthreads();
        if (r32 == 0) {
#pragma unroll
            for (int r = 0; r < 16; ++r) SS[(32 * th + crow(r, hi)) * 4 + h] = ssum[r];
        }
        __syncthreads();
#pragma unroll
        for (int r = 0; r < 16; ++r) {
            const int t = 32 * th + crow(r, hi);
            const f32x4 s4 = *(const LAS f32x4*)(SS + t * 4);
            const float rinv = rsqrtf((s4[0] + s4[1] + s4[2] + s4[3]) * (1.f / 256) + EPS);
#pragma unroll
            for (int vh = 0; vh < 2; ++vh) MIX[(m0 + t) * D + 512 + 64 * h + 32 * vh + r32] = (f16)(o[vh][r] * rinv * gain[64 * h + 32 * vh + r32]);
        }
    }
}

__device__ __forceinline__ void ph_gmlp(const Ctx& C, int l, int TID, int bid, int nblk, LAS unsigned char* lds) {
    const f16* Z = (const f16*)(C.ws + WS_Z); f16* MIX = (f16*)(C.ws + WS_MIX);
    const f16* W16 = (const f16*)(C.ws + WS_WS16) + (size_t)l * 4 * 128 * 128;
    const float* bs = C.in[11] + (size_t)l * 4 * 128; const float* gain = C.in[12] + (size_t)l * D + 768;
    const int tid = TID, lane = tid & 63, wid = tid >> 6, r32 = lane & 31, hi = lane >> 5;
    LAS unsigned char* OS = lds + 65536;
    for (int item = bid; item < M / 128; item += nblk) {
        const size_t m0 = (size_t)item * 128;
        __syncthreads();
#pragma unroll
        for (int it = 0; it < 8; ++it) {
            const int q = tid + NT * it, s = q >> 5, g = (q >> 3) & 3, ch = q & 7;
            const f16x8 v8 = *(const f16x8*)(Z + (m0 + s) * ZP + ZC_MV + 64 * g + 8 * ch);
            float v[8]; float sum = 0.f;
#pragma unroll
            for (int e = 0; e < 8; ++e) { v[e] = (float)v8[e]; sum += v[e]; }
            sum += __shfl_xor(sum, 1); sum += __shfl_xor(sum, 2); sum += __shfl_xor(sum, 4);
            const float mu = sum * (1.f / 64); float var = 0.f;
#pragma unroll
            for (int e = 0; e < 8; ++e) { v[e] -= mu; var += v[e] * v[e]; }
            var += __shfl_xor(var, 1); var += __shfl_xor(var, 2); var += __shfl_xor(var, 4);
            const float rs = rsqrtf(var * (1.f / 64) + EPS);
            f16x8 o8;
#pragma unroll
            for (int e = 0; e < 8; ++e) o8[e] = (f16)(v[e] * rs);
            *(LAS f16x8*)(lds + g * 16384 + (ch >> 2) * 8192 + s * 64 + (ch & 3) * 16) = o8;
        }
        __syncthreads();
        {
            const int g = wid >> 1, wh = wid & 1;
            const LAS unsigned char* vb = lds + g * 16384 + wh * 8192 + ((lane >> 4) & 1) * 32 + (lane & 3) * 8 + (4 * hi + ((lane & 15) >> 2)) * 64;
            for (int rt = 0; rt < 4; ++rt) {
                f32x16 acc;
#pragma unroll
                for (int r = 0; r < 16; ++r) acc[r] = 0.f;
                const f16* wrow = W16 + ((size_t)g * 128 + 32 * rt + r32) * 128 + 4 * hi;
                for (int ks = 0; ks < 2 * rt + 2; ++ks) {
                    const f16x4 a0 = *(const f16x4*)(wrow + 16 * ks), a1 = *(const f16x4*)(wrow + 16 * ks + 8);
                    const f16x8 af = {a0[0], a0[1], a0[2], a0[3], a1[0], a1[1], a1[2], a1[3]};
                    const s16x4 lo = vtr(vb + ks * 1024), hh = vtr(vb + ks * 1024 + 512);
                    typedef short s16x8 __attribute__((ext_vector_type(8)));
                    const s16x8 bv = {lo[0], lo[1], lo[2], lo[3], hh[0], hh[1], hh[2], hh[3]};
                    acc = __builtin_amdgcn_mfma_f32_32x32x16_f16(af, __builtin_bit_cast(f16x8, bv), acc, 0, 0, 0);
                }
#pragma unroll
                for (int r = 0; r < 16; ++r) {
                    const int t = 32 * rt + crow(r, hi), ch = 64 * g + 32 * wh + r32;
                    const float val = (float)Z[(m0 + t) * ZP + ZC_MU + ch] * (acc[r] + bs[g * 128 + t]);
                    *(LAS f16*)(OS + (t * 256 + ch) * 2) = (f16)val;
                }
            }
        }
        __syncthreads();
        for (int tt = 0; tt < 16; ++tt) {
            const int t = 16 * wid + tt;
            const f16x4 v4 = *(const LAS f16x4*)(OS + (t * 256 + 4 * lane) * 2);
            float v[4]; float ss = 0.f;
#pragma unroll
            for (int e = 0; e < 4; ++e) { v[e] = (float)v4[e]; ss += v[e] * v[e]; }
            const float r = rsqrtf(wave_sum(ss) * (1.f / 256) + EPS);
            const f32x4 gv = *(const f32x4*)(gain + 4 * lane);
            f16x4 o4;
#pragma unroll
            for (int e = 0; e < 4; ++e) o4[e] = (f16)(v[e] * r * gv[e]);
            *(f16x4*)(MIX + (m0 + t) * D + 768 + 4 * lane) = o4;
        }
    }
}

__device__ __forceinline__ void cvt_item(const float* W, int K, int N, f16* WT, bool remap, LAS float* scr, int item, int lane) {
    const int nb_ = (N + 31) / 32, kb = item / nb_, nb = item % nb_, k0 = 64 * kb, n0 = 32 * nb;
#pragma unroll 8
    for (int i = 0; i < 32; ++i) { const int kk = 2 * i + (lane >> 5), n = n0 + (lane & 31); scr[kk * 33 + (lane & 31)] = n < N ? W[(size_t)(k0 + kk) * N + n] : 0.f; }
    WAVE_LDS_SYNC();
    const int c = lane & 7;
#pragma unroll
    for (int j = 0; j < 4; ++j) {
        const int nn = (lane >> 3) + 8 * j, n = n0 + nn;
        if (n < N) {
            const int row = remap ? n + (n >= 1420 ? 4 : 0) : n; const LAS float* s = scr + (8 * c) * 33 + nn;
            f16x8 o;
#pragma unroll
            for (int e = 0; e < 8; ++e) o[e] = (f16)s[e * 33];
            *(f16x8*)(WT + (size_t)row * K + k0 + 8 * c) = o;
        }
    }
    WAVE_LDS_SYNC();
}
__device__ __forceinline__ void ph_wcvt(const Ctx& C, int TID, int bid, int nblk, LAS float* lds) {
    const int lane = TID & 63, wave = TID >> 6, gw = bid * NWAVE + wave, ngw = nblk * NWAVE;
    LAS float* scr = lds + wave * 4096;
    for (int it = gw; it < DEPTH * 2 * 2 * 64; it += ngw) {
        const int r = it & 63, half = (it >> 6) & 1, j = (it >> 7) & 1, l = it >> 8;
        cvt_item(C.in[6] + ((size_t)(l * 2 + j) * 2048 + half * 1024) * 128, 1024, 128, (f16*)(C.ws + WS_W1T) + ((size_t)(l * 2 + j) * 256 + half * 128) * 1024, false, scr, r, lane);
    }
    for (int it = gw; it < DEPTH * 4 * 128; it += ngw) {
        const float* w = C.in[10] + (size_t)it * 128; const int t = it & 127;
        f16* o = (f16*)(C.ws + WS_WS16) + (size_t)it * 128;
        o[lane] = (f16)(lane <= t ? w[lane] : 0.f); o[lane + 64] = (f16)(lane + 64 <= t ? w[lane + 64] : 0.f);
    }
    for (int it = gw; it < DEPTH * 2 * 32; it += ngw) {
        const int q = it & 31, lj = it >> 5;
        const float* pp = C.in[5] + (size_t)lj * 2048 + q * 64; const float* w = C.in[6] + ((size_t)lj * 2048 + q * 64) * 128;
        float a0 = 0.f, a1 = 0.f;
        for (int k = 0; k < 64; ++k) { const float pv = pp[k]; a0 += pv * w[k * 128 + lane]; a1 += pv * w[k * 128 + 64 + lane]; }
        float* o = (float*)(C.ws + WS_PCB) + (size_t)it * 128; o[lane] = a0; o[lane + 64] = a1;
    }
    constexpr int I_IN = (D / 64) * ((NIN + 31) / 32), I_O = (D / 64) * (D / 32), I_UP = (D / 64) * (DFF / 32), I_DN = (DFF / 64) * (D / 32), I_PAD = 100, I_L = I_IN + I_O + I_UP + I_DN + I_PAD;
    for (int it = gw; it < DEPTH * I_L; it += ngw) {
        const int l = it / I_L; int r = it % I_L;
        unsigned char* wl = C.ws + WS_W16 + (size_t)l * W16_LAYER;
        if (r < I_IN) { cvt_item(C.in[3] + (size_t)l * D * NIN, D, NIN, (f16*)(wl + W16_WIN), true, scr, r, lane); continue; } r -= I_IN;
        if (r < I_O) { cvt_item(C.in[13] + (size_t)l * D * D, D, D, (f16*)(wl + W16_WO), false, scr, r, lane); continue; } r -= I_O;
        if (r < I_UP) { cvt_item(C.in[17] + (size_t)l * D * DFF, D, DFF, (f16*)(wl + W16_WUP), false, scr, r, lane); continue; } r -= I_UP;
        if (r < I_DN) { cvt_item(C.in[18] + (size_t)l * DFF * D, DFF, D, (f16*)(wl + W16_WDN), false, scr, r, lane); continue; } r -= I_DN;
        const int row = r < 4 ? 1420 + r : 2720 + (r - 4);
        f16x8 z; for (int e = 0; e < 8; ++e) z[e] = (f16)0.f;
        f16* p = (f16*)(wl + W16_WIN) + (size_t)row * D;
        *(f16x8*)(p + 8 * lane) = z; *(f16x8*)(p + 512 + 8 * lane) = z;
    }
}

namespace pg8 {
#define PG8_LAS __attribute__((address_space(3)))
typedef _Float16 bf16_t;
typedef _Float16 bf16x8 __attribute__((ext_vector_type(8)));
typedef float f32x4 __attribute__((ext_vector_type(4)));
typedef unsigned u32x4 __attribute__((ext_vector_type(4)));
constexpr int BM = 256, BK = 64, HALF = 128, HTB = HALF * BK * 2  , STAGE_BYTES = 8 * HTB, NXCD = 8, WGM = 8;

__host__ __device__ __forceinline__ int lds_byte(int r, int c) { const int st = (r >> 4) * 2 + (c >> 5), rr = r & 15, cc = c & 31, ob = rr * 64 + cc * 2; return st * 1024 + (ob ^ (((ob >> 9) & 1) << 5)); }
__host__ __device__ __forceinline__ void stage_rc(int b, int& R, int& C) { const int st = b / 1024, sb = b % 1024, swz = sb ^ (((sb >> 9) & 1) << 5); R = (st >> 1) * 16 + swz / 64; C = (st & 1) * 32 + (swz % 64) / 2; }
__host__ __device__ __forceinline__ int perm32(int rho) { const int n = rho >> 4, i = rho & 15; return 8 * (i >> 2) + 4 * n + (i & 3); }

struct Unit { int pm, pn; };
struct Gemm { const bf16_t* A; const bf16_t* Bt; int M, N, K; };

struct StaticOrder {
    int nM, nN, nwg, G, c;
    __host__ __device__ void init(int M, int N, int G_, int c_) { nM = M / BM; nN = N / BM; nwg = nM * nN; G = G_; c = c_; }
    __host__ __device__ bool next(int i, Unit& u) const {
        const long L = (long)i * G + c; if (L >= nwg) return false;
        int wgid = (int)L; { const int q = nwg / NXCD, r = nwg % NXCD, xcd = wgid % NXCD, off = wgid / NXCD; wgid = (xcd < r ? xcd * (q + 1) : r * (q + 1) + (xcd - r) * q) + off; }
        const int nig = WGM * nN, gid = wgid / nig, fm = gid * WGM, gsz = (nM - fm) < WGM ? (nM - fm) : WGM;
        u.pm = fm + ((wgid % nig) % gsz); u.pn = (wgid % nig) / gsz; return true;
    }
    __device__ __forceinline__ void a_ready(const Unit&) const {}
    __device__ __forceinline__ void done(const Unit&) const {}
};


template <int ACT> struct EpiF16 {
    static constexpr bool PERM = true, AFTER_DRAIN = false;
    bf16_t* O; int ldc;
    __device__ __forceinline__ void operator()(const f32x4 (&acc)[2][2][4][2], const Unit& u, int wr, int wc, int fr, int fq) const {
        const int row0 = u.pm * BM + wr * 64 + fr, col0 = u.pn * BM + wc * 32 + 8 * fq;
#pragma unroll
        for (int ai = 0; ai < 2; ++ai)
#pragma unroll
            for (int m = 0; m < 4; ++m) { bf16_t* rowp = O + (size_t)(row0 + ai * HALF + m * 16) * ldc + col0;
#pragma unroll
                for (int bj = 0; bj < 2; ++bj) { f32x4 v0 = acc[ai][bj][m][0], v1 = acc[ai][bj][m][1];
                    if (ACT == 1) {
#pragma unroll
                        for (int e = 0; e < 4; ++e) { const float a = fmaxf(v0[e], 0.f), b = fmaxf(v1[e], 0.f); v0[e] = a * a; v1[e] = b * b; } }
                    bf16x8 w; w[0] = (bf16_t)v0[0]; w[1] = (bf16_t)v0[1]; w[2] = (bf16_t)v0[2]; w[3] = (bf16_t)v0[3]; w[4] = (bf16_t)v1[0]; w[5] = (bf16_t)v1[1]; w[6] = (bf16_t)v1[2]; w[7] = (bf16_t)v1[3];
                    *(bf16x8*)(rowp + bj * HALF) = w; } }
    }
};
template <class Epi, class Sched, bool ALIGN_EPI = false, bool SP2 = false>
__device__ __forceinline__ void gemm_phase(PG8_LAS unsigned char* lds, const Gemm g, const Sched& S, const Epi& E, const int tid) {
    const int  wid = __builtin_amdgcn_readfirstlane(tid >> 6), lane = tid & 63, wr = wid >> 2, wc = wid & 3, fr = lane & 15, fq = lane >> 4;
    const int K = g.K, nt = K / BK;
    unsigned voffA[2], voffB[2];
#pragma unroll
    for (int i = 0; i < 2; ++i) { int R, C; stage_rc(tid * 16 + i * 8192, R, C); const int Rb = Epi::PERM ? ((R & ~31) + perm32(R & 31)) : R;
        voffA[i] = (unsigned)(R * K + C) * 2u; voffB[i] = (unsigned)(Rb * K + C) * 2u; }
    const size_t kstep = (size_t)(BK * 2);
    const size_t hstep = (size_t)HALF * K * 2;
    const size_t tstep = 2 * hstep;
    const unsigned ldsw = (unsigned)wid * 1024u;
    const int aoff = lds_byte(wr * 64 + fr, fq * 8), boff = lds_byte(wc * 32 + fr, fq * 8);
#define PG8_SA(b, h) (((b) * 2 + (h)) * HTB)
#define PG8_SB(b, h) ((4 + (b) * 2 + (h)) * HTB)
#define PG8_STAGE(bufoff, gbase, voff) do { _Pragma("unroll") for (int _i = 0; _i < 2; ++_i) \
        __builtin_amdgcn_global_load_lds((const unsigned*)((const char*)(gbase) + (voff)[_i]), (PG8_LAS unsigned*)(lds + (bufoff) + ldsw + _i * 8192), 16, 0, 0); } while (0)
#define PG8_LDA(dst, b, h) do { _Pragma("unroll") for (int m = 0; m < 4; ++m) _Pragma("unroll") for (int k = 0; k < 2; ++k) dst[m][k] = *(const PG8_LAS bf16x8*)(lds + PG8_SA(b, h) + aoff + m * 2048 + k * 1024); } while (0)
#define PG8_LDB(dst, b, h) do { _Pragma("unroll") for (int n = 0; n < 2; ++n) _Pragma("unroll") for (int k = 0; k < 2; ++k) dst[n][k] = *(const PG8_LAS bf16x8*)(lds + PG8_SB(b, h) + boff + n * 2048 + k * 1024); } while (0)
#define PG8_MMA(ai, bj, At, Bt) do { __builtin_amdgcn_s_setprio(1); _Pragma("unroll") for (int m = 0; m < 4; ++m) _Pragma("unroll") for (int n = 0; n < 2; ++n) _Pragma("unroll") for (int k = 0; k < 2; ++k) \
        acc[ai][bj][m][n] = __builtin_amdgcn_mfma_f32_16x16x32_f16(Bt[n][k], At[m][k], acc[ai][bj][m][n], 0, 0, 0); __builtin_amdgcn_s_setprio(0); } while (0)
#define PG8_WAIT_V(n) asm volatile("s_waitcnt vmcnt(" #n ")" ::: "memory")
#define PG8_WAIT_L(n) asm volatile("s_waitcnt lgkmcnt(" #n ")" ::: "memory")
#define PG8_BAR __builtin_amdgcn_s_barrier()
#define PG8_SCHED __builtin_amdgcn_sched_barrier(0)
    Unit cur, nxt; int ui = 0;
    if (!S.next(0, cur)) return;
    f32x4 acc[2][2][4][2];
#pragma unroll
    for (int a = 0; a < 2; ++a)
#pragma unroll
        for (int b = 0; b < 2; ++b)
#pragma unroll
            for (int m = 0; m < 4; ++m)
#pragma unroll
                for (int n = 0; n < 2; ++n) acc[a][b][m][n] = (f32x4){0.f, 0.f, 0.f, 0.f};
    bf16x8 At[4][2], B0[2][2], B1[2][2];
    const char* cA = (const char*)g.A + (size_t)cur.pm * tstep; const char* cB = (const char*)g.Bt + (size_t)cur.pn * tstep;
    S.a_ready(cur);
    if constexpr (SP2) {
        PG8_STAGE(PG8_SB(0, 0), cB, voffB); PG8_STAGE(PG8_SB(0, 1), cB + hstep, voffB); PG8_STAGE(PG8_SA(0, 0), cA, voffA); PG8_STAGE(PG8_SA(0, 1), cA + hstep, voffA);
        if (wr == 1) PG8_BAR;
        PG8_WAIT_V(2); PG8_BAR;
        PG8_STAGE(PG8_SB(1, 0), cB + kstep, voffB); PG8_STAGE(PG8_SA(1, 0), cA + kstep, voffA); PG8_STAGE(PG8_SB(1, 1), cB + hstep + kstep, voffB);
        PG8_WAIT_V(6); PG8_BAR;
    } else {
        PG8_STAGE(PG8_SB(0, 0), cB, voffB); PG8_STAGE(PG8_SA(0, 0), cA, voffA); PG8_STAGE(PG8_SB(0, 1), cB + hstep, voffB); PG8_STAGE(PG8_SA(0, 1), cA + hstep, voffA);
        if (wr == 1) PG8_BAR;
        PG8_WAIT_V(4); PG8_BAR;
        PG8_STAGE(PG8_SB(1, 0), cB + kstep, voffB); PG8_STAGE(PG8_SA(1, 0), cA + kstep, voffA); PG8_STAGE(PG8_SB(1, 1), cB + hstep + kstep, voffB);
        PG8_WAIT_V(6); PG8_BAR;
    }
    for (;;) {
        const bool has_next = S.next(ui + 1, nxt);
        const char* nA = has_next ? (const char*)g.A + (size_t)nxt.pm * tstep : cA; const char* nB = has_next ? (const char*)g.Bt + (size_t)nxt.pn * tstep : cB;
        for (int t = 0; t < nt; t += 2) {
            const bool last = (t == nt - 2);
            const char* a1 = cA + (size_t)(t + 1) * kstep;
            const char* a2 = last ? nA : cA + (size_t)(t + 2) * kstep; const char* b2 = last ? nB : cB + (size_t)(t + 2) * kstep;
            const char* a3 = a2 + kstep; const char* b3 = b2 + kstep;
            if (last && has_next) S.a_ready(nxt);
            if constexpr (SP2) {
            PG8_LDB(B0, 0, 0); PG8_LDB(B1, 0, 1); PG8_SCHED; PG8_LDA(At, 0, 0); PG8_STAGE(PG8_SA(1, 1), a1 + hstep, voffA);
            PG8_WAIT_V(8); PG8_WAIT_L(0); PG8_BAR; PG8_MMA(0, 0, At, B0); PG8_MMA(0, 1, At, B1); PG8_BAR; PG8_SCHED;
            PG8_LDA(At, 0, 1); PG8_STAGE(PG8_SB(0, 0), b2, voffB); PG8_STAGE(PG8_SB(0, 1), b2 + hstep, voffB); PG8_STAGE(PG8_SA(0, 0), a2, voffA);
            PG8_WAIT_V(8); PG8_WAIT_L(0); PG8_BAR; PG8_MMA(1, 0, At, B0); PG8_MMA(1, 1, At, B1); PG8_BAR; PG8_SCHED;
            PG8_LDB(B0, 1, 0); PG8_LDB(B1, 1, 1); PG8_SCHED; PG8_LDA(At, 1, 0); PG8_STAGE(PG8_SA(0, 1), a2 + hstep, voffA);
            PG8_WAIT_V(8); PG8_WAIT_L(0); PG8_BAR; PG8_MMA(0, 0, At, B0); PG8_MMA(0, 1, At, B1); PG8_BAR; PG8_SCHED;
            PG8_LDA(At, 1, 1); PG8_STAGE(PG8_SB(1, 0), b3, voffB); PG8_STAGE(PG8_SB(1, 1), b3 + hstep, voffB); PG8_STAGE(PG8_SA(1, 0), a3, voffA);
            PG8_WAIT_V(8); PG8_WAIT_L(0); PG8_BAR; PG8_MMA(1, 0, At, B0); PG8_MMA(1, 1, At, B1); PG8_BAR; PG8_SCHED;
            } else {
            PG8_LDB(B0, 0, 0); PG8_SCHED; PG8_LDA(At, 0, 0); PG8_STAGE(PG8_SA(1, 1), a1 + hstep, voffA);
            PG8_WAIT_L(8); PG8_BAR; PG8_WAIT_L(0); PG8_MMA(0, 0, At, B0); PG8_BAR; PG8_SCHED;
            PG8_LDB(B1, 0, 1); PG8_STAGE(PG8_SB(0, 0), b2, voffB);
            PG8_BAR; PG8_WAIT_L(0); PG8_MMA(0, 1, At, B1); PG8_BAR;
            PG8_LDA(At, 0, 1); PG8_STAGE(PG8_SA(0, 0), a2, voffA);
            PG8_BAR; PG8_WAIT_L(0); PG8_MMA(1, 0, At, B0); PG8_BAR; PG8_SCHED;
            PG8_STAGE(PG8_SB(0, 1), b2 + hstep, voffB);
            PG8_WAIT_V(6); PG8_BAR; PG8_MMA(1, 1, At, B1); PG8_BAR;
            PG8_LDB(B0, 1, 0); PG8_SCHED; PG8_LDA(At, 1, 0); PG8_STAGE(PG8_SA(0, 1), a2 + hstep, voffA);
            PG8_WAIT_L(8); PG8_BAR; PG8_WAIT_L(0); PG8_MMA(0, 0, At, B0); PG8_BAR; PG8_SCHED;
            PG8_LDB(B1, 1, 1); PG8_STAGE(PG8_SB(1, 0), b3, voffB);
            PG8_BAR; PG8_WAIT_L(0); PG8_MMA(0, 1, At, B1); PG8_BAR;
            PG8_LDA(At, 1, 1); PG8_STAGE(PG8_SA(1, 0), a3, voffA);
            PG8_BAR; PG8_WAIT_L(0); PG8_MMA(1, 0, At, B0); PG8_BAR; PG8_SCHED;
            PG8_STAGE(PG8_SB(1, 1), b3 + hstep, voffB);
            PG8_WAIT_V(6); PG8_BAR; PG8_MMA(1, 1, At, B1); PG8_BAR;
            }
        }
        if constexpr (ALIGN_EPI) { if (wr == 0) PG8_BAR; }
        if constexpr (!Epi::AFTER_DRAIN) { E(acc, cur, wr, wc, fr, fq); S.done(cur); }
        if (!has_next) break;
#pragma unroll
        for (int a = 0; a < 2; ++a)
#pragma unroll
            for (int b = 0; b < 2; ++b)
#pragma unroll
                for (int m = 0; m < 4; ++m)
#pragma unroll
                    for (int n = 0; n < 2; ++n) acc[a][b][m][n] = (f32x4){0.f, 0.f, 0.f, 0.f};
        cur = nxt; cA = nA; cB = nB; ++ui;
        if constexpr (ALIGN_EPI) { if (wr == 1) PG8_BAR; }
    }
    PG8_WAIT_V(0);
    if constexpr (!ALIGN_EPI) { if (wr == 0) PG8_BAR; }
    PG8_BAR;
    if constexpr (Epi::AFTER_DRAIN) { E.fused(acc, cur, wr, wc, fr, fq, lds, wid, lane); S.done(cur); }
#undef PG8_SA
#undef PG8_SB
#undef PG8_STAGE
#undef PG8_LDA
#undef PG8_LDB
#undef PG8_MMA
#undef PG8_WAIT_V
#undef PG8_WAIT_L
#undef PG8_BAR
#undef PG8_SCHED
}
}

#define XB_TMO      128
#define XB_XCNT(j)  (256  + 64 * (j))
#define XB_XSUB(j)  (1280 + 64 * (j))
#define XB_XGEN(j)  (2304 + 64 * (j))
#define XB_TOP      3328
#define XB_TOPGEN   3392
#define XCD_BAR_WORDS 3456
#define XB_SPIN_CAP (1u << 18)

__device__ __forceinline__ unsigned xb_ld(unsigned* p)              { return __hip_atomic_load(p, __ATOMIC_RELAXED, __HIP_MEMORY_SCOPE_AGENT); }
__device__ __forceinline__ unsigned xb_add(unsigned* p, unsigned v) { return __hip_atomic_fetch_add(p, v, __ATOMIC_RELAXED, __HIP_MEMORY_SCOPE_AGENT); }
__device__ __forceinline__ unsigned xb_xcc_id() { return (unsigned)__builtin_amdgcn_s_getreg((3 << 11) | 20) & 0xFu; }
#define XB_SPIN(cond, bar) do { unsigned _sp = 0; while (cond) { __builtin_amdgcn_s_sleep(1); \
    if ((++_sp & 255u) == 0u) { if (xb_ld(&(bar)[XB_TMO])) break; if (_sp > XB_SPIN_CAP) { atomicAdd(&(bar)[XB_TMO], 1u); break; } } } } while (0)

struct XcdBarrier {
    unsigned* bar; unsigned x;
    volatile LAS unsigned* st;
};

__device__ __forceinline__ XcdBarrier xcd_barrier_post(unsigned* bar, volatile LAS unsigned* st) {
    XcdBarrier b; b.bar = bar; b.x = xb_xcc_id(); b.st = st;
    if (threadIdx.x == 0) (void)xb_add(&bar[XB_XCNT(b.x)], 1u);
    return b;
}
__device__ __forceinline__ void xcd_barrier_complete(unsigned* bar, unsigned x, unsigned& nloc, unsigned& nx) {
    const unsigned G = gridDim.x * gridDim.y * gridDim.z;
    unsigned sum, cnt, mine, sp = 0u;
    for (;;) {
        sum = 0u; cnt = 0u; mine = 0u;
#pragma unroll
        for (unsigned j = 0; j < 16; ++j) { const unsigned c = xb_ld(&bar[XB_XCNT(j)]); sum += c; cnt += (c > 0u) ? 1u : 0u; mine = (j == x) ? c : mine; }
        if (sum == G) break;
        __builtin_amdgcn_s_sleep(1);
        if ((++sp & 255u) == 0u) { if (xb_ld(&bar[XB_TMO])) break; if (sp > XB_SPIN_CAP) { atomicAdd(&bar[XB_TMO], 1u); break; } }
    }
    nloc = mine > 0u ? mine : 1u; nx = cnt > 0u ? cnt : 1u;
}

__device__ __forceinline__ void xcd_barrier(const XcdBarrier& b) {
    asm volatile("s_waitcnt vmcnt(0)" ::: "memory");
    __syncthreads();
    if (threadIdx.x == 0) {
        unsigned* bar = b.bar;
        __builtin_amdgcn_s_waitcnt(0);
        unsigned nloc = b.st[0], nx = b.st[1];
        if (nloc == 0u) { xcd_barrier_complete(bar, b.x, nloc, nx); b.st[0] = nloc; b.st[1] = nx; }
        const unsigned old = xb_add(&bar[XB_XSUB(b.x)], 1u);
        const unsigned gen = old / nloc;
        if (old + 1u == (gen + 1u) * nloc) {
            __builtin_amdgcn_fence(__ATOMIC_RELEASE, "agent");
            asm volatile("s_waitcnt vmcnt(0)" ::: "memory");
            const unsigned og = xb_add(&bar[XB_TOP], 1u);
            const unsigned tg = og / nx;
            if (og + 1u == (tg + 1u) * nx) xb_add(&bar[XB_TOPGEN], 1u);
            else XB_SPIN(xb_ld(&bar[XB_TOPGEN]) == tg, bar);
            __builtin_amdgcn_fence(__ATOMIC_ACQUIRE, "agent");
            xb_add(&bar[XB_XGEN(b.x)], 1u);
            asm volatile("s_waitcnt vmcnt(0)" ::: "memory");
        } else {
            XB_SPIN(xb_ld(&bar[XB_XGEN(b.x)]) == gen, bar);
            __builtin_amdgcn_fence(__ATOMIC_ACQUIRE, "agent");
            asm volatile("s_waitcnt vmcnt(0)" ::: "memory");
        }
    }
    __syncthreads();
}

constexpr int CW_BAR = 4096;
constexpr int LDS_MISC = LDS_BYTES - 256;
#define LAUNDER(v) asm volatile("" : "+s"(v))
__global__ void __launch_bounds__(NT, 2) k_mega(Ctx Carg) {
#if defined(__HIP_DEVICE_COMPILE__)
    extern __shared__ __attribute__((aligned(16))) unsigned char lds_raw[];
    LAS float* lds = (LAS float*)lds_raw;
    const int bid = blockIdx.x, nblk = gridDim.x;
    for (int u = threadIdx.x; u < 64; u += NT) ((LAS unsigned*)((LAS unsigned char*)lds_raw + LDS_MISC))[u] = 0u;
    __syncthreads();
    typedef const __attribute__((address_space(4))) Ctx* CtxCP;
    CtxCP Cp = (CtxCP)__builtin_amdgcn_kernarg_segment_ptr();
    const int wave_s = __builtin_amdgcn_readfirstlane(threadIdx.x >> 6);
    XcdBarrier bar = xcd_barrier_post((unsigned*)(Cp->ws + WS_CTL) + CW_BAR, (volatile LAS unsigned*)((LAS unsigned char*)lds_raw + LDS_MISC + 32));
#ifndef DUPMASK
#define DUPMASK 0
#endif
#ifndef PMASK
#define PMASK 0xFFFFF
#endif
#define SITE(k, ...) for (int rep_ = 0; rep_ < 1 + ((DUPMASK >> (k)) & 1); ++rep_) do { if (!((PMASK >> (k)) & 1)) break; CtxCP cp_ = Cp; LAUNDER(cp_); const Ctx C = *cp_; int ll = l; LAUNDER(ll); int wv_ = wave_s; LAUNDER(wv_); int tid_ = (wv_ << 6) | (int)__builtin_amdgcn_mbcnt_hi(~0u, __builtin_amdgcn_mbcnt_lo(~0u, 0u)); asm volatile("" : "+v"(tid_)); int bid_ = bid; LAUNDER(bid_); int nblk_ = nblk; LAUNDER(nblk_); \
        f16* H = (f16*)(C.ws + WS_H); f16* Zb = (f16*)(C.ws + WS_Z); f16* MIX = (f16*)(C.ws + WS_MIX); f16* Y = (f16*)(C.ws + WS_Y); f16* U = (f16*)(C.ws + WS_BIG); \
        (void)H; (void)Zb; (void)MIX; (void)Y; (void)U; __VA_ARGS__; } while (0); { XcdBarrier b_ = bar; LAUNDER(b_.x); LAUNDER(b_.bar); xcd_barrier(b_); }
    int l = 0;
    SITE(0, ph_mod(C, tid_, bid_, nblk_, lds); __syncthreads(); ph_rope(C, tid_, bid_, nblk_); ph_wcvt(C, tid_, bid_, nblk_, lds));
    SITE(1, ph_norm0(C, tid_, bid_, nblk_));
    for (l = 0; l < DEPTH; ++l) {
        SITE(2, { pg8::Gemm g{H, (const f16*)(C.ws + WS_W16 + (size_t)ll * W16_LAYER + W16_WIN), M, ZP, D}; pg8::StaticOrder S; S.init(M, ZP, nblk_, bid_); pg8::EpiF16<0> E{Zb, ZP}; pg8::gemm_phase<pg8::EpiF16<0>, pg8::StaticOrder, true, true>((LAS unsigned char*)lds, g, S, E, tid_); });
        SITE(3, ph_conv(C, ll, tid_, bid_, nblk_); ph_rotk(C, tid_, bid_, nblk_); ph_cmp1(C, ll, tid_, bid_, nblk_); ph_gla_local(C, ll, tid_, bid_, nblk_, (LAS unsigned char*)lds); ph_gmlp(C, ll, tid_, bid_, nblk_, (LAS unsigned char*)lds));
        SITE(4, ph_cmp2(C, ll, tid_, bid_, nblk_, lds); ph_gla_scan(C, tid_, bid_, nblk_));
        SITE(5, ph_nsa(C, ll, tid_, bid_, nblk_, lds); __syncthreads(); ph_gla_final(C, ll, tid_, bid_, nblk_, (LAS unsigned char*)lds));
        SITE(8, { pg8::Gemm g{MIX, (const f16*)(C.ws + WS_W16 + (size_t)ll * W16_LAYER + W16_WO), M, D, D}; pg8::StaticOrder S; S.init(M, D, nblk_, bid_); pg8::EpiF16<0> E{Y, D}; pg8::gemm_phase<pg8::EpiF16<0>, pg8::StaticOrder, true, true>((LAS unsigned char*)lds, g, S, E, tid_); });
        SITE(9, ph_resnorm(C, ll, 0, tid_, bid_, nblk_));
        SITE(10, { pg8::Gemm g{H, (const f16*)(C.ws + WS_W16 + (size_t)ll * W16_LAYER + W16_WUP), M, DFF, D}; pg8::StaticOrder S; S.init(M, DFF, nblk_, bid_); pg8::EpiF16<1> E{U, DFF}; pg8::gemm_phase<pg8::EpiF16<1>, pg8::StaticOrder, true, true>((LAS unsigned char*)lds, g, S, E, tid_); });
        SITE(11, { pg8::Gemm g{U, (const f16*)(C.ws + WS_W16 + (size_t)ll * W16_LAYER + W16_WDN), M, D, DFF}; pg8::StaticOrder S; S.init(M, D, nblk_, bid_); pg8::EpiF16<0> E{Y, D}; pg8::gemm_phase<pg8::EpiF16<0>, pg8::StaticOrder, true, true>((LAS unsigned char*)lds, g, S, E, tid_); });
        SITE(12, ph_resnorm(C, ll, 1, tid_, bid_, nblk_));
    }
#undef SITE
#endif
}

extern "C" void kernel_launch(void* const* d_in, const int* in_sizes, int n_in, void* d_out, int out_size, void* d_ws, size_t ws_size, hipStream_t stream) {
    static int grid = 0;
    if (grid == 0) {
        if (n_in != 19 || ws_size < WS_END) { fprintf(stderr, "kernel_launch: unexpected n_in %d / ws_size %zu\n", n_in, ws_size); grid = -1; return; }
        int dev = 0, cus = 0, per_cu = 0;
        if (hipGetDevice(&dev) != hipSuccess || hipDeviceGetAttribute(&cus, hipDeviceAttributeMultiprocessorCount, dev) != hipSuccess) { grid = -1; return; }
        if (hipFuncSetAttribute((const void*)k_mega, hipFuncAttributeMaxDynamicSharedMemorySize, LDS_BYTES) != hipSuccess) { fprintf(stderr, "hipFuncSetAttribute failed\n"); grid = -1; return; }
        if (hipOccupancyMaxActiveBlocksPerMultiprocessor(&per_cu, (const void*)k_mega, NT, LDS_BYTES) != hipSuccess || per_cu < 1) { fprintf(stderr, "occupancy query: %d\n", per_cu); }
        (void)hipGetLastError();
        grid = cus;
    }
    if (grid < 0) return;
    if (hipMemsetAsync((char*)d_ws + WS_CTL, 0, 1 * MiB, stream) != hipSuccess) return;
    Ctx c{};
    for (int i = 0; i < 19; ++i) c.in[i] = (const float*)d_in[i];
    c.out = (float*)d_out; c.ws = (unsigned char*)d_ws;
    hipLaunchKernelGGL(k_mega, dim3(grid), dim3(NT), LDS_BYTES, stream, c);
}
```

```cpp
#include <hip/hip_runtime.h>
#include <cstdint>
#include <cstdio>

#define LAS __attribute__((address_space(3)))
typedef _Float16 f16;
typedef f16 f16x4 __attribute__((ext_vector_type(4)));
typedef f16 f16x8 __attribute__((ext_vector_type(8)));
typedef float f32x4 __attribute__((ext_vector_type(4)));

constexpr int D = 1024, NB = 8, S = 4096, DEPTH = 4, M = NB * S, DFF = 4096;
constexpr int NIN = 2716, ZP = 2816;
constexpr int ZC_AH = 0, ZC_AB = 256, ZC_AC = 512, ZC_NQ = 768, ZC_KCMP = 1024, ZC_VCMP = 1088, ZC_KSLC = 1152, ZC_VSLC = 1216,
              ZC_KWIN = 1280, ZC_VWIN = 1344, ZC_NG = 1408, ZC_LQ = 1424, ZC_LK = 1552, ZC_LV = 1680, ZC_LG = 1936, ZC_LR = 2192,
              ZC_MU = 2208, ZC_MV = 2464;
constexpr int NCMP = 255;
constexpr float EPS = 1e-6f;
constexpr int NT = 512, NWAVE = 8;

constexpr size_t MiB = 1u << 20;
constexpr size_t WS_CTL = 0;
constexpr size_t WS_MOD = 1 * MiB;
constexpr size_t WS_ROPE = 2 * MiB;
constexpr size_t WS_W16 = 4 * MiB;
constexpr size_t WS_H = 98 * MiB;
constexpr size_t WS_Y = 162 * MiB;
constexpr size_t WS_BIG = 226 * MiB;
constexpr size_t WS_Z = WS_BIG;
constexpr size_t WS_MIX = WS_BIG + 176 * MiB;
constexpr size_t WS_KSR = WS_BIG + 240 * MiB;
constexpr size_t WS_KWR = WS_BIG + 244 * MiB;
constexpr size_t WS_HID = WS_BIG + 248 * MiB;
constexpr size_t WS_KC = WS_BIG + 251 * MiB;
constexpr size_t WS_VC = WS_BIG + 252 * MiB;
constexpr size_t WS_KC16 = WS_KC + 768 * 1024, WS_VC16 = WS_VC + 768 * 1024;
constexpr size_t WS_W1T = 498 * MiB;
constexpr size_t WS_WS16 = 502 * MiB;
constexpr size_t WS_PCB = 502 * MiB + 512 * 1024;
constexpr size_t WS_G = 503 * MiB;
constexpr size_t WS_END = 507 * MiB;
constexpr size_t WS_LA = WS_H;
constexpr size_t WS_QE2 = WS_H + 16 * MiB;
constexpr size_t WS_OI = WS_H + 32 * MiB;
constexpr size_t WS_KV = WS_Y;
constexpr size_t WS_SPREV = WS_Y + 16 * MiB;
constexpr size_t WS_VN = WS_Y + 32 * MiB;
constexpr size_t WS_TOTA = WS_H + 24 * MiB;

constexpr size_t W16_WIN = 0, W16_WO = (size_t)ZP * D * 2, W16_WUP = W16_WO + (size_t)D * D * 2, W16_WDN = W16_WUP + (size_t)DFF * D * 2, W16_LAYER = W16_WDN + (size_t)D * DFF * 2;
static_assert(WS_W16 + DEPTH * W16_LAYER <= WS_H, "weight copies fit below H");

constexpr int LDS_BYTES = 147456;

struct Ctx {
    const float* in[19];
    float* out;
    unsigned char* ws;
    int lo, hi;
};

__device__ __forceinline__ float wave_sum(float v) {
#pragma unroll
    for (int o = 32; o > 0; o >>= 1) v += __shfl_xor(v, o);
    return v;
}
__device__ __forceinline__ float wave_max(float v) {
#pragma unroll
    for (int o = 32; o > 0; o >>= 1) v = fmaxf(v, __shfl_xor(v, o));
    return v;
}
#define WAVE_LDS_SYNC() asm volatile("s_waitcnt lgkmcnt(0)" ::: "memory")
__device__ __forceinline__ float siluf(float v) { return v / (1.f + expf(-v)); }
__device__ __forceinline__ float sigmoidf_(float v) { return 1.f / (1.f + expf(-v)); }

typedef float f32x16 __attribute__((ext_vector_type(16)));
typedef short s16x4 __attribute__((ext_vector_type(4)));
typedef unsigned u32x4 __attribute__((ext_vector_type(4)));
__device__ __forceinline__ int crow(int r, int hi) { return (r & 3) + 8 * (r >> 2) + 4 * hi; }
__device__ __forceinline__ float pl32_max(float v) { auto rr = __builtin_amdgcn_permlane32_swap(__float_as_uint(v), __float_as_uint(v), false, false); return fmaxf(__uint_as_float(rr[0]), __uint_as_float(rr[1])); }
__device__ __forceinline__ float pl32_sum(float v) { auto rr = __builtin_amdgcn_permlane32_swap(__float_as_uint(v), __float_as_uint(v), false, false); return __uint_as_float(rr[0]) + __uint_as_float(rr[1]); }
__device__ __forceinline__ unsigned pl32_other(unsigned v, int hi) { auto rr = __builtin_amdgcn_permlane32_swap(v, v, false, false); return hi ? rr[0] : rr[1]; }
__device__ __forceinline__ s16x4 vtr(const LAS unsigned char* p) { return __builtin_bit_cast(s16x4, __builtin_amdgcn_ds_read_tr16_b64_v4i16((LAS s16x4*)p)); }
__device__ __forceinline__ void sincos_d(double a, double& s, double& c) {
    const double two_over_pi = 0.63661977236758134308, pio2_hi = 1.57079632679489655800e+00, pio2_lo = 6.12323399573676603587e-17;
    const double kq = rint(a * two_over_pi);
    double r = (a - kq * pio2_hi) - kq * pio2_lo;
    const double r2 = r * r;
    double sp = r * (1.0 + r2 * (-1.0 / 6 + r2 * (1.0 / 120 + r2 * (-1.0 / 5040 + r2 * (1.0 / 362880 + r2 * (-1.0 / 39916800 + r2 * (1.0 / 6227020800.0 + r2 * (-1.0 / 1307674368000.0))))))));
    double cp = 1.0 + r2 * (-0.5 + r2 * (1.0 / 24 + r2 * (-1.0 / 720 + r2 * (1.0 / 40320 + r2 * (-1.0 / 3628800 + r2 * (1.0 / 479001600.0 + r2 * (-1.0 / 87178291200.0 + r2 * (1.0 / 20922789888000.0))))))));
    const int q = ((int)kq) & 3;
    if (q == 0) { s = sp; c = cp; } else if (q == 1) { s = cp; c = -sp; } else if (q == 2) { s = -sp; c = -cp; } else { s = -cp; c = sp; }
}

__device__ __forceinline__ void ph_mod(const Ctx& C, int TID, int bid, int nblk, LAS float* lds) {
    const float* c = C.in[1]; const float* w_mod = C.in[15]; const float* b_mod = C.in[16];
    float* MOD = (float*)(C.ws + WS_MOD);
    LAS float* cs = lds;
    LAS float* red = lds + 8192;
    const int tid = TID, nn = tid & 63, kg = tid >> 6;
    __syncthreads();
    for (int idx = tid; idx < NB * D; idx += NT) cs[idx] = siluf(c[idx]);
    __syncthreads();
    for (int item = bid; item < DEPTH * (6 * D / 64); item += nblk) {
        const int l = item / (6 * D / 64), n = (item % (6 * D / 64)) * 64 + nn;
        const float* w = w_mod + (size_t)l * D * 6 * D + n;
        float acc[8];
#pragma unroll
        for (int b = 0; b < 8; ++b) acc[b] = 0.f;
        for (int k0 = kg * 128; k0 < kg * 128 + 128; k0 += 16) {
            float wv[16];
#pragma unroll
            for (int i = 0; i < 16; ++i) wv[i] = w[(size_t)(k0 + i) * 6 * D];
#pragma unroll
            for (int i = 0; i < 16; ++i)
#pragma unroll
                for (int b = 0; b < 8; ++b) acc[b] += cs[b * D + k0 + i] * wv[i];
        }
#pragma unroll
        for (int b = 0; b < 8; ++b) red[(kg * 8 + b) * 64 + nn] = acc[b];
        __syncthreads();
        { const int b = tid >> 6; float s = b_mod[l * 6 * D + n];
#pragma unroll
          for (int g = 0; g < 8; ++g) s += red[(g * 8 + b) * 64 + nn];
          MOD[(size_t)(l * NB + b) * 6 * D + n] = s; }
        __syncthreads();
    }
}
__device__ __forceinline__ void ph_rope(const Ctx& C, int TID, int bid, int nblk) {
    const int* pos = (const int*)C.in[2];
    float* RC = (float*)(C.ws + WS_ROPE); float* RS = RC + (size_t)M * 8;
    const double invf[8] = {1.0, 0.19392274474868576, 0.03760603093086393, 0.007292664737217109, 0.001414213562373095, 0.0002742481756762073, 5.318295896944988e-05, 1.031338537721246e-05};
    for (int idx = bid * NT + TID; idx < M * 8; idx += nblk * NT) {
        const int i = idx & 7, m = idx >> 3;
        double f = invf[0];
#pragma unroll
        for (int j = 1; j < 8; ++j) f = (i == j) ? invf[j] : f;
        double s, c; sincos_d((double)pos[m] * f, s, c);
        RC[idx] = (float)c; RS[idx] = (float)s;
    }
}
__device__ __forceinline__ void adaln_row(const float (&xv)[16], const float* g, const float* sc, const float* sh, f16* hrow, int lane) {
    float ss = 0.f;
#pragma unroll
    for (int j = 0; j < 16; ++j) ss += xv[j] * xv[j];
    const float r = rsqrtf(wave_sum(ss) * (1.f / D) + EPS);
#pragma unroll
    for (int j = 0; j < 4; ++j) {
        const int c0 = 256 * j + 4 * lane;
        const f32x4 gv = *(const f32x4*)(g + c0), scv = *(const f32x4*)(sc + c0), shv = *(const f32x4*)(sh + c0);
        f16x4 o;
#pragma unroll
        for (int e = 0; e < 4; ++e) o[e] = (f16)(xv[4 * j + e] * r * gv[e] * (1.f + scv[e]) + shv[e]);
        *(f16x4*)(hrow + c0) = o;
    }
}
__device__ __forceinline__ void ph_norm0(const Ctx& C, int TID, int bid, int nblk) {
    const float* x = C.in[0]; const float* norm_g = C.in[14]; const float* MOD = (const float*)(C.ws + WS_MOD);
    f16* H = (f16*)(C.ws + WS_H);
    const int lane = TID & 63, gw = bid * NWAVE + (TID >> 6), ngw = nblk * NWAVE;
    for (int m = gw; m < M; m += ngw) {
        const int b = m / S;
        float xv[16];
#pragma unroll
        for (int j = 0; j < 4; ++j) { const f32x4 v = *(const f32x4*)(x + (size_t)m * D + 256 * j + 4 * lane); xv[4 * j] = v[0]; xv[4 * j + 1] = v[1]; xv[4 * j + 2] = v[2]; xv[4 * j + 3] = v[3]; }
        const float* mod = MOD + (size_t)(0 * NB + b) * 6 * D;
        adaln_row(xv, norm_g + 0, mod + D, mod + 0, H + (size_t)m * D, lane);
    }
}
__device__ __forceinline__ void ph_resnorm(const Ctx& C, int l, int sub, int TID, int bid, int nblk) {
    const float* norm_g = C.in[14]; const float* MOD = (const float*)(C.ws + WS_MOD);
    const f16* Y = (const f16*)(C.ws + WS_Y); f16* H = (f16*)(C.ws + WS_H);
    const float* xsrc = (l == 0 && sub == 0) ? C.in[0] : C.out;
    const float* ga = norm_g + (size_t)(l * 4 + (sub == 0 ? 1 : 3)) * D;
    const bool has_next = !(l == DEPTH - 1 && sub == 1);
    const int ln = sub == 0 ? l : l + 1;
    const float* gb = norm_g + (size_t)((has_next ? ln : 0) * 4 + (sub == 0 ? 2 : 0)) * D;
    const int lane = TID & 63, gw = bid * NWAVE + (TID >> 6), ngw = nblk * NWAVE;
    for (int m = gw; m < M; m += ngw) {
        const int b = m / S;
        const float* mod = MOD + (size_t)(l * NB + b) * 6 * D;
        const float* gt = mod + (sub == 0 ? 2 : 5) * D;
        float yv[16], xv[16]; float ss = 0.f;
#pragma unroll
        for (int j = 0; j < 4; ++j) {
            const f16x4 v = *(const f16x4*)(Y + (size_t)m * D + 256 * j + 4 * lane);
#pragma unroll
            for (int e = 0; e < 4; ++e) { yv[4 * j + e] = (float)v[e]; ss += yv[4 * j + e] * yv[4 * j + e]; }
        }
        const float r = rsqrtf(wave_sum(ss) * (1.f / D) + EPS);
#pragma unroll
        for (int j = 0; j < 4; ++j) {
            const int c0 = 256 * j + 4 * lane;
            const f32x4 xo = *(const f32x4*)(xsrc + (size_t)m * D + c0), gav = *(const f32x4*)(ga + c0), gtv = *(const f32x4*)(gt + c0);
            f32x4 xn;
#pragma unroll
            for (int e = 0; e < 4; ++e) { xn[e] = xo[e] + gtv[e] * (yv[4 * j + e] * r * gav[e]); xv[4 * j + e] = xn[e]; }
            *(f32x4*)(C.out + (size_t)m * D + c0) = xn;
        }
        if (has_next) {
            const float* modn = MOD + (size_t)(ln * NB + b) * 6 * D;
            adaln_row(xv, gb, modn + (sub == 0 ? 4 : 1) * D, modn + (sub == 0 ? 3 : 0) * D, H + (size_t)m * D, lane);
        }
    }
}

__device__ __forceinline__ void ph_conv(const Ctx& C, int l, int TID, int bid, int nblk) {
    const f16* Z = (const f16*)(C.ws + WS_Z); f16* MIX = (f16*)(C.ws + WS_MIX);
    const float* cw = C.in[4] + (size_t)l * 3 * 256; const float* gain = C.in[12] + (size_t)l * D;
    const int lane = TID & 63, cl = lane & 31, h2 = lane >> 5, gw = bid * NWAVE + (TID >> 6), ngw = nblk * NWAVE;
    float w0[8], w1[8], w2[8], gn[8];
#pragma unroll
    for (int e = 0; e < 8; ++e) { w0[e] = cw[8 * cl + e]; w1[e] = cw[256 + 8 * cl + e]; w2[e] = cw[512 + 8 * cl + e]; gn[e] = gain[8 * cl + e]; }
    for (int unit = gw; unit < M / 16; unit += ngw) {
        const size_t mb = (size_t)unit * 16 + 8 * h2; const int t0 = (int)(mb % S);
        float z1[8], z2[8];
        {
            f16x8 h1 = {}, c1 = {}, hh2 = {}, c2 = {};
            if (t0 >= 1) { h1 = *(const f16x8*)(Z + (mb - 1) * ZP + ZC_AH + 8 * cl); c1 = *(const f16x8*)(Z + (mb - 1) * ZP + ZC_AC + 8 * cl); }
            if (t0 >= 2) { hh2 = *(const f16x8*)(Z + (mb - 2) * ZP + ZC_AH + 8 * cl); c2 = *(const f16x8*)(Z + (mb - 2) * ZP + ZC_AC + 8 * cl); }
#pragma unroll
            for (int e = 0; e < 8; ++e) { z1[e] = (float)h1[e] * (float)c1[e]; z2[e] = (float)hh2[e] * (float)c2[e]; }
        }
        f16x8 ah[8], ac[8], ab[8];
#pragma unroll
        for (int i = 0; i < 8; ++i) { const f16* zr = Z + (mb + i) * ZP + 8 * cl; ah[i] = *(const f16x8*)(zr + ZC_AH); ac[i] = *(const f16x8*)(zr + ZC_AC); ab[i] = *(const f16x8*)(zr + ZC_AB); }
#pragma unroll
        for (int i = 0; i < 8; ++i) {
            float o[8]; float ss = 0.f;
#pragma unroll
            for (int e = 0; e < 8; ++e) { const float z0 = (float)ah[i][e] * (float)ac[i][e]; o[e] = (float)ab[i][e] * (w0[e] * z2[e] + w1[e] * z1[e] + w2[e] * z0); ss += o[e] * o[e]; z2[e] = z1[e]; z1[e] = z0; }
#pragma unroll
            for (int off = 1; off < 32; off <<= 1) ss += __shfl_xor(ss, off);
            const float r = rsqrtf(ss * (1.f / 256) + EPS);
            f16x8 ov;
#pragma unroll
            for (int e = 0; e < 8; ++e) ov[e] = (f16)(o[e] * r * gn[e]);
            *(f16x8*)(MIX + (mb + i) * D + 8 * cl) = ov;
        }
    }
}
__device__ __forceinline__ void ph_rotk(const Ctx& C, int TID, int bid, int nblk) {
    const f16* Z = (const f16*)(C.ws + WS_Z); f16* KSR = (f16*)(C.ws + WS_KSR); f16* KWR = (f16*)(C.ws + WS_KWR);
    const float* RC = (const float*)(C.ws + WS_ROPE); const float* RS = RC + (size_t)M * 8;
    const int lane = TID & 63, ch = lane & 7, tk = lane >> 3, gw = bid * NWAVE + (TID >> 6), ngw = nblk * NWAVE;
    for (int unit = gw; unit < M / 8; unit += ngw) {
        const size_t m = (size_t)unit * 8 + tk;
        f16x8 v[2];
        v[0] = *(const f16x8*)(Z + m * ZP + ZC_KSLC + 8 * ch); v[1] = *(const f16x8*)(Z + m * ZP + ZC_KWIN + 8 * ch);
        const f32x4 c0 = *(const f32x4*)(RC + m * 8), c1 = *(const f32x4*)(RC + m * 8 + 4), s0 = *(const f32x4*)(RS + m * 8), s1 = *(const f32x4*)(RS + m * 8 + 4);
#pragma unroll
        for (int w = 0; w < 2; ++w) {
            const u32x4 own = __builtin_bit_cast(u32x4, v[w]); u32x4 oth;
#pragma unroll
            for (int k = 0; k < 4; ++k) oth[k] = __shfl_xor(own[k], 1);
            const f16x8 of = __builtin_bit_cast(f16x8, oth);
            if (ch < 2) {
#pragma unroll
                for (int i = 0; i < 8; ++i) {
                    const float cs = i < 4 ? c0[i & 3] : c1[i & 3], sn = i < 4 ? s0[i & 3] : s1[i & 3];
                    const float a = (float)v[w][i], bq = (float)of[i];
                    v[w][i] = (f16)(ch ? a * cs + bq * sn : a * cs - bq * sn);
                }
            }
        }
        *(f16x8*)(KSR + m * 64 + 8 * ch) = v[0]; *(f16x8*)(KWR + m * 64 + 8 * ch) = v[1];
    }
}
__device__ __forceinline__ void ph_cmp1(const Ctx& C, int l, int TID, int bid, int nblk) {
    const f16* Z = (const f16*)(C.ws + WS_Z); float* G = (float*)(C.ws + WS_G);
    const f16* W1T = (const f16*)(C.ws + WS_W1T) + (size_t)l * 2 * 256 * 1024;
    const int lane = TID & 63, r32 = lane & 31, hi = lane >> 5, gw = bid * NWAVE + (TID >> 6), ngw = nblk * NWAVE;
    for (int it = gw; it < 2 * 64 * 8; it += ngw) {
        const int ct = it & 7, rt = (it >> 3) & 63, j = it >> 9;
        const int row = rt * 32 + r32;
        const f16* ap = Z + ((size_t)(row >> 8) * S + 16 * (row & 255)) * ZP + (j ? ZC_VCMP : ZC_KCMP) + 8 * hi;
        const f16* bp = W1T + ((size_t)j * 256 + ct * 32 + r32) * 1024 + 8 * hi;
        f32x16 acc;
#pragma unroll
        for (int r = 0; r < 16; ++r) acc[r] = 0.f;
        for (int k8 = 0; k8 < 64; k8 += 8) {
            f16x8 av[8], bv[8];
#pragma unroll
            for (int i = 0; i < 8; ++i) { const int ks = k8 + i; av[i] = *(const f16x8*)(ap + (size_t)(ks >> 2) * ZP + (ks & 3) * 16); bv[i] = *(const f16x8*)(bp + ks * 16); }
#pragma unroll
            for (int i = 0; i < 8; ++i) acc = __builtin_amdgcn_mfma_f32_32x32x16_f16(av[i], bv[i], acc, 0, 0, 0);
        }
        float* gp = G + ((size_t)j * 2048 + rt * 32) * 256 + ct * 32 + r32;
#pragma unroll
        for (int r = 0; r < 16; ++r) gp[(size_t)crow(r, hi) * 256] = acc[r];
    }
}
__device__ __forceinline__ void ph_cmp2(const Ctx& C, int l, int TID, int bid, int nblk, LAS float* lds) {
    const float* G = (const float*)(C.ws + WS_G); const float* PCB = (const float*)(C.ws + WS_PCB) + (size_t)l * 2 * 32 * 128;
    float* KC = (float*)(C.ws + WS_KC); float* VC = (float*)(C.ws + WS_VC);
    const float* w2 = C.in[7] + (size_t)l * 2 * 128 * 64;
    LAS float* w2s = lds;
    LAS float* cbs = lds + 16384;
    LAS float* hs = lds + 16640 + (TID >> 6) * 128;
    const int tid = TID, lane = tid & 63, gw = bid * NWAVE + (tid >> 6), ngw = nblk * NWAVE;
    __syncthreads();
    for (int idx = tid; idx < 2 * 128 * 64; idx += NT) w2s[idx] = w2[idx];
    if (tid < 256) { float s = 0.f; for (int q = 0; q < 32; ++q) s += PCB[((tid >> 7) * 32 + q) * 128 + (tid & 127)]; cbs[tid] = s; }
    __syncthreads();
    for (int it = gw; it < 2 * NB * NCMP; it += ngw) {
        const int j = it / (NB * NCMP), bi = it % (NB * NCMP), b = bi / NCMP, i = bi % NCMP;
        const float* g0 = G + ((size_t)j * 2048 + b * 256 + i) * 256;
#pragma unroll
        for (int q = 0; q < 2; ++q) { const int o = lane + 64 * q; hs[o] = siluf(g0[o] + g0[256 + 128 + o] + cbs[j * 128 + o]); }
        WAVE_LDS_SYNC();
        float acc = 0.f;
#pragma unroll 16
        for (int o = 0; o < 128; ++o) acc += hs[o] * w2s[(j * 128 + o) * 64 + lane];
        (j ? VC : KC)[(size_t)bi * 64 + lane] = acc;
        ((f16*)(C.ws + (j ? WS_VC16 : WS_KC16)))[((size_t)b * 256 + i) * 64 + lane] = (f16)acc;
        WAVE_LDS_SYNC();
    }
    for (int it = gw; it < 2 * NB; it += ngw) ((f16*)(C.ws + ((it & 1) ? WS_VC16 : WS_KC16)))[((size_t)(it >> 1) * 256 + 255) * 64 + lane] = (f16)0.f;
}
constexpr float NSA_C2 = 0.125f * 1.4426950408889634f;

#define NSA_ISSUE(Kg, Vg, vpitch, jt, koff, voff) do { \
        int ln_ = lane; asm volatile("" : "+v"(ln_)); \
        const f16* ksrc_ = (Kg) + (size_t)(64 * (jt) + ln_) * 64 + wid * 8; \
        const f16* vsrc_ = (Vg) + (size_t)(64 * (jt) + 16 * (wid & 3) + (ln_ >> 2)) * (vpitch) + (wid >> 2) * 32 + (ln_ & 3) * 8; \
        __builtin_amdgcn_global_load_lds((const unsigned*)ksrc_, (LAS unsigned*)(lds + (koff) + wid * 1024), 16, 0, 0); \
        __builtin_amdgcn_global_load_lds((const unsigned*)vsrc_, (LAS unsigned*)(lds + (voff) + wid * 1024), 16, 0, 0); } while (0)
#define NSA_QKT(p0, p1, kb, qf) do { \
        _Pragma("unroll") for (int r_ = 0; r_ < 16; ++r_) { p0[r_] = 0.f; p1[r_] = 0.f; } \
        _Pragma("unroll") for (int d0_ = 0; d0_ < 4; ++d0_) { \
            const f16x8 k0_ = *(const LAS f16x8*)((kb) + d0_ * 2048), k1_ = *(const LAS f16x8*)((kb) + d0_ * 2048 + 512); \
            p0 = __builtin_amdgcn_mfma_f32_32x32x16_f16(k0_, qf[d0_], p0, 0, 0, 0); \
            p1 = __builtin_amdgcn_mfma_f32_32x32x16_f16(k1_, qf[d0_], p1, 0, 0, 0); } } while (0)
#define NSA_PV(o, p0, p1, vs) do { \
        f16x8 pa_[4]; \
        _Pragma("unroll") for (int e_ = 0; e_ < 8; ++e_) { pa_[0][e_] = (f16)p0[e_]; pa_[1][e_] = (f16)p0[8 + e_]; pa_[2][e_] = (f16)p1[e_]; pa_[3][e_] = (f16)p1[8 + e_]; } \
        _Pragma("unroll") for (int d0_ = 0; d0_ < 2; ++d0_) \
            _Pragma("unroll") for (int ks_ = 0; ks_ < 4; ++ks_) { \
                const s16x4 lo_ = vtr((vs) + d0_ * 4096 + ks_ * 1024), hh_ = vtr((vs) + d0_ * 4096 + ks_ * 1024 + 512); \
                const s16x8 bv_ = {lo_[0], lo_[1], lo_[2], lo_[3], hh_[0], hh_[1], hh_[2], hh_[3]}; \
                o[d0_] = __builtin_amdgcn_mfma_f32_32x32x16_f16(pa_[ks_], __builtin_bit_cast(f16x8, bv_), o[d0_], 0, 0, 0); } } while (0)
typedef short s16x8 __attribute__((ext_vector_type(8)));
#ifndef NSA_DUP
#define NSA_DUP 0
#endif

template <int MODE>
__device__ __forceinline__ void nsa_branch(const f16* Kg, const f16* Vg, int c, unsigned long long sel, int tokw, const f16x8 (&qf)[4], f32x16 (&o)[2], float& lsum,
                                           LAS unsigned char* lds, LAS float* wsf, int wid, int lane, int r32, int hi) {
    const float NEG = -__builtin_inff();
    float mhat = 0.f; lsum = 0.f;
#pragma unroll
    for (int r = 0; r < 16; ++r) { o[0][r] = 0.f; o[1][r] = 0.f; }
    const int ntiles = MODE == 0 ? c + 1 : (c < 8 ? c + 1 : 9);
    const LAS unsigned char* vlane = lds + 16384 + ((lane >> 4) & 1) * 32 + (lane & 3) * 8 + (4 * hi + ((lane & 15) >> 2)) * 64;
    const LAS unsigned char* klane = lds + hi * 1024 + r32 * 16;
#define NSA_TILE(i_) (MODE == 0 ? (i_) : c - (i_))
    NSA_ISSUE(Kg, Vg, ZP, NSA_TILE(0), 0, 16384);
    for (int i = 0; i < ntiles; ++i) {
        const int j = NSA_TILE(i), slot = (i & 1) * 8192;
        asm volatile("s_waitcnt vmcnt(0)" ::: "memory");
        __syncthreads();
        if (i + 1 < ntiles) NSA_ISSUE(Kg, Vg, ZP, NSA_TILE(i + 1), slot ^ 8192, 16384 + (slot ^ 8192));
        f16x8 kf[8];
#pragma unroll
        for (int q = 0; q < 8; ++q) kf[q] = *(const LAS f16x8*)(klane + slot + (q >> 1) * 2048 + (q & 1) * 512);
        const bool rowsel = MODE == 0 ? ((sel >> j) & 1ull) != 0ull : true;
        const float cv = rowsel ? -mhat : NEG;
        f32x16 p0, p1, cin;
#pragma unroll
        for (int r = 0; r < 16; ++r) cin[r] = cv;
        __builtin_amdgcn_sched_barrier(0);
        p0 = __builtin_amdgcn_mfma_f32_32x32x16_f16(kf[0], qf[0], cin, 0, 0, 0);
        p1 = __builtin_amdgcn_mfma_f32_32x32x16_f16(kf[1], qf[0], cin, 0, 0, 0);
#pragma unroll
        for (int d0 = 1; d0 < 4; ++d0) {
            p0 = __builtin_amdgcn_mfma_f32_32x32x16_f16(kf[2 * d0], qf[d0], p0, 0, 0, 0);
            p1 = __builtin_amdgcn_mfma_f32_32x32x16_f16(kf[2 * d0 + 1], qf[d0], p1, 0, 0, 0);
        }
        s16x4 vf[16];
#pragma unroll
        for (int q = 0; q < 16; ++q) vf[q] = vtr(vlane + slot + (q >> 3) * 4096 + ((q >> 1) & 3) * 1024 + (q & 1) * 512);
        __builtin_amdgcn_sched_barrier(0);
        if (j == c) {
#pragma unroll
            for (int r = 0; r < 16; ++r) { const int kk = crow(r, hi); if (kk > tokw) p0[r] = NEG; if (kk + 32 > tokw) p1[r] = NEG; }
        }
        if (MODE == 1 && j == c - 8) {
#pragma unroll
            for (int r = 0; r < 16; ++r) { const int kk = crow(r, hi); if (kk <= tokw) p0[r] = NEG; if (kk + 32 <= tokw) p1[r] = NEG; }
        }
        float rm = fmaxf(fmaxf(p0[0], p1[0]), fmaxf(p0[1], p1[1]));
#pragma unroll
        for (int r = 2; r < 16; r += 2) rm = fmaxf(rm, fmaxf(fmaxf(p0[r], p1[r]), fmaxf(p0[r + 1], p1[r + 1])));
        rm = pl32_max(rm);
        if (__any(rm > 8.0f)) {
            const float dl = fmaxf(rm, 0.f);
            mhat += dl;
#pragma unroll
            for (int r = 0; r < 16; ++r) { p0[r] -= dl; p1[r] -= dl; }
            const float f = __builtin_amdgcn_exp2f(-dl);
            lsum *= f;
            if (hi == 0) wsf[r32] = f;
            WAVE_LDS_SYNC();
#pragma unroll
            for (int r = 0; r < 16; ++r) { const float fr = wsf[crow(r, hi)]; o[0][r] *= fr; o[1][r] *= fr; }
            WAVE_LDS_SYNC();
        }
        float ps0 = 0.f, ps1 = 0.f;
#pragma unroll
        for (int r = 0; r < 16; ++r) { p0[r] = __builtin_amdgcn_exp2f(p0[r]); p1[r] = __builtin_amdgcn_exp2f(p1[r]); ps0 += p0[r]; ps1 += p1[r]; }
        lsum += ps0 + ps1;
        f16x8 pa[4];
#pragma unroll
        for (int e = 0; e < 8; ++e) { pa[0][e] = (f16)p0[e]; pa[1][e] = (f16)p0[8 + e]; pa[2][e] = (f16)p1[e]; pa[3][e] = (f16)p1[8 + e]; }
        __builtin_amdgcn_sched_barrier(0);
#pragma unroll
        for (int d0 = 0; d0 < 2; ++d0)
#pragma unroll
            for (int ks = 0; ks < 4; ++ks) {
                const s16x4 lo = vf[d0 * 8 + ks * 2], hh = vf[d0 * 8 + ks * 2 + 1];
                const s16x8 bv = {lo[0], lo[1], lo[2], lo[3], hh[0], hh[1], hh[2], hh[3]};
                o[d0] = __builtin_amdgcn_mfma_f32_32x32x16_f16(pa[ks], __builtin_bit_cast(f16x8, bv), o[d0], 0, 0, 0);
            }
    }
#undef NSA_TILE
    __syncthreads();
}

constexpr int NSA_WS_OFF = 65536;
__device__ __forceinline__ void nsa_unit(const Ctx& C, int l, int b, int c, int TID, LAS unsigned char* lds) {
    const f16* Z = (const f16*)(C.ws + WS_Z); f16* MIX = (f16*)(C.ws + WS_MIX);
    const f16* KSR = (const f16*)(C.ws + WS_KSR); const f16* KWR = (const f16*)(C.ws + WS_KWR);
    const f16* KC16 = (const f16*)(C.ws + WS_KC16) + (size_t)b * 256 * 64; const f16* VC16 = (const f16*)(C.ws + WS_VC16) + (size_t)b * 256 * 64;
    const float* RC = (const float*)(C.ws + WS_ROPE); const float* RS = RC + (size_t)M * 8;
    const float* gain = C.in[12] + (size_t)l * D + 256;
    float* TOTA = (float*)(C.ws + WS_TOTA);
    const int tid = TID, lane = tid & 63, wid = __builtin_amdgcn_readfirstlane(tid >> 6), r32 = lane & 31, hi = lane >> 5;
    const size_t m0 = (size_t)b * S + 64 * c;
    const int tokw = 8 * wid + (r32 >> 2), head = r32 & 3;
    const size_t mrow = m0 + tokw;
#define TOTP(r_) ({ int rr_ = r32; asm volatile("" : "+v"(rr_)); TOTA + (m0 + 8 * wid) * 256 + (size_t)crow((r_), hi) * 64 + rr_; })
#define ZROW() ({ size_t mr_ = mrow; asm volatile("" : "+v"(mr_)); Z + mr_ * ZP; })
    const float NEG = -__builtin_inff();
    LAS float* wsb = (LAS float*)(lds + NSA_WS_OFF) + wid * 1280;
    LAS float* wsf = wsb; LAS float* Aa = wsb + 64; LAS float* Bb = wsb + 576; LAS float* Ssc = wsb + 1100; LAS unsigned long long* SELW = (LAS unsigned long long*)(wsb + 1168);
    f32x16 tot[2], o[2];
    unsigned long long sel;
    for (int repc = 0; repc < ((NSA_DUP & 1) ? 2 : 1); ++repc) {
        f16x8 qc[4];
#pragma unroll
        for (int d0 = 0; d0 < 4; ++d0) { const f16x8 qv = *(const f16x8*)(ZROW() + ZC_NQ + 64 * head + 16 * d0 + 8 * hi);
#pragma unroll
            for (int i = 0; i < 8; ++i) qc[d0][i] = (f16)((float)qv[i] * NSA_C2); }
        const int nct = (4 * c + 3 + 63) >> 6;
        for (int T = 0; T < nct; ++T) NSA_ISSUE(KC16, VC16, 64, T, T * 8192, 32768 + T * 8192);
        for (int i = lane; i < 1036; i += 64) Aa[i] = 0.f;
        asm volatile("s_waitcnt vmcnt(0)" ::: "memory");
        __syncthreads();
        const int t = 64 * c + tokw, imax = t >= 31 ? (t - 31) >> 4 : -1;
        const LAS unsigned char* kb0 = lds + hi * 1024 + r32 * 16;
        const LAS unsigned char* vl0 = lds + 32768 + ((lane >> 4) & 1) * 32 + (lane & 3) * 8 + (4 * hi + ((lane & 15) >> 2)) * 64;
        float m = NEG, lsum = 0.f;
        for (int T = 0; T < nct; ++T) {
            f32x16 p0, p1;
            NSA_QKT(p0, p1, kb0 + T * 8192, qc);
            float rm = NEG;
#pragma unroll
            for (int r = 0; r < 16; ++r) { const int i0 = 64 * T + crow(r, hi); p0[r] = i0 <= imax ? p0[r] : NEG; p1[r] = i0 + 32 <= imax ? p1[r] : NEG; rm = fmaxf(rm, fmaxf(p0[r], p1[r])); }
            rm = pl32_max(rm);
            const float mnew = fmaxf(m, rm), msafe = mnew == NEG ? 0.f : mnew;
            float ps = 0.f;
#pragma unroll
            for (int r = 0; r < 16; ++r) ps += __builtin_amdgcn_exp2f(p0[r] - msafe) + __builtin_amdgcn_exp2f(p1[r] - msafe);
            lsum = lsum * __builtin_amdgcn_exp2f(m - msafe) + ps; m = mnew;
        }
        const float ltot = pl32_sum(lsum), inv = ltot > 0.f ? 1.f / ltot : 0.f, msafe = m == NEG ? 0.f : m;
#pragma unroll
        for (int r = 0; r < 16; ++r) { o[0][r] = 0.f; o[1][r] = 0.f; }
        for (int T = 0; T < nct; ++T) {
            f32x16 p0, p1;
            NSA_QKT(p0, p1, kb0 + T * 8192, qc);
#pragma unroll
            for (int r = 0; r < 16; ++r) { const int i0 = 64 * T + crow(r, hi);
                p0[r] = i0 <= imax ? __builtin_amdgcn_exp2f(p0[r] - msafe) * inv : 0.f; p1[r] = i0 + 32 <= imax ? __builtin_amdgcn_exp2f(p1[r] - msafe) * inv : 0.f; }
#pragma unroll
            for (int k = 0; k < 4; ++k) {
                float a0 = 2.f * (p0[4 * k] + p0[4 * k + 1] + p0[4 * k + 2]) + p0[4 * k + 3], b0 = p0[4 * k + 3];
                float a1 = 2.f * (p1[4 * k] + p1[4 * k + 1] + p1[4 * k + 2]) + p1[4 * k + 3], b1 = p1[4 * k + 3];
                a0 += __shfl_xor(a0, 1); a0 += __shfl_xor(a0, 2); b0 += __shfl_xor(b0, 1); b0 += __shfl_xor(b0, 2);
                a1 += __shfl_xor(a1, 1); a1 += __shfl_xor(a1, 2); b1 += __shfl_xor(b1, 1); b1 += __shfl_xor(b1, 2);
                if (head == 0) { const int g = 16 * T + 2 * k + hi, tl = r32 >> 2;
                    Aa[tl * 64 + g] = a0; Bb[tl * 65 + g + 1] = b0; Aa[tl * 64 + g + 8] = a1; Bb[tl * 65 + g + 9] = b1; }
            }
            NSA_PV(o, p0, p1, vl0 + T * 8192);
        }
        {
            const float f = sigmoidf_((float)ZROW()[ZC_NG + 3 * head + 0]);
            if (hi == 0) wsf[r32] = f;
            WAVE_LDS_SYNC();
#pragma unroll
            for (int r = 0; r < 16; ++r) { const float fr = wsf[crow(r, hi)]; TOTP(r)[0] = o[0][r] * fr; TOTP(r)[32] = o[1][r] * fr; }
            WAVE_LDS_SYNC();
        }
        if (c >= 16) {
            for (int tk = 0; tk < 8; ++tk) {
                const bool forced = (lane < 1) || (c - lane >= 0 && c - lane < 2);
                const float sc = (lane <= c) ? Aa[tk * 64 + lane] + Bb[tk * 65 + lane] + (forced ? 1e4f : 0.f) : -1e30f;
                Ssc[lane] = sc;
                WAVE_LDS_SYNC();
                int rank = 0;
#pragma unroll 4
                for (int q = 0; q < 16; ++q) { const f32x4 v = *(const LAS f32x4*)(Ssc + 4 * q);
#pragma unroll
                    for (int e = 0; e < 4; ++e) rank += v[e] > sc ? 1 : 0; }
                const unsigned long long mk = __ballot(rank < 16);
                if (lane == 0) SELW[tk] = mk;
                WAVE_LDS_SYNC();
            }
            sel = SELW[r32 >> 2];
        } else sel = (2ull << c) - 1ull;
        __syncthreads();
    }
    f16x8 qf[4];
#pragma unroll
    for (int d0 = 0; d0 < 4; ++d0) qf[d0] = *(const f16x8*)(ZROW() + ZC_NQ + 64 * head + 16 * d0 + 8 * hi);
    {
        const u32x4 w = __builtin_bit_cast(u32x4, qf[0]); u32x4 ow;
#pragma unroll
        for (int k = 0; k < 4; ++k) ow[k] = pl32_other(w[k], hi);
        const f16x8 of = __builtin_bit_cast(f16x8, ow);
        size_t mr2 = mrow; asm volatile("" : "+v"(mr2));
        const f32x4 c0 = *(const f32x4*)(RC + mr2 * 8), c1 = *(const f32x4*)(RC + mr2 * 8 + 4), s0 = *(const f32x4*)(RS + mr2 * 8), s1 = *(const f32x4*)(RS + mr2 * 8 + 4);
#pragma unroll
        for (int i = 0; i < 8; ++i) {
            const float cs = i < 4 ? c0[i & 3] : c1[i & 3], sn = i < 4 ? s0[i & 3] : s1[i & 3];
            const float a = (float)qf[0][i], bq = (float)of[i];
            const float r = hi ? a * cs + bq * sn : a * cs - bq * sn;
            qf[0][i] = (f16)(r * NSA_C2);
        }
#pragma unroll
        for (int d0 = 1; d0 < 4; ++d0)
#pragma unroll
            for (int i = 0; i < 8; ++i) qf[d0][i] = (f16)((float)qf[d0][i] * NSA_C2);
    }
    float lsum;
    for (int rep = 0; rep < ((NSA_DUP & 2) ? 2 : 1); ++rep)
    nsa_branch<0>(KSR + (size_t)b * S * 64, Z + (size_t)b * S * ZP + ZC_VSLC, c, sel, tokw, qf, o, lsum, lds, wsf, wid, lane, r32, hi);
    {
        const float f = sigmoidf_((float)ZROW()[ZC_NG + 3 * head + 1]) / pl32_sum(lsum);
        if (hi == 0) wsf[r32] = f;
        WAVE_LDS_SYNC();
#pragma unroll
        for (int r = 0; r < 16; ++r) { const float fr = wsf[crow(r, hi)]; float* tp = TOTP(r); tp[0] += o[0][r] * fr; tp[32] += o[1][r] * fr; }
        WAVE_LDS_SYNC();
    }
    for (int rep = 0; rep < ((NSA_DUP & 4) ? 2 : 1); ++rep)
    nsa_branch<1>(KWR + (size_t)b * S * 64, Z + (size_t)b * S * ZP + ZC_VWIN, c, sel, tokw, qf, o, lsum, lds, wsf, wid, lane, r32, hi);
    {
        const float f = sigmoidf_((float)ZROW()[ZC_NG + 3 * head + 2]) / pl32_sum(lsum);
        if (hi == 0) wsf[r32] = f;
        WAVE_LDS_SYNC();
#pragma unroll
        for (int r = 0; r < 16; ++r) { const float fr = wsf[crow(r, hi)]; const float* tp = TOTP(r); tot[0][r] = tp[0] + o[0][r] * fr; tot[1][r] = tp[32] + o[1][r] * fr; }
        WAVE_LDS_SYNC();
    }
    int r32s = r32; asm volatile("" : "+v"(r32s));
#pragma unroll
    for (int k = 0; k < 4; ++k) {
        const size_t mm = m0 + 8 * wid + 2 * k + hi;
        float ss = 0.f;
#pragma unroll
        for (int hd = 0; hd < 4; ++hd)
#pragma unroll
            for (int d0 = 0; d0 < 2; ++d0) { const float v = tot[d0][4 * k + hd]; ss += v * v; }
#pragma unroll
        for (int off = 1; off < 32; off <<= 1) ss += __shfl_xor(ss, off);
        const float rinv = rsqrtf(ss * (1.f / 256) + EPS);
#pragma unroll
        for (int hd = 0; hd < 4; ++hd)
#pragma unroll
            for (int d0 = 0; d0 < 2; ++d0) MIX[mm * D + 256 + 64 * hd + 32 * d0 + r32s] = (f16)(tot[d0][4 * k + hd] * rinv * gain[64 * hd + 32 * d0 + r32s]);
    }
}
#undef ZROW
#undef TOTP
__device__ __forceinline__ void ph_nsa(const Ctx& C, int l, int TID, int bid, int nblk, LAS float* lds) {
    for (int item = bid; item < 256; item += nblk) {
        const int b = item >> 5, s = item & 31;
        for (int u = 0; u < 2; ++u) {
            const int c = u == 0 ? s : 63 - s;
            __syncthreads();
            nsa_unit(C, l, b, c, TID, (LAS unsigned char*)lds);
        }
    }
}
constexpr size_t WS_QE2H = WS_H;
constexpr size_t WS_OI16 = WS_H + 8 * MiB;
constexpr size_t WS_SPT = WS_Y + 16 * MiB;
constexpr size_t WS_DEC = WS_Y + 24 * MiB;
__device__ __forceinline__ void ph_gla_local(const Ctx& C, int l, int TID, int bid, int nblk, LAS unsigned char* lds) {
    const f16* Z = (const f16*)(C.ws + WS_Z);
    f16* QE2H = (f16*)(C.ws + WS_QE2H); f16* OI16 = (f16*)(C.ws + WS_OI16); float* KV = (float*)(C.ws + WS_KV); float* DEC = (float*)(C.ws + WS_DEC);
    const float* w2 = C.in[8] + (size_t)l * 16 * 128; const float* gb = C.in[9] + (size_t)l * 128;
    const int tid = TID, lane = tid & 63, wid = __builtin_amdgcn_readfirstlane(tid >> 6), r32 = lane & 31, hi = lane >> 5;
    const int dim = tid & 127, tq = tid >> 7, hh = dim >> 5, dd = dim & 31;
    LAS float* LR = (LAS float*)lds; LAS float* TOT = (LAS float*)(lds + 4096); LAS float* BM = (LAS float*)(lds + 6144); LAS float* BL = (LAS float*)(lds + 6656);
    constexpr int QE_OFF = 8192, KE_OFF = 24576, K2_OFF = 40960, V_OFF = 57344, QK_OFF = 90112;
    float w2c[16];
#pragma unroll
    for (int r = 0; r < 16; ++r) w2c[r] = w2[r * 128 + dim];
    const float bias = gb[dim];
    for (int item = bid; item < M / 64; item += nblk) {
        const size_t m0 = (size_t)item * 64; const int b = item >> 6, n = item & 63;
        __syncthreads();
#pragma unroll
        for (int it = 0; it < 2; ++it) { const int q = tid + NT * it; LR[q] = (float)Z[(m0 + (q >> 4)) * ZP + ZC_LR + (q & 15)]; }
#pragma unroll
        for (int it = 0; it < 4; ++it) { const int q = tid + NT * it, s = q >> 5, h4 = (q >> 3) & 3, ch = q & 7;
            *(LAS f16x8*)(lds + V_OFF + h4 * 8192 + (ch >> 2) * 4096 + s * 64 + (ch & 3) * 16) = *(const f16x8*)(Z + (m0 + s) * ZP + ZC_LV + 64 * h4 + 8 * ch); }
#pragma unroll
        for (int it = 0; it < 4; ++it) { const int q = tid + NT * it, s = q >> 5, ch = q & 31;
            *(LAS f16x8*)(lds + QK_OFF + s * 512 + ch * 16) = *(const f16x8*)(Z + (m0 + s) * ZP + ZC_LQ + 8 * ch); }
        __syncthreads();
        float bl[16]; float run = 0.f;
#pragma unroll
        for (int i = 0; i < 16; ++i) {
            float a = bias;
#pragma unroll
            for (int r = 0; r < 16; ++r) a += LR[(16 * tq + i) * 16 + r] * w2c[r];
            const float ls = fminf(a, 0.f) - log1pf(expf(-fabsf(a)));
            run += ls * (1.f / 16.f); bl[i] = run;
        }
        TOT[tq * 128 + dim] = run;
        __syncthreads();
        float pre = 0.f;
#pragma unroll
        for (int q = 0; q < 3; ++q) pre += q < tq ? TOT[q * 128 + dim] : 0.f;
#pragma unroll
        for (int i = 0; i < 16; ++i) bl[i] += pre;
        if (tq == 2) BM[dim] = bl[0];
        if (tq == 3) BL[dim] = bl[15];
        __syncthreads();
        const float bmid = BM[dim], blast = BL[dim];
        if (tq == 3) DEC[((size_t)(b * 4 + hh) * 64 + n) * 32 + dd] = expf(blast);
#pragma unroll
        for (int i = 0; i < 16; ++i) {
            const int t = 16 * tq + i;
            const float qv = (float)*(const LAS f16*)(lds + QK_OFF + t * 512 + dim * 2) * 0.17677669529663687f, kv = (float)*(const LAS f16*)(lds + QK_OFF + t * 512 + 256 + dim * 2);
            *(LAS f16*)(lds + QE_OFF + hh * 4096 + t * 64 + dd * 2) = (f16)(qv * expf(bl[i] - bmid));
            *(LAS f16*)(lds + KE_OFF + hh * 4096 + (dd >> 3) * 1024 + t * 16 + (dd & 7) * 2) = (f16)(kv * expf(bmid - bl[i]));
            *(LAS f16*)(lds + K2_OFF + hh * 4096 + t * 64 + dd * 2) = (f16)(kv * expf(blast - bl[i]));
            QE2H[(m0 + t) * 128 + dim] = (f16)(qv * expf(bl[i]));
        }
        __syncthreads();
        {
            const int h = wid >> 1, th = wid & 1;
            f16x8 qb[2];
#pragma unroll
            for (int d0 = 0; d0 < 2; ++d0) qb[d0] = *(const LAS f16x8*)(lds + QE_OFF + h * 4096 + (32 * th + r32) * 64 + (16 * d0 + 8 * hi) * 2);
            f32x16 p0, p1;
#pragma unroll
            for (int r = 0; r < 16; ++r) { p0[r] = 0.f; p1[r] = 0.f; }
            const LAS unsigned char* kb = lds + KE_OFF + h * 4096 + hi * 1024 + r32 * 16;
#pragma unroll
            for (int d0 = 0; d0 < 2; ++d0) {
                const f16x8 k0 = *(const LAS f16x8*)(kb + d0 * 2048), k1 = *(const LAS f16x8*)(kb + d0 * 2048 + 512);
                p0 = __builtin_amdgcn_mfma_f32_32x32x16_f16(k0, qb[d0], p0, 0, 0, 0);
                p1 = __builtin_amdgcn_mfma_f32_32x32x16_f16(k1, qb[d0], p1, 0, 0, 0);
            }
            const int trow = 32 * th + r32;
#pragma unroll
            for (int r = 0; r < 16; ++r) { const int s = crow(r, hi); p0[r] = s <= trow ? p0[r] : 0.f; p1[r] = s + 32 <= trow ? p1[r] : 0.f; }
            f32x16 o[2];
#pragma unroll
            for (int r = 0; r < 16; ++r) { o[0][r] = 0.f; o[1][r] = 0.f; }
            const LAS unsigned char* vs = lds + V_OFF + h * 8192 + ((lane >> 4) & 1) * 32 + (lane & 3) * 8 + (4 * hi + ((lane & 15) >> 2)) * 64;
            NSA_PV(o, p0, p1, vs);
#pragma unroll
            for (int d0 = 0; d0 < 2; ++d0)
#pragma unroll
                for (int r = 0; r < 16; ++r) OI16[(m0 + 32 * th + crow(r, hi)) * 256 + 64 * h + 32 * d0 + r32] = (f16)o[d0][r];
            f32x16 kvacc;
#pragma unroll
            for (int r = 0; r < 16; ++r) kvacc[r] = 0.f;
            const LAS unsigned char* ka = lds + K2_OFF + h * 4096 + ((lane >> 4) & 1) * 32 + (lane & 3) * 8 + (4 * hi + ((lane & 15) >> 2)) * 64;
#pragma unroll
            for (int ks = 0; ks < 4; ++ks) {
                const s16x4 alo = vtr(ka + ks * 1024), ahi = vtr(ka + ks * 1024 + 512), blo = vtr(vs + th * 4096 + ks * 1024), bhi = vtr(vs + th * 4096 + ks * 1024 + 512);
                const s16x8 av = {alo[0], alo[1], alo[2], alo[3], ahi[0], ahi[1], ahi[2], ahi[3]}, bv = {blo[0], blo[1], blo[2], blo[3], bhi[0], bhi[1], bhi[2], bhi[3]};
                kvacc = __builtin_amdgcn_mfma_f32_32x32x16_f16(__builtin_bit_cast(f16x8, av), __builtin_bit_cast(f16x8, bv), kvacc, 0, 0, 0);
            }
#pragma unroll
            for (int r = 0; r < 16; ++r) KV[((size_t)(b * 4 + h) * 64 + n) * 2048 + crow(r, hi) * 64 + 32 * th + r32] = kvacc[r];
        }
    }
}
__device__ __forceinline__ void ph_gla_scan(const Ctx& C, int TID, int bid, int nblk) {
    const float* DEC = (const float*)(C.ws + WS_DEC); const float* KV = (const float*)(C.ws + WS_KV); f16* SPT = (f16*)(C.ws + WS_SPT);
    for (int idx = bid * NT + TID; idx < NB * 4 * 2048; idx += nblk * NT) {
        const int dv = idx & 2047, bh = idx >> 11, d = dv >> 6, v = dv & 63;
        float st = 0.f;
        for (int n0 = 0; n0 < 64; n0 += 16) {
            float kvv[16], dc[16];
#pragma unroll
            for (int i = 0; i < 16; ++i) { kvv[i] = KV[((size_t)bh * 64 + n0 + i) * 2048 + dv]; dc[i] = DEC[((size_t)bh * 64 + n0 + i) * 32 + d]; }
#pragma unroll
            for (int i = 0; i < 16; ++i) { SPT[(((size_t)bh * 64 + n0 + i) * 64 + v) * 32 + d] = (f16)st; st = dc[i] * st + kvv[i]; }
        }
    }
}
__device__ __forceinline__ void ph_gla_final(const Ctx& C, int l, int TID, int bid, int nblk, LAS unsigned char* lds) {
    const f16* Z = (const f16*)(C.ws + WS_Z); f16* MIX = (f16*)(C.ws + WS_MIX);
    const f16* QE2H = (const f16*)(C.ws + WS_QE2H); const f16* OI16 = (const f16*)(C.ws + WS_OI16); const f16* SPT = (const f16*)(C.ws + WS_SPT);
    const float* gain = C.in[12] + (size_t)l * D + 512;
    const int tid = TID, lane = tid & 63, wid = __builtin_amdgcn_readfirstlane(tid >> 6), r32 = lane & 31, hi = lane >> 5;
    LAS float* SS = (LAS float*)lds;
    for (int item = bid; item < M / 64; item += nblk) {
        const size_t m0 = (size_t)item * 64; const int b = item >> 6, n = item & 63;
        const int h = wid >> 1, th = wid & 1;
        const f16* qa_p = QE2H + (m0 + 32 * th + r32) * 128 + 32 * h + 8 * hi;
        const f16x8 qa0 = *(const f16x8*)(qa_p), qa1 = *(const f16x8*)(qa_p + 16);
        f32x16 o[2];
#pragma unroll
        for (int vh = 0; vh < 2; ++vh) {
            const f16* sp = SPT + (((size_t)(b * 4 + h) * 64 + n) * 64 + 32 * vh + r32) * 32 + 8 * hi;
            const f16x8 s0 = *(const f16x8*)(sp), s1 = *(const f16x8*)(sp + 16);
#pragma unroll
            for (int r = 0; r < 16; ++r) o[vh][r] = (float)OI16[(m0 + 32 * th + crow(r, hi)) * 256 + 64 * h + 32 * vh + r32];
            o[vh] = __builtin_amdgcn_mfma_f32_32x32x16_f16(qa0, s0, o[vh], 0, 0, 0);
            o[vh] = __builtin_amdgcn_mfma_f32_32x32x16_f16(qa1, s1, o[vh], 0, 0, 0);
        }
        float ssum[16];
#pragma unroll
        for (int r = 0; r < 16; ++r) {
            float s = o[0][r] * o[0][r] + o[1][r] * o[1][r];
#pragma unroll
            for (int off = 1; off < 32; off <<= 1) s += __shfl_xor(s, off);
            const float rn = rsqrtf(s * (1.f / 64) + EPS);
            const size_t mt = m0 + 32 * th + crow(r, hi);
            float s2 = 0.f;
#pragma unroll
            for (int vh = 0; vh < 2; ++vh) { const float gv = (float)Z[mt * ZP + ZC_LG + 64 * h + 32 * vh + r32]; const float og = siluf(gv) * (o[vh][r] * rn); o[vh][r] = og; s2 += og * og; }
#pragma unroll
            for (int off = 1; off < 32; off <<= 1) s2 += __shfl_xor(s2, off);
            ssum[r] = s2;
        }
        __syncthreads();
        if (r32 == 0) {
#pragma unroll
            for (int r = 0; r < 16; ++r) SS[(32 * th + crow(r, hi)) * 4 + h] = ssum[r];
        }
        __syncthreads();
#pragma unroll
        for (int r = 0; r < 16; ++r) {
            const int t = 32 * th + crow(r, hi);
            const f32x4 s4 = *(const LAS f32x4*)(SS + t * 4);
            const float rinv = rsqrtf((s4[0] + s4[1] + s4[2] + s4[3]) * (1.f / 256) + EPS);
#pragma unroll
            for (int vh = 0; vh < 2; ++vh) MIX[(m0 + t) * D + 512 + 64 * h + 32 * vh + r32] = (f16)(o[vh][r] * rinv * gain[64 * h + 32 * vh + r32]);
        }
    }
}

__device__ __forceinline__ void ph_gmlp(const Ctx& C, int l, int TID, int bid, int nblk, LAS unsigned char* lds) {
    const f16* Z = (const f16*)(C.ws + WS_Z); f16* MIX = (f16*)(C.ws + WS_MIX);
    const f16* W16 = (const f16*)(C.ws + WS_WS16) + (size_t)l * 4 * 128 * 128;
    const float* bs = C.in[11] + (size_t)l * 4 * 128; const float* gain = C.in[12] + (size_t)l * D + 768;
    const int tid = TID, lane = tid & 63, wid = tid >> 6, r32 = lane & 31, hi = lane >> 5;
    LAS unsigned char* OS = lds + 65536;
    for (int item = bid; item < M / 128; item += nblk) {
        const size_t m0 = (size_t)item * 128;
        __syncthreads();
#pragma unroll
        for (int it = 0; it < 8; ++it) {
            const int q = tid + NT * it, s = q >> 5, g = (q >> 3) & 3, ch = q & 7;
            const f16x8 v8 = *(const f16x8*)(Z + (m0 + s) * ZP + ZC_MV + 64 * g + 8 * ch);
            float v[8]; float sum = 0.f;
#pragma unroll
            for (int e = 0; e < 8; ++e) { v[e] = (float)v8[e]; sum += v[e]; }
            sum += __shfl_xor(sum, 1); sum += __shfl_xor(sum, 2); sum += __shfl_xor(sum, 4);
            const float mu = sum * (1.f / 64); float var = 0.f;
#pragma unroll
            for (int e = 0; e < 8; ++e) { v[e] -= mu; var += v[e] * v[e]; }
            var += __shfl_xor(var, 1); var += __shfl_xor(var, 2); var += __shfl_xor(var, 4);
            const float rs = rsqrtf(var * (1.f / 64) + EPS);
            f16x8 o8;
#pragma unroll
            for (int e = 0; e < 8; ++e) o8[e] = (f16)(v[e] * rs);
            *(LAS f16x8*)(lds + g * 16384 + (ch >> 2) * 8192 + s * 64 + (ch & 3) * 16) = o8;
            *(LAS f16x8*)(OS + (s * 256 + 64 * g + 8 * ch) * 2) = *(const f16x8*)(Z + (m0 + s) * ZP + ZC_MU + 64 * g + 8 * ch);
        }
        __syncthreads();
        {
            const int g = wid >> 1, wh = wid & 1;
            const LAS unsigned char* vb = lds + g * 16384 + wh * 8192 + ((lane >> 4) & 1) * 32 + (lane & 3) * 8 + (4 * hi + ((lane & 15) >> 2)) * 64;
            for (int rt = 0; rt < 4; ++rt) {
                f32x16 acc;
#pragma unroll
                for (int r = 0; r < 16; ++r) acc[r] = 0.f;
                const f16* wrow = W16 + ((size_t)g * 128 + 32 * rt + r32) * 128 + 4 * hi;
                for (int ks = 0; ks < 2 * rt + 2; ++ks) {
                    const f16x4 a0 = *(const f16x4*)(wrow + 16 * ks), a1 = *(const f16x4*)(wrow + 16 * ks + 8);
                    const f16x8 af = {a0[0], a0[1], a0[2], a0[3], a1[0], a1[1], a1[2], a1[3]};
                    const s16x4 lo = vtr(vb + ks * 1024), hh = vtr(vb + ks * 1024 + 512);
                    typedef short s16x8 __attribute__((ext_vector_type(8)));
                    const s16x8 bv = {lo[0], lo[1], lo[2], lo[3], hh[0], hh[1], hh[2], hh[3]};
                    acc = __builtin_amdgcn_mfma_f32_32x32x16_f16(af, __builtin_bit_cast(f16x8, bv), acc, 0, 0, 0);
                }
#pragma unroll
                for (int r = 0; r < 16; ++r) {
                    const int t = 32 * rt + crow(r, hi), ch = 64 * g + 32 * wh + r32;
                    LAS f16* op = (LAS f16*)(OS + (t * 256 + ch) * 2);
                    *op = (f16)((float)*op * (acc[r] + bs[g * 128 + t]));
                }
            }
        }
        __syncthreads();
        for (int tt = 0; tt < 16; ++tt) {
            const int t = 16 * wid + tt;
            const f16x4 v4 = *(const LAS f16x4*)(OS + (t * 256 + 4 * lane) * 2);
            float v[4]; float ss = 0.f;
#pragma unroll
            for (int e = 0; e < 4; ++e) { v[e] = (float)v4[e]; ss += v[e] * v[e]; }
            const float r = rsqrtf(wave_sum(ss) * (1.f / 256) + EPS);
            const f32x4 gv = *(const f32x4*)(gain + 4 * lane);
            f16x4 o4;
#pragma unroll
            for (int e = 0; e < 4; ++e) o4[e] = (f16)(v[e] * r * gv[e]);
            *(f16x4*)(MIX + (m0 + t) * D + 768 + 4 * lane) = o4;
        }
    }
}

__device__ __forceinline__ void cvt_item(const float* W, int K, int N, f16* WT, bool remap, LAS float* scr, int item, int lane) {
    const int nb_ = (N + 31) / 32, kb = item / nb_, nb = item % nb_, k0 = 64 * kb, n0 = 32 * nb;
#pragma unroll 8
    for (int i = 0; i < 32; ++i) { const int kk = 2 * i + (lane >> 5), n = n0 + (lane & 31); scr[kk * 33 + (lane & 31)] = n < N ? W[(size_t)(k0 + kk) * N + n] : 0.f; }
    WAVE_LDS_SYNC();
    const int c = lane & 7;
#pragma unroll
    for (int j = 0; j < 4; ++j) {
        const int nn = (lane >> 3) + 8 * j, n = n0 + nn;
        if (n < N) {
            const int row = remap ? n + (n >= 1420 ? 4 : 0) : n; const LAS float* s = scr + (8 * c) * 33 + nn;
            f16x8 o;
#pragma unroll
            for (int e = 0; e < 8; ++e) o[e] = (f16)s[e * 33];
            *(f16x8*)(WT + (size_t)row * K + k0 + 8 * c) = o;
        }
    }
    WAVE_LDS_SYNC();
}
__device__ __forceinline__ void ph_wcvt(const Ctx& C, int TID, int bid, int nblk, LAS float* lds) {
    const int lane = TID & 63, wave = TID >> 6, gw = bid * NWAVE + wave, ngw = nblk * NWAVE;
    LAS float* scr = lds + wave * 4096;
    for (int it = gw; it < DEPTH * 2 * 2 * 64; it += ngw) {
        const int r = it & 63, half = (it >> 6) & 1, j = (it >> 7) & 1, l = it >> 8;
        cvt_item(C.in[6] + ((size_t)(l * 2 + j) * 2048 + half * 1024) * 128, 1024, 128, (f16*)(C.ws + WS_W1T) + ((size_t)(l * 2 + j) * 256 + half * 128) * 1024, false, scr, r, lane);
    }
    for (int it = gw; it < DEPTH * 4 * 128; it += ngw) {
        const float* w = C.in[10] + (size_t)it * 128; const int t = it & 127;
        f16* o = (f16*)(C.ws + WS_WS16) + (size_t)it * 128;
        o[lane] = (f16)(lane <= t ? w[lane] : 0.f); o[lane + 64] = (f16)(lane + 64 <= t ? w[lane + 64] : 0.f);
    }
    for (int it = gw; it < DEPTH * 2 * 32; it += ngw) {
        const int q = it & 31, lj = it >> 5;
        const float* pp = C.in[5] + (size_t)lj * 2048 + q * 64; const float* w = C.in[6] + ((size_t)lj * 2048 + q * 64) * 128;
        float a0 = 0.f, a1 = 0.f;
        for (int k = 0; k < 64; ++k) { const float pv = pp[k]; a0 += pv * w[k * 128 + lane]; a1 += pv * w[k * 128 + 64 + lane]; }
        float* o = (float*)(C.ws + WS_PCB) + (size_t)it * 128; o[lane] = a0; o[lane + 64] = a1;
    }
    constexpr int I_IN = (D / 64) * ((NIN + 31) / 32), I_O = (D / 64) * (D / 32), I_UP = (D / 64) * (DFF / 32), I_DN = (DFF / 64) * (D / 32), I_PAD = 100, I_L = I_IN + I_O + I_UP + I_DN + I_PAD;
    for (int it = gw; it < DEPTH * I_L; it += ngw) {
        const int l = it / I_L; int r = it % I_L;
        unsigned char* wl = C.ws + WS_W16 + (size_t)l * W16_LAYER;
        if (r < I_IN) { cvt_item(C.in[3] + (size_t)l * D * NIN, D, NIN, (f16*)(wl + W16_WIN), true, scr, r, lane); continue; } r -= I_IN;
        if (r < I_O) { cvt_item(C.in[13] + (size_t)l * D * D, D, D, (f16*)(wl + W16_WO), false, scr, r, lane); continue; } r -= I_O;
        if (r < I_UP) { cvt_item(C.in[17] + (size_t)l * D * DFF, D, DFF, (f16*)(wl + W16_WUP), false, scr, r, lane); continue; } r -= I_UP;
        if (r < I_DN) { cvt_item(C.in[18] + (size_t)l * DFF * D, DFF, D, (f16*)(wl + W16_WDN), false, scr, r, lane); continue; } r -= I_DN;
        const int row = r < 4 ? 1420 + r : 2720 + (r - 4);
        f16x8 z; for (int e = 0; e < 8; ++e) z[e] = (f16)0.f;
        f16* p = (f16*)(wl + W16_WIN) + (size_t)row * D;
        *(f16x8*)(p + 8 * lane) = z; *(f16x8*)(p + 512 + 8 * lane) = z;
    }
}

namespace pg8 {
#define PG8_LAS __attribute__((address_space(3)))
typedef _Float16 bf16_t;
typedef _Float16 bf16x8 __attribute__((ext_vector_type(8)));
typedef float f32x4 __attribute__((ext_vector_type(4)));
typedef unsigned u32x4 __attribute__((ext_vector_type(4)));
constexpr int BM = 256, BK = 64, HALF = 128, HTB = HALF * BK * 2  , STAGE_BYTES = 8 * HTB, NXCD = 8, WGM = 8;

__host__ __device__ __forceinline__ int lds_byte(int r, int c) { const int st = (r >> 4) * 2 + (c >> 5), rr = r & 15, cc = c & 31, ob = rr * 64 + cc * 2; return st * 1024 + (ob ^ (((ob >> 9) & 1) << 5)); }
__host__ __device__ __forceinline__ void stage_rc(int b, int& R, int& C) { const int st = b / 1024, sb = b % 1024, swz = sb ^ (((sb >> 9) & 1) << 5); R = (st >> 1) * 16 + swz / 64; C = (st & 1) * 32 + (swz % 64) / 2; }
__host__ __device__ __forceinline__ int perm32(int rho) { const int n = rho >> 4, i = rho & 15; return 8 * (i >> 2) + 4 * n + (i & 3); }

struct Unit { int pm, pn; };
struct Gemm { const bf16_t* A; const bf16_t* Bt; int M, N, K; };

struct StaticOrder {
    int nM, nN, nwg, G, c;
    __host__ __device__ void init(int M, int N, int G_, int c_) { nM = M / BM; nN = N / BM; nwg = nM * nN; G = G_; c = c_; }
    __host__ __device__ bool next(int i, Unit& u) const {
        const long L = (long)i * G + c; if (L >= nwg) return false;
        int wgid = (int)L; { const int q = nwg / NXCD, r = nwg % NXCD, xcd = wgid % NXCD, off = wgid / NXCD; wgid = (xcd < r ? xcd * (q + 1) : r * (q + 1) + (xcd - r) * q) + off; }
        const int nig = WGM * nN, gid = wgid / nig, fm = gid * WGM, gsz = (nM - fm) < WGM ? (nM - fm) : WGM;
        u.pm = fm + ((wgid % nig) % gsz); u.pn = (wgid % nig) / gsz; return true;
    }
    __device__ __forceinline__ void a_ready(const Unit&) const {}
    __device__ __forceinline__ void done(const Unit&) const {}
};


template <int ACT> struct EpiF16 {
    static constexpr bool PERM = true, AFTER_DRAIN = false;
    bf16_t* O; int ldc;
    __device__ __forceinline__ void operator()(const f32x4 (&acc)[2][2][4][2], const Unit& u, int wr, int wc, int fr, int fq) const {
        const int row0 = u.pm * BM + wr * 64 + fr, col0 = u.pn * BM + wc * 32 + 8 * fq;
#pragma unroll
        for (int ai = 0; ai < 2; ++ai)
#pragma unroll
            for (int m = 0; m < 4; ++m) { bf16_t* rowp = O + (size_t)(row0 + ai * HALF + m * 16) * ldc + col0;
#pragma unroll
                for (int bj = 0; bj < 2; ++bj) { f32x4 v0 = acc[ai][bj][m][0], v1 = acc[ai][bj][m][1];
                    if (ACT == 1) {
#pragma unroll
                        for (int e = 0; e < 4; ++e) { const float a = fmaxf(v0[e], 0.f), b = fmaxf(v1[e], 0.f); v0[e] = a * a; v1[e] = b * b; } }
                    bf16x8 w; w[0] = (bf16_t)v0[0]; w[1] = (bf16_t)v0[1]; w[2] = (bf16_t)v0[2]; w[3] = (bf16_t)v0[3]; w[4] = (bf16_t)v1[0]; w[5] = (bf16_t)v1[1]; w[6] = (bf16_t)v1[2]; w[7] = (bf16_t)v1[3];
                    *(bf16x8*)(rowp + bj * HALF) = w; } }
    }
};
template <class Epi, class Sched, bool ALIGN_EPI = false, bool SP2 = false>
__device__ __forceinline__ void gemm_phase(PG8_LAS unsigned char* lds, const Gemm g, const Sched& S, const Epi& E, const int tid) {
    const int  wid = __builtin_amdgcn_readfirstlane(tid >> 6), lane = tid & 63, wr = wid >> 2, wc = wid & 3, fr = lane & 15, fq = lane >> 4;
    const int K = g.K, nt = K / BK;
    unsigned voffA[2], voffB[2];
#pragma unroll
    for (int i = 0; i < 2; ++i) { int R, C; stage_rc(tid * 16 + i * 8192, R, C); const int Rb = Epi::PERM ? ((R & ~31) + perm32(R & 31)) : R;
        voffA[i] = (unsigned)(R * K + C) * 2u; voffB[i] = (unsigned)(Rb * K + C) * 2u; }
    const size_t kstep = (size_t)(BK * 2);
    const size_t hstep = (size_t)HALF * K * 2;
    const size_t tstep = 2 * hstep;
    const unsigned ldsw = (unsigned)wid * 1024u;
    const int aoff = lds_byte(wr * 64 + fr, fq * 8), boff = lds_byte(wc * 32 + fr, fq * 8);
#define PG8_SA(b, h) (((b) * 2 + (h)) * HTB)
#define PG8_SB(b, h) ((4 + (b) * 2 + (h)) * HTB)
#define PG8_STAGE(bufoff, gbase, voff) do { _Pragma("unroll") for (int _i = 0; _i < 2; ++_i) \
        __builtin_amdgcn_global_load_lds((const unsigned*)((const char*)(gbase) + (voff)[_i]), (PG8_LAS unsigned*)(lds + (bufoff) + ldsw + _i * 8192), 16, 0, 0); } while (0)
#define PG8_LDA(dst, b, h) do { _Pragma("unroll") for (int m = 0; m < 4; ++m) _Pragma("unroll") for (int k = 0; k < 2; ++k) dst[m][k] = *(const PG8_LAS bf16x8*)(lds + PG8_SA(b, h) + aoff + m * 2048 + k * 1024); } while (0)
#define PG8_LDB(dst, b, h) do { _Pragma("unroll") for (int n = 0; n < 2; ++n) _Pragma("unroll") for (int k = 0; k < 2; ++k) dst[n][k] = *(const PG8_LAS bf16x8*)(lds + PG8_SB(b, h) + boff + n * 2048 + k * 1024); } while (0)
#define PG8_MMA(ai, bj, At, Bt) do { __builtin_amdgcn_s_setprio(1); _Pragma("unroll") for (int m = 0; m < 4; ++m) _Pragma("unroll") for (int n = 0; n < 2; ++n) _Pragma("unroll") for (int k = 0; k < 2; ++k) \
        acc[ai][bj][m][n] = __builtin_amdgcn_mfma_f32_16x16x32_f16(Bt[n][k], At[m][k], acc[ai][bj][m][n], 0, 0, 0); __builtin_amdgcn_s_setprio(0); } while (0)
#define PG8_WAIT_V(n) asm volatile("s_waitcnt vmcnt(" #n ")" ::: "memory")
#define PG8_WAIT_L(n) asm volatile("s_waitcnt lgkmcnt(" #n ")" ::: "memory")
#define PG8_BAR __builtin_amdgcn_s_barrier()
#define PG8_SCHED __builtin_amdgcn_sched_barrier(0)
    Unit cur, nxt; int ui = 0;
    if (!S.next(0, cur)) return;
    f32x4 acc[2][2][4][2];
#pragma unroll
    for (int a = 0; a < 2; ++a)
#pragma unroll
        for (int b = 0; b < 2; ++b)
#pragma unroll
            for (int m = 0; m < 4; ++m)
#pragma unroll
                for (int n = 0; n < 2; ++n) acc[a][b][m][n] = (f32x4){0.f, 0.f, 0.f, 0.f};
    bf16x8 At[4][2], B0[2][2], B1[2][2];
    const char* cA = (const char*)g.A + (size_t)cur.pm * tstep; const char* cB = (const char*)g.Bt + (size_t)cur.pn * tstep;
    S.a_ready(cur);
    if constexpr (SP2) {
        PG8_STAGE(PG8_SB(0, 0), cB, voffB); PG8_STAGE(PG8_SB(0, 1), cB + hstep, voffB); PG8_STAGE(PG8_SA(0, 0), cA, voffA); PG8_STAGE(PG8_SA(0, 1), cA + hstep, voffA);
        if (wr == 1) PG8_BAR;
        PG8_WAIT_V(2); PG8_BAR;
        PG8_STAGE(PG8_SB(1, 0), cB + kstep, voffB); PG8_STAGE(PG8_SA(1, 0), cA + kstep, voffA); PG8_STAGE(PG8_SB(1, 1), cB + hstep + kstep, voffB);
        PG8_WAIT_V(6); PG8_BAR;
    } else {
        PG8_STAGE(PG8_SB(0, 0), cB, voffB); PG8_STAGE(PG8_SA(0, 0), cA, voffA); PG8_STAGE(PG8_SB(0, 1), cB + hstep, voffB); PG8_STAGE(PG8_SA(0, 1), cA + hstep, voffA);
        if (wr == 1) PG8_BAR;
        PG8_WAIT_V(4); PG8_BAR;
        PG8_STAGE(PG8_SB(1, 0), cB + kstep, voffB); PG8_STAGE(PG8_SA(1, 0), cA + kstep, voffA); PG8_STAGE(PG8_SB(1, 1), cB + hstep + kstep, voffB);
        PG8_WAIT_V(6); PG8_BAR;
    }
    for (;;) {
        const bool has_next = S.next(ui + 1, nxt);
        const char* nA = has_next ? (const char*)g.A + (size_t)nxt.pm * tstep : cA; const char* nB = has_next ? (const char*)g.Bt + (size_t)nxt.pn * tstep : cB;
        for (int t = 0; t < nt; t += 2) {
            const bool last = (t == nt - 2);
            const char* a1 = cA + (size_t)(t + 1) * kstep;
            const char* a2 = last ? nA : cA + (size_t)(t + 2) * kstep; const char* b2 = last ? nB : cB + (size_t)(t + 2) * kstep;
            const char* a3 = a2 + kstep; const char* b3 = b2 + kstep;
            if (last && has_next) S.a_ready(nxt);
            if constexpr (SP2) {
            PG8_LDB(B0, 0, 0); PG8_LDB(B1, 0, 1); PG8_SCHED; PG8_LDA(At, 0, 0); PG8_STAGE(PG8_SA(1, 1), a1 + hstep, voffA);
            PG8_WAIT_V(8); PG8_WAIT_L(0); PG8_BAR; PG8_MMA(0, 0, At, B0); PG8_MMA(0, 1, At, B1); PG8_BAR; PG8_SCHED;
            PG8_LDA(At, 0, 1); PG8_STAGE(PG8_SB(0, 0), b2, voffB); PG8_STAGE(PG8_SB(0, 1), b2 + hstep, voffB); PG8_STAGE(PG8_SA(0, 0), a2, voffA);
            PG8_WAIT_V(8); PG8_WAIT_L(0); PG8_BAR; PG8_MMA(1, 0, At, B0); PG8_MMA(1, 1, At, B1); PG8_BAR; PG8_SCHED;
            PG8_LDB(B0, 1, 0); PG8_LDB(B1, 1, 1); PG8_SCHED; PG8_LDA(At, 1, 0); PG8_STAGE(PG8_SA(0, 1), a2 + hstep, voffA);
            PG8_WAIT_V(8); PG8_WAIT_L(0); PG8_BAR; PG8_MMA(0, 0, At, B0); PG8_MMA(0, 1, At, B1); PG8_BAR; PG8_SCHED;
            PG8_LDA(At, 1, 1); PG8_STAGE(PG8_SB(1, 0), b3, voffB); PG8_STAGE(PG8_SB(1, 1), b3 + hstep, voffB); PG8_STAGE(PG8_SA(1, 0), a3, voffA);
            PG8_WAIT_V(8); PG8_WAIT_L(0); PG8_BAR; PG8_MMA(1, 0, At, B0); PG8_MMA(1, 1, At, B1); PG8_BAR; PG8_SCHED;
            } else {
            PG8_LDB(B0, 0, 0); PG8_SCHED; PG8_LDA(At, 0, 0); PG8_STAGE(PG8_SA(1, 1), a1 + hstep, voffA);
            PG8_WAIT_L(8); PG8_BAR; PG8_WAIT_L(0); PG8_MMA(0, 0, At, B0); PG8_BAR; PG8_SCHED;
            PG8_LDB(B1, 0, 1); PG8_STAGE(PG8_SB(0, 0), b2, voffB);
            PG8_BAR; PG8_WAIT_L(0); PG8_MMA(0, 1, At, B1); PG8_BAR;
            PG8_LDA(At, 0, 1); PG8_STAGE(PG8_SA(0, 0), a2, voffA);
            PG8_BAR; PG8_WAIT_L(0); PG8_MMA(1, 0, At, B0); PG8_BAR; PG8_SCHED;
            PG8_STAGE(PG8_SB(0, 1), b2 + hstep, voffB);
            PG8_WAIT_V(6); PG8_BAR; PG8_MMA(1, 1, At, B1); PG8_BAR;
            PG8_LDB(B0, 1, 0); PG8_SCHED; PG8_LDA(At, 1, 0); PG8_STAGE(PG8_SA(0, 1), a2 + hstep, voffA);
            PG8_WAIT_L(8); PG8_BAR; PG8_WAIT_L(0); PG8_MMA(0, 0, At, B0); PG8_BAR; PG8_SCHED;
            PG8_LDB(B1, 1, 1); PG8_STAGE(PG8_SB(1, 0), b3, voffB);
            PG8_BAR; PG8_WAIT_L(0); PG8_MMA(0, 1, At, B1); PG8_BAR;
            PG8_LDA(At, 1, 1); PG8_STAGE(PG8_SA(1, 0), a3, voffA);
            PG8_BAR; PG8_WAIT_L(0); PG8_MMA(1, 0, At, B0); PG8_BAR; PG8_SCHED;
            PG8_STAGE(PG8_SB(1, 1), b3 + hstep, voffB);
            PG8_WAIT_V(6); PG8_BAR; PG8_MMA(1, 1, At, B1); PG8_BAR;
            }
        }
        if constexpr (ALIGN_EPI) { if (wr == 0) PG8_BAR; }
        if constexpr (!Epi::AFTER_DRAIN) { E(acc, cur, wr, wc, fr, fq); S.done(cur); }
        if (!has_next) break;
#pragma unroll
        for (int a = 0; a < 2; ++a)
#pragma unroll
            for (int b = 0; b < 2; ++b)
#pragma unroll
                for (int m = 0; m < 4; ++m)
#pragma unroll
                    for (int n = 0; n < 2; ++n) acc[a][b][m][n] = (f32x4){0.f, 0.f, 0.f, 0.f};
        cur = nxt; cA = nA; cB = nB; ++ui;
        if constexpr (ALIGN_EPI) { if (wr == 1) PG8_BAR; }
    }
    PG8_WAIT_V(0);
    if constexpr (!ALIGN_EPI) { if (wr == 0) PG8_BAR; }
    PG8_BAR;
    if constexpr (Epi::AFTER_DRAIN) { E.fused(acc, cur, wr, wc, fr, fq, lds, wid, lane); S.done(cur); }
#undef PG8_SA
#undef PG8_SB
#undef PG8_STAGE
#undef PG8_LDA
#undef PG8_LDB
#undef PG8_MMA
#undef PG8_WAIT_V
#undef PG8_WAIT_L
#undef PG8_BAR
#undef PG8_SCHED
}
}

#define XB_TMO      128
#define XB_XCNT(j)  (256  + 64 * (j))
#define XB_XSUB(j)  (1280 + 64 * (j))
#define XB_XGEN(j)  (2304 + 64 * (j))
#define XB_TOP      3328
#define XB_TOPGEN   3392
#define XCD_BAR_WORDS 3456
#define XB_SPIN_CAP (1u << 18)

__device__ __forceinline__ unsigned xb_ld(unsigned* p)              { return __hip_atomic_load(p, __ATOMIC_RELAXED, __HIP_MEMORY_SCOPE_AGENT); }
__device__ __forceinline__ unsigned xb_add(unsigned* p, unsigned v) { return __hip_atomic_fetch_add(p, v, __ATOMIC_RELAXED, __HIP_MEMORY_SCOPE_AGENT); }
__device__ __forceinline__ unsigned xb_xcc_id() { return (unsigned)__builtin_amdgcn_s_getreg((3 << 11) | 20) & 0xFu; }
#define XB_SPIN(cond, bar) do { unsigned _sp = 0; while (cond) { __builtin_amdgcn_s_sleep(1); \
    if ((++_sp & 255u) == 0u) { if (xb_ld(&(bar)[XB_TMO])) break; if (_sp > XB_SPIN_CAP) { atomicAdd(&(bar)[XB_TMO], 1u); break; } } } } while (0)

struct XcdBarrier {
    unsigned* bar; unsigned x;
    volatile LAS unsigned* st;
};

__device__ __forceinline__ XcdBarrier xcd_barrier_post(unsigned* bar, volatile LAS unsigned* st) {
    XcdBarrier b; b.bar = bar; b.x = xb_xcc_id(); b.st = st;
    if (threadIdx.x == 0) (void)xb_add(&bar[XB_XCNT(b.x)], 1u);
    return b;
}
__device__ __forceinline__ void xcd_barrier_complete(unsigned* bar, unsigned x, unsigned& nloc, unsigned& nx) {
    const unsigned G = gridDim.x * gridDim.y * gridDim.z;
    unsigned sum, cnt, mine, sp = 0u;
    for (;;) {
        sum = 0u; cnt = 0u; mine = 0u;
#pragma unroll
        for (unsigned j = 0; j < 16; ++j) { const unsigned c = xb_ld(&bar[XB_XCNT(j)]); sum += c; cnt += (c > 0u) ? 1u : 0u; mine = (j == x) ? c : mine; }
        if (sum == G) break;
        __builtin_amdgcn_s_sleep(1);
        if ((++sp & 255u) == 0u) { if (xb_ld(&bar[XB_TMO])) break; if (sp > XB_SPIN_CAP) { atomicAdd(&bar[XB_TMO], 1u); break; } }
    }
    nloc = mine > 0u ? mine : 1u; nx = cnt > 0u ? cnt : 1u;
}

__device__ __forceinline__ void xcd_barrier(const XcdBarrier& b) {
    asm volatile("s_waitcnt vmcnt(0)" ::: "memory");
    __syncthreads();
    if (threadIdx.x == 0) {
        unsigned* bar = b.bar;
        __builtin_amdgcn_s_waitcnt(0);
        unsigned nloc = b.st[0], nx = b.st[1];
        if (nloc == 0u) { xcd_barrier_complete(bar, b.x, nloc, nx); b.st[0] = nloc; b.st[1] = nx; }
        const unsigned old = xb_add(&bar[XB_XSUB(b.x)], 1u);
        const unsigned gen = old / nloc;
        if (old + 1u == (gen + 1u) * nloc) {
            __builtin_amdgcn_fence(__ATOMIC_RELEASE, "agent");
            asm volatile("s_waitcnt vmcnt(0)" ::: "memory");
            const unsigned og = xb_add(&bar[XB_TOP], 1u);
            const unsigned tg = og / nx;
            if (og + 1u == (tg + 1u) * nx) xb_add(&bar[XB_TOPGEN], 1u);
            else XB_SPIN(xb_ld(&bar[XB_TOPGEN]) == tg, bar);
            __builtin_amdgcn_fence(__ATOMIC_ACQUIRE, "agent");
            xb_add(&bar[XB_XGEN(b.x)], 1u);
            asm volatile("s_waitcnt vmcnt(0)" ::: "memory");
        } else {
            XB_SPIN(xb_ld(&bar[XB_XGEN(b.x)]) == gen, bar);
            __builtin_amdgcn_fence(__ATOMIC_ACQUIRE, "agent");
            asm volatile("s_waitcnt vmcnt(0)" ::: "memory");
        }
    }
    __syncthreads();
}

constexpr int CW_BAR = 4096;
constexpr int LDS_MISC = LDS_BYTES - 256;
#define LAUNDER(v) asm volatile("" : "+s"(v))
__global__ void __launch_bounds__(NT, 2) k_mega(Ctx Carg) {
#if defined(__HIP_DEVICE_COMPILE__)
    extern __shared__ __attribute__((aligned(16))) unsigned char lds_raw[];
    LAS float* lds = (LAS float*)lds_raw;
    const int bid = blockIdx.x, nblk = gridDim.x;
    for (int u = threadIdx.x; u < 64; u += NT) ((LAS unsigned*)((LAS unsigned char*)lds_raw + LDS_MISC))[u] = 0u;
    __syncthreads();
    typedef const __attribute__((address_space(4))) Ctx* CtxCP;
    CtxCP Cp = (CtxCP)__builtin_amdgcn_kernarg_segment_ptr();
    const int wave_s = __builtin_amdgcn_readfirstlane(threadIdx.x >> 6);
    XcdBarrier bar = xcd_barrier_post((unsigned*)(Cp->ws + WS_CTL) + CW_BAR, (volatile LAS unsigned*)((LAS unsigned char*)lds_raw + LDS_MISC + 32));
#ifndef DUPMASK
#define DUPMASK 0
#endif
#ifndef PMASK
#define PMASK 0xFFFFF
#endif
#define SITE(k, ...) for (int rep_ = 0; rep_ < 1 + ((DUPMASK >> (k)) & 1); ++rep_) do { if (!((PMASK >> (k)) & 1)) break; CtxCP cp_ = Cp; LAUNDER(cp_); const Ctx C = *cp_; int ll = l; LAUNDER(ll); int wv_ = wave_s; LAUNDER(wv_); int tid_ = (wv_ << 6) | (int)__builtin_amdgcn_mbcnt_hi(~0u, __builtin_amdgcn_mbcnt_lo(~0u, 0u)); asm volatile("" : "+v"(tid_)); int bid_ = bid; LAUNDER(bid_); int nblk_ = nblk; LAUNDER(nblk_); \
        f16* H = (f16*)(C.ws + WS_H); f16* Zb = (f16*)(C.ws + WS_Z); f16* MIX = (f16*)(C.ws + WS_MIX); f16* Y = (f16*)(C.ws + WS_Y); f16* U = (f16*)(C.ws + WS_BIG); \
        (void)H; (void)Zb; (void)MIX; (void)Y; (void)U; __VA_ARGS__; } while (0); { XcdBarrier b_ = bar; LAUNDER(b_.x); LAUNDER(b_.bar); xcd_barrier(b_); }
    int l = 0;
    SITE(0, ph_mod(C, tid_, bid_, nblk_, lds); __syncthreads(); ph_rope(C, tid_, bid_, nblk_); ph_wcvt(C, tid_, bid_, nblk_, lds));
    SITE(1, ph_norm0(C, tid_, bid_, nblk_));
    for (l = 0; l < DEPTH; ++l) {
        SITE(2, { pg8::Gemm g{H, (const f16*)(C.ws + WS_W16 + (size_t)ll * W16_LAYER + W16_WIN), M, ZP, D}; pg8::StaticOrder S; S.init(M, ZP, nblk_, bid_); pg8::EpiF16<0> E{Zb, ZP}; pg8::gemm_phase<pg8::EpiF16<0>, pg8::StaticOrder, true, true>((LAS unsigned char*)lds, g, S, E, tid_); });
        SITE(3, ph_conv(C, ll, tid_, bid_, nblk_); ph_rotk(C, tid_, bid_, nblk_); ph_cmp1(C, ll, tid_, bid_, nblk_); ph_gla_local(C, ll, tid_, bid_, nblk_, (LAS unsigned char*)lds); ph_gmlp(C, ll, tid_, bid_, nblk_, (LAS unsigned char*)lds));
        SITE(4, ph_cmp2(C, ll, tid_, bid_, nblk_, lds); ph_gla_scan(C, tid_, bid_, nblk_));
        SITE(5, ph_nsa(C, ll, tid_, bid_, nblk_, lds); __syncthreads(); ph_gla_final(C, ll, tid_, bid_, nblk_, (LAS unsigned char*)lds));
        SITE(8, { pg8::Gemm g{MIX, (const f16*)(C.ws + WS_W16 + (size_t)ll * W16_LAYER + W16_WO), M, D, D}; pg8::StaticOrder S; S.init(M, D, nblk_, bid_); pg8::EpiF16<0> E{Y, D}; pg8::gemm_phase<pg8::EpiF16<0>, pg8::StaticOrder, true, true>((LAS unsigned char*)lds, g, S, E, tid_); });
        SITE(9, ph_resnorm(C, ll, 0, tid_, bid_, nblk_));
        SITE(10, { pg8::Gemm g{H, (const f16*)(C.ws + WS_W16 + (size_t)ll * W16_LAYER + W16_WUP), M, DFF, D}; pg8::StaticOrder S; S.init(M, DFF, nblk_, bid_); pg8::EpiF16<1> E{U, DFF}; pg8::gemm_phase<pg8::EpiF16<1>, pg8::StaticOrder, true, true>((LAS unsigned char*)lds, g, S, E, tid_); });
        SITE(11, { pg8::Gemm g{U, (const f16*)(C.ws + WS_W16 + (size_t)ll * W16_LAYER + W16_WDN), M, D, DFF}; pg8::StaticOrder S; S.init(M, D, nblk_, bid_); pg8::EpiF16<0> E{Y, D}; pg8::gemm_phase<pg8::EpiF16<0>, pg8::StaticOrder, true, true>((LAS unsigned char*)lds, g, S, E, tid_); });
        SITE(12, ph_resnorm(C, ll, 1, tid_, bid_, nblk_));
    }
#undef SITE
#endif
}

extern "C" void kernel_launch(void* const* d_in, const int* in_sizes, int n_in, void* d_out, int out_size, void* d_ws, size_t ws_size, hipStream_t stream) {
    static int grid = 0;
    if (grid == 0) {
        if (n_in != 19 || ws_size < WS_END) { fprintf(stderr, "kernel_launch: unexpected n_in %d / ws_size %zu\n", n_in, ws_size); grid = -1; return; }
        int dev = 0, cus = 0, per_cu = 0;
        if (hipGetDevice(&dev) != hipSuccess || hipDeviceGetAttribute(&cus, hipDeviceAttributeMultiprocessorCount, dev) != hipSuccess) { grid = -1; return; }
        if (hipFuncSetAttribute((const void*)k_mega, hipFuncAttributeMaxDynamicSharedMemorySize, LDS_BYTES) != hipSuccess) { fprintf(stderr, "hipFuncSetAttribute failed\n"); grid = -1; return; }
        if (hipOccupancyMaxActiveBlocksPerMultiprocessor(&per_cu, (const void*)k_mega, NT, LDS_BYTES) != hipSuccess || per_cu < 1) { fprintf(stderr, "occupancy query: %d\n", per_cu); }
        (void)hipGetLastError();
        grid = cus;
    }
    if (grid < 0) return;
    if (hipMemsetAsync((char*)d_ws + WS_CTL, 0, 1 * MiB, stream) != hipSuccess) return;
    Ctx c{};
    for (int i = 0; i < 19; ++i) c.in[i] = (const float*)d_in[i];
    c.out = (float*)d_out; c.ws = (unsigned char*)d_ws;
    hipLaunchKernelGGL(k_mega, dim3(grid), dim3(NT), LDS_BYTES, stream, c);
}
```
